# Optimizing an MI355X kernel written in HIP

```python
import math
import jax, jax.numpy as jnp
from jax import lax
import numpy as np

D_MODEL = 1024
BATCH = 1
SEQ = 16384
DEPTH = 2

D_RWKV = D_MODEL // 2
RWKV_HEAD = 64
RWKV_HEADS = D_RWKV // RWKV_HEAD
D_CONV = D_MODEL - D_RWKV
CONV_WIDTH = 3
LORA_W = 64
LORA_A = 64
LORA_G = 128
D_IN_A = 3 * D_RWKV + LORA_W + LORA_A + LORA_G
D_IN_B = 3 * D_CONV
D_IN = D_IN_A + D_IN_B
GN_EPS = 64e-5
SSM_GROUP = 16
SSM_GROUPS = D_MODEL // SSM_GROUP
SSM_STATE = 64
SSM_CHUNK = 128
D_FF = 4 * D_MODEL
D_PLE = 256
RMS_EPS = 1e-6

kernel_name = 'hybrid_rwkv7_shortconv_s5_block'


def rms_norm(x, g):
    xf = x.astype(jnp.float32)
    y = xf * lax.rsqrt(jnp.mean(xf * xf, axis=-1, keepdims=True) + RMS_EPS)
    return (y * g.astype(jnp.float32)).astype(x.dtype)


def shift_prev(x, n=1):
    return jnp.pad(x, ((0, 0), (n, 0), (0, 0)))[:, :x.shape[1]]


def rwkv7_recurrence(r, w, k, v, a, b):
    bsz, _, heads, n = r.shape

    def step(s, inp):
        r_t, w_t, k_t, v_t, a_t, b_t = inp
        sa = jnp.einsum('bhij,bhj->bhi', s, a_t)
        s = s * w_t[:, :, None, :] + sa[..., :, None] * b_t[..., None, :] + v_t[..., :, None] * k_t[..., None, :]
        return s, jnp.einsum('bhij,bhj->bhi', s, r_t)

    xs = tuple(jnp.moveaxis(t, 1, 0) for t in (r, w, k, v, a, b))
    s0 = jnp.zeros((bsz, heads, n, n), jnp.float32)
    _, y = lax.scan(step, s0, xs)
    return jnp.moveaxis(y, 0, 1)


def rwkv_conv_mixer(hn, w_in, shift_mu, w0, w_lora_up, a0, a_lora_up, g_lora_up,
                    k_k, k_a, r_k, ln_w, ln_b, conv_w, w_out):
    bsz, t, _ = hn.shape
    f32 = jnp.float32
    z = hn @ w_in
    za, zb = z[..., :D_IN_A], z[..., D_IN_A:]
    za = za + shift_mu * (shift_prev(za) - za)
    r, k, v, xw, xa, xg = jnp.split(
        za, [D_RWKV, 2 * D_RWKV, 3 * D_RWKV, 3 * D_RWKV + LORA_W, 3 * D_RWKV + LORA_W + LORA_A], axis=-1)
    w_log = -jax.nn.softplus(-(w0 + jnp.tanh(xw) @ w_lora_up)) - 0.5
    decay = jnp.exp(-jnp.exp(w_log.astype(f32)))
    a = jax.nn.sigmoid(a0 + xa @ a_lora_up)
    g = jax.nn.sigmoid(xg) @ g_lora_up

    def heads(u):
        return u.reshape(bsz, t, RWKV_HEADS, RWKV_HEAD).astype(f32)

    kk = heads(k * k_k)
    kk = kk / jnp.maximum(jnp.sqrt(jnp.sum(kk * kk, axis=-1, keepdims=True)), 1e-12)
    k = k * (1.0 + (a - 1.0) * k_a)
    r_h, k_h, v_h, a_h = heads(r), heads(k), heads(v), heads(a)
    y = rwkv7_recurrence(r_h, heads(decay), k_h, v_h, -kk, kk * a_h)
    mu = jnp.mean(y, axis=-1, keepdims=True)
    var = jnp.mean(jnp.square(y - mu), axis=-1, keepdims=True)
    y = (y - mu) * lax.rsqrt(var + GN_EPS)
    y = y * ln_w.reshape(RWKV_HEADS, RWKV_HEAD).astype(f32) + ln_b.reshape(RWKV_HEADS, RWKV_HEAD).astype(f32)
    bonus = jnp.sum(r_h * k_h * r_k.astype(f32), axis=-1, keepdims=True) * v_h
    y_a = ((y + bonus).reshape(bsz, t, D_RWKV) * g.astype(f32)).astype(hn.dtype)
    b_gate, c_gate, xin = jnp.split(zb, 3, axis=-1)
    u = c_gate * xin
    conv = conv_w[0] * u + conv_w[1] * shift_prev(u, 1) + conv_w[2] * shift_prev(u, 2)
    y_b = b_gate * conv
    return jnp.concatenate([y_a, y_b], axis=-1) @ w_out


def _affine_combine(e1, e2):
    a1, b1 = e1
    a2, b2 = e2
    return a2 * a1, a2 * b1 + b2


def s5_mixer(hn, lambda_re, lambda_im, log_step, b_re, b_im, c_re, c_im, d_skip, glu_w1, glu_w2):
    bsz, t, _ = hn.shape
    f32, c64 = jnp.float32, jnp.complex64
    u = hn.astype(f32).reshape(bsz, t, SSM_GROUPS, SSM_GROUP)
    lam = lax.complex(jnp.minimum(lambda_re.astype(f32), -1e-4), lambda_im.astype(f32))
    step = jnp.exp(log_step.astype(f32))[:, None]
    lam_bar = jnp.exp(lam * step)
    b_bar = ((lam_bar - 1.0) / lam)[..., None] * lax.complex(b_re.astype(f32), b_im.astype(f32))
    c = lax.complex(c_re.astype(f32), c_im.astype(f32))
    n_chunks = t // SSM_CHUNK
    u_chunks = u.reshape(bsz, n_chunks, SSM_CHUNK, SSM_GROUPS, SSM_GROUP).transpose(1, 2, 0, 3, 4)

    def chunk_step(h_prev, u_c):
        bu = jnp.einsum('gpc,lbgc->lbgp', b_bar, u_c.astype(c64))
        a_cum, h_loc = lax.associative_scan(_affine_combine, (jnp.broadcast_to(lam_bar, bu.shape), bu), axis=0)
        states = h_loc + a_cum * h_prev[None]
        y_c = jnp.real(jnp.einsum('gcp,lbgp->lbgc', c, states))
        return states[-1], y_c

    h0 = jnp.zeros((bsz, SSM_GROUPS, SSM_STATE), c64)
    _, y = lax.scan(chunk_step, h0, u_chunks)
    y = y.transpose(2, 0, 1, 3, 4).reshape(bsz, t, SSM_GROUPS, SSM_GROUP)
    y = (y + d_skip.reshape(SSM_GROUPS, SSM_GROUP).astype(f32) * u).reshape(bsz, t, D_MODEL)
    y = jax.nn.gelu(y).astype(hn.dtype)
    return (y @ glu_w1) * jax.nn.sigmoid(y @ glu_w2)


def sqrelu_mlp(hn, ffn_up, ffn_down):
    return jnp.square(jax.nn.relu(hn @ ffn_up)) @ ffn_down


def setup_inputs(seed: int = 0) -> dict:
    key = jax.random.key(seed)
    ks = iter(jax.random.split(key, 64))

    def nrm(shape, scale):
        return jax.random.normal(next(ks), shape, jnp.float32) * scale

    def gain(n):
        return 1.0 + nrm((n,), 0.02)

    d = D_MODEL
    ratio = jnp.arange(D_RWKV, dtype=jnp.float32) / (D_RWKV - 1)
    inp = {}
    inp['x'] = nrm((BATCH, SEQ, d), 1.0)
    inp['p'] = nrm((DEPTH, BATCH, SEQ, D_PLE), 1.0)
    inp['l0_norm_mix'] = gain(d)
    inp['l0_w_in'] = nrm((d, D_IN), d ** -0.5)
    inp['l0_shift_mu'] = jax.random.uniform(next(ks), (D_IN_A,), jnp.float32)
    inp['l0_w0'] = -6.5 + 5.0 * ratio ** 0.85 + nrm((D_RWKV,), 0.1)
    inp['l0_w_lora_up'] = nrm((LORA_W, D_RWKV), 0.1 * LORA_W ** -0.5)
    inp['l0_a0'] = nrm((D_RWKV,), 0.1)
    inp['l0_a_lora_up'] = nrm((LORA_A, D_RWKV), 0.1 * LORA_A ** -0.5)
    inp['l0_g_lora_up'] = nrm((LORA_G, D_RWKV), LORA_G ** -0.5)
    inp['l0_k_k'] = 0.85 + nrm((D_RWKV,), 0.02)
    inp['l0_k_a'] = 1.0 + nrm((D_RWKV,), 0.02)
    inp['l0_r_k'] = nrm((RWKV_HEADS, RWKV_HEAD), 0.1)
    inp['l0_ln_w'] = gain(D_RWKV)
    inp['l0_ln_b'] = nrm((D_RWKV,), 0.02)
    inp['l0_conv_w'] = nrm((CONV_WIDTH, D_CONV), CONV_WIDTH ** -0.5)
    inp['l0_w_out'] = nrm((d, d), d ** -0.5)
    inp['l0_norm_ffn'] = gain(d)
    inp['l0_ffn_up'] = nrm((d, D_FF), d ** -0.5)
    inp['l0_ffn_down'] = nrm((D_FF, d), D_FF ** -0.5)
    inp['l0_norm_ple'] = gain(d)
    inp['l0_ple_gate'] = nrm((d, d), d ** -0.5)
    inp['l0_ple_proj'] = nrm((D_PLE, d), D_PLE ** -0.5)
    inp['l1_norm_mix'] = gain(d)
    inp['l1_lambda_re'] = -0.5 + nrm((SSM_GROUPS, SSM_STATE), 0.01)
    inp['l1_lambda_im'] = math.pi * jnp.arange(SSM_STATE, dtype=jnp.float32)[None, :] + nrm((SSM_GROUPS, SSM_STATE), 0.01)
    inp['l1_log_step'] = jax.random.uniform(next(ks), (SSM_GROUPS,), jnp.float32, math.log(1e-3), math.log(1e-1))
    inp['l1_b_re'] = nrm((SSM_GROUPS, SSM_STATE, SSM_GROUP), (2 * SSM_GROUP) ** -0.5)
    inp['l1_b_im'] = nrm((SSM_GROUPS, SSM_STATE, SSM_GROUP), (2 * SSM_GROUP) ** -0.5)
    inp['l1_c_re'] = nrm((SSM_GROUPS, SSM_GROUP, SSM_STATE), SSM_STATE ** -0.5)
    inp['l1_c_im'] = nrm((SSM_GROUPS, SSM_GROUP, SSM_STATE), SSM_STATE ** -0.5)
    inp['l1_d_skip'] = nrm((d,), 1.0)
    inp['l1_glu_w1'] = nrm((d, d), d ** -0.5)
    inp['l1_glu_w2'] = nrm((d, d), d ** -0.5)
    inp['l1_norm_ffn'] = gain(d)
    inp['l1_ffn_up'] = nrm((d, D_FF), d ** -0.5)
    inp['l1_ffn_down'] = nrm((D_FF, d), D_FF ** -0.5)
    inp['l1_norm_ple'] = gain(d)
    inp['l1_ple_gate'] = nrm((d, d), d ** -0.5)
    inp['l1_ple_proj'] = nrm((D_PLE, d), D_PLE ** -0.5)
    inp['norm_final'] = gain(d)
    return inp


def reference(x, p,
              l0_norm_mix, l0_w_in, l0_shift_mu, l0_w0, l0_w_lora_up, l0_a0, l0_a_lora_up, l0_g_lora_up,
              l0_k_k, l0_k_a, l0_r_k, l0_ln_w, l0_ln_b, l0_conv_w, l0_w_out,
              l0_norm_ffn, l0_ffn_up, l0_ffn_down, l0_norm_ple, l0_ple_gate, l0_ple_proj,
              l1_norm_mix, l1_lambda_re, l1_lambda_im, l1_log_step, l1_b_re, l1_b_im, l1_c_re, l1_c_im,
              l1_d_skip, l1_glu_w1, l1_glu_w2,
              l1_norm_ffn, l1_ffn_up, l1_ffn_down, l1_norm_ple, l1_ple_gate, l1_ple_proj,
              norm_final):
    mix_fns = [rwkv_conv_mixer, s5_mixer]
    mix_params = [
        (l0_w_in, l0_shift_mu, l0_w0, l0_w_lora_up, l0_a0, l0_a_lora_up, l0_g_lora_up,
         l0_k_k, l0_k_a, l0_r_k, l0_ln_w, l0_ln_b, l0_conv_w, l0_w_out),
        (l1_lambda_re, l1_lambda_im, l1_log_step, l1_b_re, l1_b_im, l1_c_re, l1_c_im,
         l1_d_skip, l1_glu_w1, l1_glu_w2),
    ]
    norm_mix = [l0_norm_mix, l1_norm_mix]
    norm_ffn = [l0_norm_ffn, l1_norm_ffn]
    ffn = [(l0_ffn_up, l0_ffn_down), (l1_ffn_up, l1_ffn_down)]
    norm_ple = [l0_norm_ple, l1_norm_ple]
    ple = [(l0_ple_gate, l0_ple_proj), (l1_ple_gate, l1_ple_proj)]

    h = x
    for i in range(DEPTH):
        h = h + mix_fns[i % 2](rms_norm(h, norm_mix[i]), *mix_params[i])
        h = h + sqrelu_mlp(rms_norm(h, norm_ffn[i]), *ffn[i])
        gate = jax.nn.sigmoid(rms_norm(h, norm_ple[i]) @ ple[i][0])
        h = h + (p[i] @ ple[i][1]) * gate
    return rms_norm(h, norm_final)
```

```cpp
#include <hip/hip_runtime.h>
#include <hip/hip_cooperative_groups.h>
#include <cstdio>
#include <cstdint>
namespace pg8 {
#define PG8_LAS __attribute__((address_space(3)))
typedef unsigned short bf16_t;
typedef short bf16x8 __attribute__((ext_vector_type(8)));
typedef float f32x4 __attribute__((ext_vector_type(4)));
typedef unsigned u32x4 __attribute__((ext_vector_type(4)));
constexpr int BM = 256, BK = 64, HALF = 128, HTB = HALF * BK * 2  , STAGE_BYTES = 8 * HTB, NXCD = 8, WGM = 8;

__host__ __device__ __forceinline__ int lds_byte(int r, int c) { const int st = (r >> 4) * 2 + (c >> 5), rr = r & 15, cc = c & 31, ob = rr * 64 + cc * 2; return st * 1024 + (ob ^ (((ob >> 9) & 1) << 5)); }
__host__ __device__ __forceinline__ void stage_rc(int b, int& R, int& C) { const int st = b / 1024, sb = b % 1024, swz = sb ^ (((sb >> 9) & 1) << 5); R = (st >> 1) * 16 + swz / 64; C = (st & 1) * 32 + (swz % 64) / 2; }
__host__ __device__ __forceinline__ int perm32(int rho) { const int n = rho >> 4, i = rho & 15; return 8 * (i >> 2) + 4 * n + (i & 3); }

struct Unit { int pm, pn; };
struct Gemm { const bf16_t* A; const bf16_t* Bt; int M, N, K; };

struct StaticOrder {
    int nM, nN, nwg, G, c;
    __host__ __device__ void init(int M, int N, int G_, int c_) { nM = M / BM; nN = N / BM; nwg = nM * nN; G = G_; c = c_; }
    __host__ __device__ bool next(int i, Unit& u) const {
        const long L = (long)i * G + c; if (L >= nwg) return false;
        int wgid = (int)L; { const int q = nwg / NXCD, r = nwg % NXCD, xcd = wgid % NXCD, off = wgid / NXCD; wgid = (xcd < r ? xcd * (q + 1) : r * (q + 1) + (xcd - r) * q) + off; }
        const int nig = WGM * nN, gid = wgid / nig, fm = gid * WGM, gsz = (nM - fm) < WGM ? (nM - fm) : WGM;
        u.pm = fm + ((wgid % nig) % gsz); u.pn = (wgid % nig) / gsz; return true;
    }
    __device__ __forceinline__ void a_ready(const Unit&) const {}
    __device__ __forceinline__ void done(const Unit&) const {}
};

typedef float f32x2n __attribute__((ext_vector_type(2))); typedef __bf16 hbf2n __attribute__((ext_vector_type(2)));
__device__ __forceinline__ unsigned cvt_pk_bf16(float lo, float hi) { const f32x2n v = {lo, hi}; const hbf2n b = __builtin_convertvector(v, hbf2n); return __builtin_bit_cast(unsigned, b); }
typedef float f32x2 __attribute__((ext_vector_type(2)));

constexpr int TT = 16384;
typedef unsigned u32x2 __attribute__((ext_vector_type(2)));
__device__ __forceinline__ float fsigmoid(float x) { return __builtin_amdgcn_rcpf(1.0f + __expf(-x)); }
template <int NSL> __device__ __forceinline__ float row_rstd(const float* st, int r, int fq) {
    const f32x4 v = *(const f32x4*)(st + (size_t)r * 32 + 4 * fq);
    float s = (v[0] + v[1]) + (v[2] + v[3]);
    if (NSL == 32) { const f32x4 w = *(const f32x4*)(st + (size_t)r * 32 + 16 + 4 * fq); s += (w[0] + w[1]) + (w[2] + w[3]); }
    s += __shfl_xor(s, 16); s += __shfl_xor(s, 32);
    return rsqrtf(s * (1.0f / 1024.0f) + 1e-6f);
}
template <int MODE, int NSL> struct EpiB {
    static constexpr bool PERM = true, AFTER_DRAIN = false;
    bf16_t* o0; bf16_t* o1; bf16_t* o2; const float* st; const float* c0; const float* c1; int ldc;
    __device__ __forceinline__ void operator()(const f32x4 (&acc)[2][2][4][2], const Unit& u, int wr, int wc, int fr, int fq) const {
        const int row0 = u.pm * BM + wr * 64 + fr; const int pn = u.pn;
        bf16_t* base; int ld, colt; int kind = 0;
        if (MODE == 0) {
            if (pn < 6) { base = o0 + (size_t)(pn >> 1) * TT * 512; ld = 512; colt = (pn & 1) * 256; }
            else if (pn == 6) { base = o1; ld = 256; colt = 0; }
            else { base = o2; ld = 1536; colt = (pn - 7) * 256; }
        } else if (MODE == 1) {
            kind = pn >> 1; base = o0 + (size_t)kind * TT * 512; if (kind == 2) base = o2; ld = 512; colt = (pn & 1) * 256;
        } else { base = o0; ld = ldc; colt = pn * 256; }
        const int col0 = colt + wc * 32 + 8 * fq;
        const float* cbias = c0; if (kind == 1) cbias = c1; cbias += col0;
        f32x4 bv00 = (f32x4){0.f, 0.f, 0.f, 0.f}, bv01 = bv00, bv10 = bv00, bv11 = bv00;
        if (MODE == 1) { if (kind < 2) { bv00 = *(const f32x4*)(cbias); bv01 = *(const f32x4*)(cbias + 4); bv10 = *(const f32x4*)(cbias + HALF); bv11 = *(const f32x4*)(cbias + HALF + 4); } }
#pragma unroll
        for (int ai = 0; ai < 2; ++ai)
#pragma unroll
            for (int m = 0; m < 4; ++m) {
                const int r = row0 + ai * HALF + m * 16;
                float rs = 1.f;
                if (MODE == 0 || MODE == 2) rs = row_rstd<NSL>(st, r, fq);
                bf16_t* rowp = base + (size_t)r * ld + col0;
#pragma unroll
                for (int bj = 0; bj < 2; ++bj) {
                    f32x4 v0 = acc[ai][bj][m][0], v1 = acc[ai][bj][m][1];
                    if (MODE == 0) { v0 = v0 * rs; v1 = v1 * rs; }
                    if (MODE == 2) {
#pragma unroll
                        for (int e = 0; e < 4; ++e) { float a = fmaxf(v0[e], 0.f) * rs, b = fmaxf(v1[e], 0.f) * rs; v0[e] = a * a; v1[e] = b * b; }
                    }
                    if (MODE == 1) {
                        if (kind < 2) {
                            const float sc = kind == 0 ? (0.6065306597f * 1.4426950409f) : 1.0f;
                            v0 = v0 + (bj == 0 ? bv00 : bv10); v1 = v1 + (bj == 0 ? bv01 : bv11);
#pragma unroll
                            for (int e = 0; e < 4; ++e) { v0[e] = sc * fsigmoid(v0[e]); v1[e] = sc * fsigmoid(v1[e]); }
                        }
                    }
                    u32x4 w; w.x = cvt_pk_bf16(v0[0], v0[1]); w.y = cvt_pk_bf16(v0[2], v0[3]); w.z = cvt_pk_bf16(v1[0], v1[1]); w.w = cvt_pk_bf16(v1[2], v1[3]);
                    *(u32x4*)(rowp + bj * HALF) = w;
                }
                if (m & 1) asm volatile("" ::: "memory");
            }
    }
};
template <int MODE> struct EpiRes {
    static constexpr bool PERM = false, AFTER_DRAIN = false;
    const float* base; float* out; bf16_t* hb; const float* st_in; float* st_out; const bf16_t* pp;
    __device__ __forceinline__ void operator()(const f32x4 (&acc)[2][2][4][2], const Unit& u, int wr, int wc, int fr, int fq) const {
        const int row0 = u.pm * BM + wr * 64 + fr;
#pragma unroll
        for (int ai = 0; ai < 2; ++ai)
#pragma unroll
            for (int m = 0; m < 4; ++m) {
                const int r = row0 + ai * HALF + m * 16;
                float rs = 1.f;
                if (MODE == 1) rs = row_rstd<16>(st_in, r, fq);
                float ss = 0.f;
#pragma unroll
                for (int bj = 0; bj < (MODE == 2 ? 1 : 2); ++bj)
#pragma unroll
                    for (int n = 0; n < 2; ++n) {
                        const int c = (MODE == 2 ? u.pn * 128 : u.pn * BM + bj * HALF) + wc * 32 + n * 16 + 4 * fq;
                        const size_t off = (size_t)r * 1024 + c;
                        const f32x4 b = *(const f32x4*)(base + off);
                        f32x4 v = acc[ai][bj][m][n];
                        if (MODE == 1) {
                            const u32x2 pw = *(const u32x2*)(pp + off);
                            const float p0 = __uint_as_float(pw.x << 16), p1 = __uint_as_float(pw.x & 0xffff0000u), p2 = __uint_as_float(pw.y << 16), p3 = __uint_as_float(pw.y & 0xffff0000u);
                            v[0] = p0 * fsigmoid(v[0] * rs); v[1] = p1 * fsigmoid(v[1] * rs); v[2] = p2 * fsigmoid(v[2] * rs); v[3] = p3 * fsigmoid(v[3] * rs);
                        }
                        if (MODE == 2) {
                            const f32x4 g = acc[ai][1][m][n];
#pragma unroll
                            for (int e = 0; e < 4; ++e) v[e] = v[e] * fsigmoid(g[e]);
                        }
                        const f32x4 o = b + v;
                        *(f32x4*)(out + off) = o;
                        if (hb) { u32x2 w; w.x = cvt_pk_bf16(o[0], o[1]); w.y = cvt_pk_bf16(o[2], o[3]); *(u32x2*)(hb + off) = w; }
                        ss += (o[0] * o[0] + o[1] * o[1]) + (o[2] * o[2] + o[3] * o[3]);
                    }
                ss += __shfl_xor(ss, 16); ss += __shfl_xor(ss, 32);
                if (fq == 0) st_out[(size_t)r * 32 + u.pn * 4 + wc] = ss;
                asm volatile("" ::: "memory");
            }
    }
};

template <class Epi, class Sched, bool ALIGN_EPI = false, bool SP2 = false>
__device__ __forceinline__ void gemm_phase(PG8_LAS unsigned char* lds, const Gemm g, const Sched& S, const Epi& E) {
    int tid_l = threadIdx.x; asm volatile("" : "+v"(tid_l)); const int tid = tid_l, wid = __builtin_amdgcn_readfirstlane(tid >> 6), lane = tid & 63, wr = wid >> 2, wc = wid & 3, fr = lane & 15, fq = lane >> 4;
    int K = g.K; asm volatile("" : "+s"(K)); const int nt = K / BK;
    unsigned voffA[2], voffB[2];
#pragma unroll
    for (int i = 0; i < 2; ++i) { int R, C; stage_rc(tid * 16 + i * 8192, R, C); const int Rb = Epi::PERM ? ((R & ~31) + perm32(R & 31)) : R;
        voffA[i] = (unsigned)(R * K + C) * 2u; voffB[i] = (unsigned)(Rb * K + C) * 2u; }
    const size_t kstep = (size_t)(BK * 2);
    const size_t hstep = (size_t)HALF * K * 2;
    const size_t tstep = 2 * hstep;
    const unsigned ldsw = (unsigned)wid * 1024u;
    const int aoff = lds_byte(wr * 64 + fr, fq * 8), boff = lds_byte(wc * 32 + fr, fq * 8);
#define PG8_SA(b, h) (((b) * 2 + (h)) * HTB)
#define PG8_SB(b, h) ((4 + (b) * 2 + (h)) * HTB)
#define PG8_STAGE(bufoff, gbase, voff) do { _Pragma("unroll") for (int _i = 0; _i < 2; ++_i) \
        __builtin_amdgcn_global_load_lds((const unsigned*)((const char*)(gbase) + (voff)[_i]), (PG8_LAS unsigned*)(lds + (bufoff) + ldsw + _i * 8192), 16, 0, 0); } while (0)
#define PG8_LDA(dst, b, h) do { _Pragma("unroll") for (int m = 0; m < 4; ++m) _Pragma("unroll") for (int k = 0; k < 2; ++k) dst[m][k] = *(const PG8_LAS bf16x8*)(lds + PG8_SA(b, h) + aoff + m * 2048 + k * 1024); } while (0)
#define PG8_LDB(dst, b, h) do { _Pragma("unroll") for (int n = 0; n < 2; ++n) _Pragma("unroll") for (int k = 0; k < 2; ++k) dst[n][k] = *(const PG8_LAS bf16x8*)(lds + PG8_SB(b, h) + boff + n * 2048 + k * 1024); } while (0)
#define PG8_MMA(ai, bj, At, Bt) do { __builtin_amdgcn_s_setprio(1); _Pragma("unroll") for (int m = 0; m < 4; ++m) _Pragma("unroll") for (int n = 0; n < 2; ++n) _Pragma("unroll") for (int k = 0; k < 2; ++k) \
        acc[ai][bj][m][n] = __builtin_amdgcn_mfma_f32_16x16x32_bf16(Bt[n][k], At[m][k], acc[ai][bj][m][n], 0, 0, 0); __builtin_amdgcn_s_setprio(0); } while (0)
#define PG8_WAIT_V(n) asm volatile("s_waitcnt vmcnt(" #n ")" ::: "memory")
#define PG8_WAIT_L(n) asm volatile("s_waitcnt lgkmcnt(" #n ")" ::: "memory")
#define PG8_BAR __builtin_amdgcn_s_barrier()
#define PG8_SCHED __builtin_amdgcn_sched_barrier(0)
    Unit cur, nxt; int ui = 0;
    if (!S.next(0, cur)) return;
    f32x4 acc[2][2][4][2];
#pragma unroll
    for (int a = 0; a < 2; ++a)
#pragma unroll
        for (int b = 0; b < 2; ++b)
#pragma unroll
            for (int m = 0; m < 4; ++m)
#pragma unroll
                for (int n = 0; n < 2; ++n) acc[a][b][m][n] = (f32x4){0.f, 0.f, 0.f, 0.f};
    bf16x8 At[4][2], B0[2][2], B1[2][2];
    const char* cA = (const char*)g.A + (size_t)cur.pm * tstep; const char* cB = (const char*)g.Bt + (size_t)cur.pn * tstep;
    S.a_ready(cur);
    if constexpr (SP2) {
        PG8_STAGE(PG8_SB(0, 0), cB, voffB); PG8_STAGE(PG8_SB(0, 1), cB + hstep, voffB); PG8_STAGE(PG8_SA(0, 0), cA, voffA); PG8_STAGE(PG8_SA(0, 1), cA + hstep, voffA);
        if (wr == 1) PG8_BAR;
        PG8_WAIT_V(2); PG8_BAR;
        PG8_STAGE(PG8_SB(1, 0), cB + kstep, voffB); PG8_STAGE(PG8_SA(1, 0), cA + kstep, voffA); PG8_STAGE(PG8_SB(1, 1), cB + hstep + kstep, voffB);
        PG8_WAIT_V(6); PG8_BAR;
    } else {
        PG8_STAGE(PG8_SB(0, 0), cB, voffB); PG8_STAGE(PG8_SA(0, 0), cA, voffA); PG8_STAGE(PG8_SB(0, 1), cB + hstep, voffB); PG8_STAGE(PG8_SA(0, 1), cA + hstep, voffA);
        if (wr == 1) PG8_BAR;
        PG8_WAIT_V(4); PG8_BAR;
        PG8_STAGE(PG8_SB(1, 0), cB + kstep, voffB); PG8_STAGE(PG8_SA(1, 0), cA + kstep, voffA); PG8_STAGE(PG8_SB(1, 1), cB + hstep + kstep, voffB);
        PG8_WAIT_V(6); PG8_BAR;
    }
    for (;;) {
        const bool has_next = S.next(ui + 1, nxt);
        const char* nA = has_next ? (const char*)g.A + (size_t)nxt.pm * tstep : cA; const char* nB = has_next ? (const char*)g.Bt + (size_t)nxt.pn * tstep : cB;
        for (int t = 0; t < nt; t += 2) {
            const bool last = (t == nt - 2);
            const char* a1 = cA + (size_t)(t + 1) * kstep;
            const char* a2 = last ? nA : cA + (size_t)(t + 2) * kstep; const char* b2 = last ? nB : cB + (size_t)(t + 2) * kstep;
            const char* a3 = a2 + kstep; const char* b3 = b2 + kstep;
            if (last && has_next) S.a_ready(nxt);
            if constexpr (SP2) {
            PG8_LDB(B0, 0, 0); PG8_LDB(B1, 0, 1); PG8_SCHED; PG8_LDA(At, 0, 0); PG8_STAGE(PG8_SA(1, 1), a1 + hstep, voffA);
            PG8_WAIT_V(8); PG8_WAIT_L(0); PG8_BAR; PG8_MMA(0, 0, At, B0); PG8_MMA(0, 1, At, B1); PG8_BAR; PG8_SCHED;
            PG8_LDA(At, 0, 1); PG8_STAGE(PG8_SB(0, 0), b2, voffB); PG8_STAGE(PG8_SB(0, 1), b2 + hstep, voffB); PG8_STAGE(PG8_SA(0, 0), a2, voffA);
            PG8_WAIT_V(8); PG8_WAIT_L(0); PG8_BAR; PG8_MMA(1, 0, At, B0); PG8_MMA(1, 1, At, B1); PG8_BAR; PG8_SCHED;
            PG8_LDB(B0, 1, 0); PG8_LDB(B1, 1, 1); PG8_SCHED; PG8_LDA(At, 1, 0); PG8_STAGE(PG8_SA(0, 1), a2 + hstep, voffA);
            PG8_WAIT_V(8); PG8_WAIT_L(0); PG8_BAR; PG8_MMA(0, 0, At, B0); PG8_MMA(0, 1, At, B1); PG8_BAR; PG8_SCHED;
            PG8_LDA(At, 1, 1); PG8_STAGE(PG8_SB(1, 0), b3, voffB); PG8_STAGE(PG8_SB(1, 1), b3 + hstep, voffB); PG8_STAGE(PG8_SA(1, 0), a3, voffA);
            PG8_WAIT_V(8); PG8_WAIT_L(0); PG8_BAR; PG8_MMA(1, 0, At, B0); PG8_MMA(1, 1, At, B1); PG8_BAR; PG8_SCHED;
            } else {
            PG8_LDB(B0, 0, 0); PG8_SCHED; PG8_LDA(At, 0, 0); PG8_STAGE(PG8_SA(1, 1), a1 + hstep, voffA);
            PG8_WAIT_L(8); PG8_BAR; PG8_WAIT_L(0); PG8_MMA(0, 0, At, B0); PG8_BAR; PG8_SCHED;
            PG8_LDB(B1, 0, 1); PG8_STAGE(PG8_SB(0, 0), b2, voffB);
            PG8_BAR; PG8_WAIT_L(0); PG8_MMA(0, 1, At, B1); PG8_BAR;
            PG8_LDA(At, 0, 1); PG8_STAGE(PG8_SA(0, 0), a2, voffA);
            PG8_BAR; PG8_WAIT_L(0); PG8_MMA(1, 0, At, B0); PG8_BAR; PG8_SCHED;
            PG8_STAGE(PG8_SB(0, 1), b2 + hstep, voffB);
            PG8_WAIT_V(6); PG8_BAR; PG8_MMA(1, 1, At, B1); PG8_BAR;
            PG8_LDB(B0, 1, 0); PG8_SCHED; PG8_LDA(At, 1, 0); PG8_STAGE(PG8_SA(0, 1), a2 + hstep, voffA);
            PG8_WAIT_L(8); PG8_BAR; PG8_WAIT_L(0); PG8_MMA(0, 0, At, B0); PG8_BAR; PG8_SCHED;
            PG8_LDB(B1, 1, 1); PG8_STAGE(PG8_SB(1, 0), b3, voffB);
            PG8_BAR; PG8_WAIT_L(0); PG8_MMA(0, 1, At, B1); PG8_BAR;
            PG8_LDA(At, 1, 1); PG8_STAGE(PG8_SA(1, 0), a3, voffA);
            PG8_BAR; PG8_WAIT_L(0); PG8_MMA(1, 0, At, B0); PG8_BAR; PG8_SCHED;
            PG8_STAGE(PG8_SB(1, 1), b3 + hstep, voffB);
            PG8_WAIT_V(6); PG8_BAR; PG8_MMA(1, 1, At, B1); PG8_BAR;
            }
        }
        if constexpr (ALIGN_EPI) { if (wr == 0) PG8_BAR; }
        if constexpr (!Epi::AFTER_DRAIN) { E(acc, cur, wr, wc, fr, fq); S.done(cur); }
        if (!has_next) break;
#pragma unroll
        for (int a = 0; a < 2; ++a)
#pragma unroll
            for (int b = 0; b < 2; ++b)
#pragma unroll
                for (int m = 0; m < 4; ++m)
#pragma unroll
                    for (int n = 0; n < 2; ++n) acc[a][b][m][n] = (f32x4){0.f, 0.f, 0.f, 0.f};
        cur = nxt; cA = nA; cB = nB; ++ui;
        if constexpr (ALIGN_EPI) { if (wr == 1) PG8_BAR; }
    }
    PG8_WAIT_V(0);
    if constexpr (!ALIGN_EPI) { if (wr == 0) PG8_BAR; }
    PG8_BAR;
    if constexpr (Epi::AFTER_DRAIN) { E.fused(acc, cur, wr, wc, fr, fq, lds, wid, lane); S.done(cur); }
#undef PG8_SA
#undef PG8_SB
#undef PG8_STAGE
#undef PG8_LDA
#undef PG8_LDB
#undef PG8_MMA
#undef PG8_WAIT_V
#undef PG8_WAIT_L
#undef PG8_BAR
#undef PG8_SCHED
}
}

namespace cg = cooperative_groups;
#define LAS __attribute__((address_space(3)))
typedef unsigned short bf16;
typedef float f32x4 __attribute__((ext_vector_type(4)));
typedef float f32x2 __attribute__((ext_vector_type(2)));
typedef unsigned u32x4 __attribute__((ext_vector_type(4)));
typedef unsigned u32x2 __attribute__((ext_vector_type(2)));
typedef short bf16x8 __attribute__((ext_vector_type(8)));
typedef short bf16x4 __attribute__((ext_vector_type(4)));

constexpr int T = 16384, D = 1024, FF = 4096, DIN = 3328, NWAVES = 8;
constexpr int LDS_BYTES = 147456;
constexpr size_t KiB = 1024, MiB = 1024 * 1024;
constexpr size_t WS_BON = 0;
constexpr size_t WS_EST = 1 * MiB;
constexpr size_t WS_S5P = 5 * MiB;
constexpr size_t WS_STA = 8 * MiB, WS_STB = 10 * MiB;
constexpr size_t W_IN = 12 * MiB, W_LORA = W_IN + 6656 * KiB, W_OUT = W_LORA + 768 * KiB, W_UP0 = W_OUT + 2 * MiB, W_DN0 = W_UP0 + 8 * MiB, W_G0 = W_DN0 + 8 * MiB,
                 W_P0 = W_G0 + 2 * MiB, W_GLU = W_P0 + 512 * KiB, W_UP1 = W_GLU + 4 * MiB, W_DN1 = W_UP1 + 8 * MiB, W_G1 = W_DN1 + 8 * MiB, W_P1 = W_G1 + 2 * MiB;
static_assert(W_P1 + 512 * KiB <= 64 * MiB, "weights");
constexpr size_t WS_PBF = 64 * MiB;
constexpr size_t WS_B1 = 80 * MiB, WS_B2 = 112 * MiB;
constexpr size_t WS_R = 144 * MiB, WS_E = 192 * MiB, WS_A = 208 * MiB, WS_KP = 224 * MiB;
constexpr size_t WS_HID = 112 * MiB;
constexpr size_t WS_PP = 144 * MiB, WS_YG = 144 * MiB;
constexpr size_t WS_END = 240 * MiB;
constexpr size_t DO_ZB = 0, DO_X = 48 * MiB, DO_AP = 56 * MiB, DO_KK = 48 * MiB, DO_G = 0, DO_RS = 16 * MiB, DO_VS = 32 * MiB;
constexpr size_t WS_Y = 144 * MiB;

__device__ __forceinline__ float bflo(unsigned w) { return __uint_as_float(w << 16); }
__device__ __forceinline__ float bfhi(unsigned w) { return __uint_as_float(w & 0xffff0000u); }
__device__ __forceinline__ unsigned pk2(float lo, float hi) { return pg8::cvt_pk_bf16(lo, hi); }
__device__ __forceinline__ void unpack8(const u32x4 w, float (&f)[8]) { f[0] = bflo(w.x); f[1] = bfhi(w.x); f[2] = bflo(w.y); f[3] = bfhi(w.y); f[4] = bflo(w.z); f[5] = bfhi(w.z); f[6] = bflo(w.w); f[7] = bfhi(w.w); }
__device__ __forceinline__ u32x4 pack8(const float (&f)[8]) { u32x4 w; w.x = pk2(f[0], f[1]); w.y = pk2(f[2], f[3]); w.z = pk2(f[4], f[5]); w.w = pk2(f[6], f[7]); return w; }
__device__ __forceinline__ float wave_sum(float v) {
#pragma unroll
    for (int o = 1; o < 64; o <<= 1) v += __shfl_xor(v, o);
    return v;
}
__device__ __forceinline__ float sum8(float v) { v += __shfl_xor(v, 1); v += __shfl_xor(v, 2); v += __shfl_xor(v, 4); return v; }
template <int CTRL, int RM> __device__ __forceinline__ float dpp0(float x) {
    return __builtin_bit_cast(float, __builtin_amdgcn_update_dpp(0, __builtin_bit_cast(int, x), CTRL, RM, 0xf, false));
}
__device__ __forceinline__ float wave_sum_dpp(float x) {
    x += dpp0<0xB1, 0xf>(x);
    x += dpp0<0x4E, 0xf>(x);
    x += dpp0<0x141, 0xf>(x);
    x += dpp0<0x140, 0xf>(x);
    x += dpp0<0x142, 0xa>(x);
    x += dpp0<0x143, 0xc>(x);
    return __builtin_bit_cast(float, __builtin_amdgcn_readlane(__builtin_bit_cast(int, x), 63));
}
__device__ __forceinline__ float gelu_tanh(float x) {
    const float u = 0.7978845608f * (x + 0.044715f * x * x * x);
    const float e = __expf(2.0f * u);
    const float th = 1.0f - 2.0f * __builtin_amdgcn_rcpf(e + 1.0f);
    return 0.5f * x * (1.0f + th);
}

__device__ __forceinline__ void tr_item(const float* W, int K, int N, bf16* WT, int mode, const float* gain, LAS float* scr, int item, int lane) {
    const int nblk = N / 32, kb = item / nblk, nb = item % nblk, k0 = 64 * kb, n0 = 32 * nb;
#pragma unroll 8
    for (int i = 0; i < 32; ++i) { const int kk = 2 * i + (lane >> 5); float v = W[(size_t)(k0 + kk) * N + n0 + (lane & 31)]; if (gain) v *= gain[k0 + kk]; scr[kk * 33 + (lane & 31)] = v; }
    asm volatile("s_waitcnt lgkmcnt(0)" ::: "memory");
    const int c = lane & 7;
#pragma unroll
    for (int j = 0; j < 4; ++j) { const int n = (lane >> 3) + 8 * j; const LAS float* s = scr + (8 * c) * 33 + n;
        u32x4 o; o.x = pk2(s[0 * 33], s[1 * 33]); o.y = pk2(s[2 * 33], s[3 * 33]); o.z = pk2(s[4 * 33], s[5 * 33]); o.w = pk2(s[6 * 33], s[7 * 33]);
        const int ng = n0 + n; const int row = mode == 0 ? ng : (256 * (ng >> 7) + (ng & 127) + (mode == 2 ? 128 : 0));
        *(u32x4*)(WT + (size_t)row * K + k0 + 8 * c) = o; }
    asm volatile("s_waitcnt lgkmcnt(0)" ::: "memory");
}

#define RLX_AGENT __ATOMIC_RELAXED, __HIP_MEMORY_SCOPE_AGENT
#define XB_TMO      128
#define XB_XCNT(j)  (256  + 64 * (j))
#define XB_XSUB(j)  (1280 + 64 * (j))
#define XB_XGEN(j)  (2304 + 64 * (j))
#define XB_TOP      3328
#define XB_TOPGEN   3392
#define XCD_BAR_WORDS 3456
#define XB_SPIN_CAP (1u << 18)

__device__ __forceinline__ unsigned xb_ld(unsigned* p)              { return __hip_atomic_load(p, __ATOMIC_RELAXED, __HIP_MEMORY_SCOPE_AGENT); }
__device__ __forceinline__ unsigned xb_add(unsigned* p, unsigned v) { return __hip_atomic_fetch_add(p, v, __ATOMIC_RELAXED, __HIP_MEMORY_SCOPE_AGENT); }
__device__ __forceinline__ unsigned xb_xcc_id() { return (unsigned)__builtin_amdgcn_s_getreg((3 << 11) | 20) & 0xFu; }
#define XB_SPIN(cond, bar) do { unsigned _sp = 0; while (cond) { __builtin_amdgcn_s_sleep(1); \
    if ((++_sp & 255u) == 0u) { if (xb_ld(&(bar)[XB_TMO])) break; if (_sp > XB_SPIN_CAP) { atomicAdd(&(bar)[XB_TMO], 1u); break; } } } } while (0)

struct XcdBarrier {
    unsigned* bar; unsigned x;
    volatile LAS unsigned* st;
};

__device__ __forceinline__ XcdBarrier xcd_barrier_post(unsigned* bar, volatile LAS unsigned* st) {
    XcdBarrier b; b.bar = bar; b.x = xb_xcc_id(); b.st = st;
    if (threadIdx.x == 0) (void)xb_add(&bar[XB_XCNT(b.x)], 1u);
    return b;
}
__device__ __forceinline__ void xcd_barrier_complete(unsigned* bar, unsigned x, unsigned& nloc, unsigned& nx) {
    const unsigned G = gridDim.x * gridDim.y * gridDim.z;
    unsigned sum, cnt, mine, sp = 0u;
    for (;;) {
        sum = 0u; cnt = 0u; mine = 0u;
#pragma unroll
        for (unsigned j = 0; j < 16; ++j) { const unsigned c = xb_ld(&bar[XB_XCNT(j)]); sum += c; cnt += (c > 0u) ? 1u : 0u; mine = (j == x) ? c : mine; }
        if (sum == G) break;
        __builtin_amdgcn_s_sleep(1);
        if ((++sp & 255u) == 0u) { if (xb_ld(&bar[XB_TMO])) break; if (sp > XB_SPIN_CAP) { atomicAdd(&bar[XB_TMO], 1u); break; } }
    }
    nloc = mine > 0u ? mine : 1u; nx = cnt > 0u ? cnt : 1u;
}

__device__ __forceinline__ void xcd_barrier(const XcdBarrier& b) {
    asm volatile("s_waitcnt vmcnt(0)" ::: "memory");
    __syncthreads();
    if (threadIdx.x == 0) {
        unsigned* bar = b.bar;
        __builtin_amdgcn_s_waitcnt(0);
        unsigned nloc = b.st[0], nx = b.st[1];
        if (nloc == 0u) { xcd_barrier_complete(bar, b.x, nloc, nx); b.st[0] = nloc; b.st[1] = nx; }
        const unsigned old = xb_add(&bar[XB_XSUB(b.x)], 1u);
        const unsigned gen = old / nloc;
        if (old + 1u == (gen + 1u) * nloc) {
            __builtin_amdgcn_fence(__ATOMIC_RELEASE, "agent");
            asm volatile("s_waitcnt vmcnt(0)" ::: "memory");
            const unsigned og = xb_add(&bar[XB_TOP], 1u);
            const unsigned tg = og / nx;
            if (og + 1u == (tg + 1u) * nx) xb_add(&bar[XB_TOPGEN], 1u);
            else XB_SPIN(xb_ld(&bar[XB_TOPGEN]) == tg, bar);
            __builtin_amdgcn_fence(__ATOMIC_ACQUIRE, "agent");
            xb_add(&bar[XB_XGEN(b.x)], 1u);
            asm volatile("s_waitcnt vmcnt(0)" ::: "memory");
        } else {
            XB_SPIN(xb_ld(&bar[XB_XGEN(b.x)]) == gen, bar);
            __builtin_amdgcn_fence(__ATOMIC_ACQUIRE, "agent");
            asm volatile("s_waitcnt vmcnt(0)" ::: "memory");
        }
    }
    __syncthreads();
}

constexpr size_t WS_BAR = 6 * MiB;
struct Args { const float* in[41]; float* out; unsigned char* ws; };
typedef const __attribute__((address_space(4))) Args* KArgs;
__device__ __forceinline__ KArgs kargs() { KArgs p = (KArgs)__builtin_amdgcn_kernarg_segment_ptr(); asm volatile("" : "+s"(p)); return p; }

__global__ void __launch_bounds__(NWAVES * 64, 2) mega_fwd(Args a) {
    extern __shared__ __attribute__((aligned(16))) unsigned char lds_raw[];
    LAS unsigned char* lds = (LAS unsigned char*)lds_raw;
    cg::grid_group grid = cg::this_grid();
    const int G = gridDim.x, bid = blockIdx.x;
    volatile LAS unsigned* xst = (volatile LAS unsigned*)(lds + 131072);
    if (threadIdx.x < 2) xst[threadIdx.x] = 0u;
    __syncthreads();
    XcdBarrier xbar = xcd_barrier_post((unsigned*)(((KArgs)__builtin_amdgcn_kernarg_segment_ptr())->ws + WS_BAR), xst);
#define GSYNC() xcd_barrier(xbar)
#define GSYNC_CG() do { asm volatile("s_waitcnt vmcnt(0)" ::: "memory"); __syncthreads(); if (threadIdx.x == 0) __builtin_amdgcn_fence(__ATOMIC_RELEASE, "agent"); grid.sync(); __builtin_amdgcn_fence(__ATOMIC_ACQUIRE, "agent"); asm volatile("s_waitcnt vmcnt(0)" ::: "memory"); } while (0)

#define STA ((float*)(ws + WS_STA))
#define STB ((float*)(ws + WS_STB))
#define B1 ((bf16*)(ws + WS_B1))
#define B2 ((bf16*)(ws + WS_B2))
#define Rb ((bf16*)(ws + WS_R))
#define Kb (Rb + (size_t)T * 512)
#define Vb (Rb + (size_t)T * 1024)
#define Eb ((bf16*)(ws + WS_E))
#define Ab ((bf16*)(ws + WS_A))
#define KPb ((bf16*)(ws + WS_KP))
#define ZB ((bf16*)(dob + DO_ZB))
#define Xb ((bf16*)(dob + DO_X))
#define APb ((bf16*)(dob + DO_AP))
#define KKb ((bf16*)(dob + DO_KK))
#define Gb ((bf16*)(dob + DO_G))
#define RSb ((bf16*)(dob + DO_RS))
#define VSb ((bf16*)(dob + DO_VS))
#define BON ((float*)(ws + WS_BON))
#define HID ((bf16*)(ws + WS_HID))
#define PP ((bf16*)(ws + WS_PP))
#define YG ((bf16*)(ws + WS_YG))
#define PBF ((bf16*)(ws + WS_PBF))
#define EST ((f32x2*)(ws + WS_EST))
#define LB ((f32x2*)(ws + WS_S5P))
#define LBL (LB + 4096)
#define BB (LB + 8192)
#define PHASE_ARGS KArgs ka = kargs(); unsigned char* const ws = ka->ws; unsigned char* const dob = (unsigned char*)ka->out; (void)dob; int tid_p = threadIdx.x; asm volatile("" : "+v"(tid_p)); const int tid = tid_p, lane = tid & 63, wave = __builtin_amdgcn_readfirstlane(tid >> 6), gw = bid * NWAVES + wave, NGW = G * NWAVES; (void)gw; (void)NGW; (void)lane;
    {
        PHASE_ARGS
        LAS float* scr = (LAS float*)(lds + wave * 16384);
        constexpr int I_IN = 16 * (DIN / 32), I_SQ = 16 * 32, I_UP = 16 * 128, I_DN = 64 * 32, I_PR = 4 * 32;
        constexpr int NITEMS = I_IN + I_SQ + I_UP + I_DN + I_SQ + I_PR + 2 * I_SQ + I_UP + I_DN + I_SQ + I_PR;
        for (int it = gw; it < NITEMS; it += NGW) {
            int r = it;
            if (r < I_IN) { tr_item(ka->in[3], D, DIN, (bf16*)(ws + W_IN), 0, ka->in[2], scr, r, lane); continue; } r -= I_IN;
            if (r < I_SQ) { tr_item(ka->in[16], D, D, (bf16*)(ws + W_OUT), 0, nullptr, scr, r, lane); continue; } r -= I_SQ;
            if (r < I_UP) { tr_item(ka->in[18], D, FF, (bf16*)(ws + W_UP0), 0, ka->in[17], scr, r, lane); continue; } r -= I_UP;
            if (r < I_DN) { tr_item(ka->in[19], FF, D, (bf16*)(ws + W_DN0), 0, nullptr, scr, r, lane); continue; } r -= I_DN;
            if (r < I_SQ) { tr_item(ka->in[21], D, D, (bf16*)(ws + W_G0), 0, ka->in[20], scr, r, lane); continue; } r -= I_SQ;
            if (r < I_PR) { tr_item(ka->in[22], 256, D, (bf16*)(ws + W_P0), 0, nullptr, scr, r, lane); continue; } r -= I_PR;
            if (r < I_SQ) { tr_item(ka->in[32], D, D, (bf16*)(ws + W_GLU), 1, nullptr, scr, r, lane); continue; } r -= I_SQ;
            if (r < I_SQ) { tr_item(ka->in[33], D, D, (bf16*)(ws + W_GLU), 2, nullptr, scr, r, lane); continue; } r -= I_SQ;
            if (r < I_UP) { tr_item(ka->in[35], D, FF, (bf16*)(ws + W_UP1), 0, ka->in[34], scr, r, lane); continue; } r -= I_UP;
            if (r < I_DN) { tr_item(ka->in[36], FF, D, (bf16*)(ws + W_DN1), 0, nullptr, scr, r, lane); continue; } r -= I_DN;
            if (r < I_SQ) { tr_item(ka->in[38], D, D, (bf16*)(ws + W_G1), 0, ka->in[37], scr, r, lane); continue; } r -= I_SQ;
            tr_item(ka->in[39], 256, D, (bf16*)(ws + W_P1), 0, nullptr, scr, r, lane);
        }
        {
            bf16* WL = (bf16*)(ws + W_LORA); const float* wl = ka->in[6]; const float* al = ka->in[8]; const float* gl = ka->in[9];
            for (int i = bid * 512 + tid; i < 1536 * 256; i += G * 512) {
                const int n = i >> 8, k = i & 255; float v = 0.f;
                if (n < 512) { if (k < 64) v = wl[k * 512 + n]; }
                else if (n < 1024) { if (k >= 64 && k < 128) v = al[(k - 64) * 512 + (n - 512)]; }
                else { if (k >= 128) v = gl[(k - 128) * 512 + (n - 1024)]; }
                WL[i] = (bf16)(pk2(v, 0.f) & 0xffffu);
            }
        }
        for (int m = gw; m < T; m += NGW) {
            const f32x4* xr = (const f32x4*)(ka->in[0] + (size_t)m * D) + lane; f32x4 v[4]; float s = 0.f;
#pragma unroll
            for (int j = 0; j < 4; ++j) { v[j] = xr[64 * j]; s += (v[j][0] * v[j][0] + v[j][1] * v[j][1]) + (v[j][2] * v[j][2] + v[j][3] * v[j][3]); }
            s = wave_sum(s);
            u32x2* o8 = (u32x2*)(B1 + (size_t)m * D) + lane;
#pragma unroll
            for (int j = 0; j < 4; ++j) { u32x2 w; w.x = pk2(v[j][0], v[j][1]); w.y = pk2(v[j][2], v[j][3]); o8[64 * j] = w; }
            if (lane < 16) STA[(size_t)m * 32 + lane] = lane == 0 ? s : 0.f;
        }
        {
            const f32x4* ps = (const f32x4*)ka->in[1]; u32x2* pd = (u32x2*)PBF;
            for (int i = bid * 512 + tid; i < 2 * T * 256 / 4; i += G * 512) { const f32x4 v = ps[i]; u32x2 w; w.x = pk2(v[0], v[1]); w.y = pk2(v[2], v[3]); pd[i] = w; }
        }
        for (int i = bid * 512 + tid; i < 4096; i += G * 512) {
            const int g = i >> 6;
            const float step = expf(ka->in[26][g]); const float lre = fminf(ka->in[24][i], -1e-4f), lim = ka->in[25][i];
            const float x = lre * step, ang = lim * step; float sn, cs; sincosf(ang, &sn, &cs);
            const float er = expf(x); const float lbr = er * cs, lbi = er * sn;
            const float sh = sinf(0.5f * ang); const float nr = expm1f(x) * cs - 2.f * sh * sh, ni = lbi;
            const float d = lre * lre + lim * lim; const float qr = (nr * lre + ni * lim) / d, qi = (ni * lre - nr * lim) / d;
            LB[i] = (f32x2){lbr, lbi};
            float pr = lbr, pi = lbi;
#pragma unroll
            for (int q = 0; q < 7; ++q) { const float tr = pr * pr - pi * pi, ti = 2.f * pr * pi; pr = tr; pi = ti; }
            LBL[i] = (f32x2){pr, pi};
            for (int c = 0; c < 16; ++c) { const float br = ka->in[27][(size_t)i * 16 + c], bi = ka->in[28][(size_t)i * 16 + c]; BB[(size_t)i * 16 + c] = (f32x2){qr * br - qi * bi, qr * bi + qi * br}; }
        }
    }
    GSYNC_CG();

    {
        PHASE_ARGS
        pg8::Gemm g{B1, (const bf16*)(ws + W_IN), T, DIN, D}; pg8::StaticOrder S; S.init(T, DIN, G, bid);
        pg8::EpiB<0, 16> E{Rb, Xb, ZB, STA, nullptr, nullptr, 0};
        pg8::gemm_phase<pg8::EpiB<0, 16>, pg8::StaticOrder, true, true>(lds, g, S, E);
    }
    GSYNC();

    {
        PHASE_ARGS
        const float* mu = ka->in[4]; const float* cw = ka->in[15];
        for (int t = gw; t < T; t += NGW) {
            {
                const u32x2 x0 = *((const u32x2*)(Xb + (size_t)t * 256) + lane);
                u32x2 x1 = (u32x2){0u, 0u}; if (t > 0) x1 = *((const u32x2*)(Xb + (size_t)(t - 1) * 256) + lane);
                const f32x4 m4 = *((const f32x4*)(mu + 1536) + lane);
                float c[4] = {bflo(x0.x), bfhi(x0.x), bflo(x0.y), bfhi(x0.y)}, p[4] = {bflo(x1.x), bfhi(x1.x), bflo(x1.y), bfhi(x1.y)}, o[4];
#pragma unroll
                for (int e = 0; e < 4; ++e) { const float xs = c[e] + m4[e] * (p[e] - c[e]);
                    o[e] = lane < 16 ? tanhf(xs) : (lane < 32 ? xs : pg8::fsigmoid(xs)); }
                u32x2 w; w.x = pk2(o[0], o[1]); w.y = pk2(o[2], o[3]); *((u32x2*)(APb + (size_t)t * 256) + lane) = w;
            }
            {
                const bf16* z0 = ZB + (size_t)t * 1536; float bg[8], c0[8], x0[8], c1[8], x1[8], c2[8], x2[8];
                unpack8(*((const u32x4*)z0 + lane), bg); unpack8(*((const u32x4*)(z0 + 512) + lane), c0); unpack8(*((const u32x4*)(z0 + 1024) + lane), x0);
                const u32x4 zz = (u32x4){0u, 0u, 0u, 0u};
                unpack8(t > 0 ? *((const u32x4*)(z0 - 1536 + 512) + lane) : zz, c1); unpack8(t > 0 ? *((const u32x4*)(z0 - 1536 + 1024) + lane) : zz, x1);
                unpack8(t > 1 ? *((const u32x4*)(z0 - 3072 + 512) + lane) : zz, c2); unpack8(t > 1 ? *((const u32x4*)(z0 - 3072 + 1024) + lane) : zz, x2);
                float o[8];
#pragma unroll
                for (int e = 0; e < 8; ++e) { const int ch = 8 * lane + e; o[e] = bg[e] * (cw[ch] * (c0[e] * x0[e]) + cw[512 + ch] * (c1[e] * x1[e]) + cw[1024 + ch] * (c2[e] * x2[e])); }
                *((u32x4*)(B2 + (size_t)t * D + 512) + lane) = pack8(o);
            }
        }
    }
    GSYNC();

    {
        PHASE_ARGS
        pg8::Gemm g{APb, (const bf16*)(ws + W_LORA), T, 1536, 256}; pg8::StaticOrder S; S.init(T, 1536, G, bid);
        pg8::EpiB<1, 16> E{Eb, Ab, Gb, nullptr, ka->in[5], ka->in[7], 0};
        pg8::gemm_phase<pg8::EpiB<1, 16>, pg8::StaticOrder, true, true>(lds, g, S, E);
    }
    GSYNC();

    {
        PHASE_ARGS
        const float* mu = ka->in[4]; const float* k_k = ka->in[10]; const float* k_a = ka->in[11]; const float* r_k = ka->in[12];
        float mr[8], mk[8], mv[8], kk_[8], ka_[8], rk_[8];
#pragma unroll
        for (int e = 0; e < 8; ++e) { const int ch = 8 * lane + e; mr[e] = mu[ch]; mk[e] = mu[512 + ch]; mv[e] = mu[1024 + ch]; kk_[e] = k_k[ch]; ka_[e] = k_a[ch]; rk_[e] = r_k[ch]; }
        for (int t = gw; t < T; t += NGW) {
            float k0[8], k1[8], r0[8], r1[8], v0[8], v1[8], av[8];
            const u32x4 zz = (u32x4){0u, 0u, 0u, 0u};
            unpack8(*((const u32x4*)(Kb + (size_t)t * 512) + lane), k0); unpack8(t > 0 ? *((const u32x4*)(Kb + (size_t)(t - 1) * 512) + lane) : zz, k1);
            unpack8(*((const u32x4*)(Rb + (size_t)t * 512) + lane), r0); unpack8(t > 0 ? *((const u32x4*)(Rb + (size_t)(t - 1) * 512) + lane) : zz, r1);
            unpack8(*((const u32x4*)(Vb + (size_t)t * 512) + lane), v0); unpack8(t > 0 ? *((const u32x4*)(Vb + (size_t)(t - 1) * 512) + lane) : zz, v1);
            unpack8(*((const u32x4*)(Ab + (size_t)t * 512) + lane), av);
            float kp[8], kn[8], rs[8], vs[8]; float ss = 0.f, bs = 0.f;
#pragma unroll
            for (int e = 0; e < 8; ++e) {
                const float ks = k0[e] + mk[e] * (k1[e] - k0[e]); rs[e] = r0[e] + mr[e] * (r1[e] - r0[e]); vs[e] = v0[e] + mv[e] * (v1[e] - v0[e]);
                kn[e] = ks * kk_[e]; ss += kn[e] * kn[e];
                kp[e] = ks * (1.f + (av[e] - 1.f) * ka_[e]); bs += rs[e] * kp[e] * rk_[e];
            }
            ss = sum8(ss); bs = sum8(bs);
            const float inv = 1.f / fmaxf(sqrtf(ss), 1e-12f);
#pragma unroll
            for (int e = 0; e < 8; ++e) kn[e] *= inv;
            *((u32x4*)(KPb + (size_t)t * 512) + lane) = pack8(kp);
            *((u32x4*)(KKb + (size_t)t * 512) + lane) = pack8(kn);
            *((u32x4*)(RSb + (size_t)t * 512) + lane) = pack8(rs);
            *((u32x4*)(VSb + (size_t)t * 512) + lane) = pack8(vs);
            if ((lane & 7) == 0) BON[(size_t)t * 8 + (lane >> 3)] = bs;
        }
    }
    GSYNC();

    {
        PHASE_ARGS
        constexpr int TS = 68;
        LAS bf16* TA = (LAS bf16*)(lds + wave * 12288);
        LAS bf16* TBh = TA + 16 * TS; LAS bf16* TKh = TBh + 16 * TS; LAS bf16* TR = TKh + 16 * TS;
        LAS float* MAB = (LAS float*)(lds + wave * 12288 + 8704);
        LAS float* MAK = MAB + 256; LAS float* TM = MAK + 256;
        for (int u = gw; u < 8192; u += NGW) {
            const int c = u >> 3, h = u & 7; const size_t bo = (size_t)(c * 16) * 512 + h * 64;
            float at[16], bh[16], kh[16], rt[16];
            {
                unsigned short e_[16], k_[16], a_[16], p_[16], r_[16];
#pragma unroll
                for (int t = 0; t < 16; ++t) { const size_t o = bo + (size_t)t * 512 + lane; e_[t] = Eb[o]; k_[t] = KKb[o]; a_[t] = Ab[o]; p_[t] = KPb[o]; r_[t] = RSb[o]; }
                float g = 1.f;
#pragma unroll
                for (int t = 0; t < 16; ++t) {
                    const float w = __builtin_amdgcn_exp2f(-bflo(e_[t])); const float gp = g; g *= w; const float gi = 1.0f / g;
                    const float kkv = bflo(k_[t]);
                    at[t] = -kkv * gp; bh[t] = kkv * bflo(a_[t]) * gi; kh[t] = bflo(p_[t]) * gi; rt[t] = bflo(r_[t]) * g;
                    TA[t * TS + lane] = (bf16)(pk2(at[t], 0.f) & 0xffffu); TBh[t * TS + lane] = (bf16)(pk2(bh[t], 0.f) & 0xffffu);
                    TKh[t * TS + lane] = (bf16)(pk2(kh[t], 0.f) & 0xffffu); TR[t * TS + lane] = (bf16)(pk2(rt[t], 0.f) & 0xffffu);
                }
                bf16* bbp = KKb + bo + (size_t)(lane >> 2) * 512 + (lane & 3) * 16; bf16* kbp = KPb + bo + (size_t)(lane >> 2) * 512 + (lane & 3) * 16;
                float tb[8], tk[8];
#pragma unroll
                for (int hh = 0; hh < 2; ++hh) {
#pragma unroll
                    for (int e = 0; e < 8; ++e) { tb[e] = bh[hh * 8 + e] * g; tk[e] = kh[hh * 8 + e] * g; }
                    *(u32x4*)(bbp + hh * 8) = pack8(tb); *(u32x4*)(kbp + hh * 8) = pack8(tk);
                }
                ((float*)(Eb + bo + (size_t)(12 + (lane >> 5)) * 512))[lane & 31] = g;
#pragma unroll
                for (int t = 0; t < 16; ++t) RSb[bo + (size_t)t * 512 + lane] = (bf16)(pk2(rt[t], 0.f) & 0xffffu);
            }
            const int fr = lane & 15, q = lane >> 4;
            f32x4 mab = (f32x4){0.f, 0.f, 0.f, 0.f}, mak = mab, mbr = mab, mkr = mab;
#pragma unroll
            for (int m = 0; m < 4; ++m) {
                const bf16x4 fb = *(const LAS bf16x4*)(TBh + fr * TS + 16 * m + 4 * q), fk = *(const LAS bf16x4*)(TKh + fr * TS + 16 * m + 4 * q);
                const bf16x4 fa = *(const LAS bf16x4*)(TA + fr * TS + 16 * m + 4 * q), frr = *(const LAS bf16x4*)(TR + fr * TS + 16 * m + 4 * q);
                mab = __builtin_amdgcn_mfma_f32_16x16x16bf16_1k(fb, fa, mab, 0, 0, 0); mak = __builtin_amdgcn_mfma_f32_16x16x16bf16_1k(fk, fa, mak, 0, 0, 0);
                mbr = __builtin_amdgcn_mfma_f32_16x16x16bf16_1k(fb, frr, mbr, 0, 0, 0); mkr = __builtin_amdgcn_mfma_f32_16x16x16bf16_1k(fk, frr, mkr, 0, 0, 0);
            }
#pragma unroll
            for (int jj = 0; jj < 4; ++jj) { const int s = 4 * q + jj;
                MAB[s * 16 + fr] = s < fr ? mab[jj] : 0.f; MAK[s * 16 + fr] = s < fr ? mak[jj] : 0.f;
                mbr[jj] = s <= fr ? mbr[jj] : 0.f; mkr[jj] = s <= fr ? mkr[jj] : 0.f; }
            {
                u32x2 w1, w2; w1.x = pk2(mbr[0], mbr[1]); w1.y = pk2(mbr[2], mbr[3]); w2.x = pk2(mkr[0], mkr[1]); w2.y = pk2(mkr[2], mkr[3]);
                *(u32x2*)(Eb + bo + (size_t)(4 + (fr >> 2)) * 512 + (fr & 3) * 16 + 4 * q) = w1;
                *(u32x2*)(Eb + bo + (size_t)(8 + (fr >> 2)) * 512 + (fr & 3) * 16 + 4 * q) = w2;
            }
            float tm[16];
#pragma unroll
            for (int t = 0; t < 16; ++t) { float acc = (t == fr) ? 1.f : 0.f;
#pragma unroll
                for (int s = 0; s < t; ++s) acc += tm[s] * MAB[s * 16 + t];
                tm[t] = acc; }
            if (q == 0) {
#pragma unroll
                for (int t = 0; t < 16; ++t) TM[fr * 16 + t] = tm[t];
            }
#pragma unroll
            for (int t = 0; t < 16; ++t) { float acc = 0.f;
#pragma unroll
                for (int s = 0; s <= t; ++s) acc += TM[s * 16 + t] * at[s];
                Ab[bo + (size_t)t * 512 + lane] = (bf16)(pk2(acc, 0.f) & 0xffffu); }
            {
                float p4[4] = {0.f, 0.f, 0.f, 0.f};
#pragma unroll
                for (int s2 = 0; s2 < 16; ++s2) { const float mk_ = MAK[fr * 16 + s2];
#pragma unroll
                    for (int e = 0; e < 4; ++e) p4[e] += mk_ * TM[s2 * 16 + 4 * q + e]; }
#pragma unroll
                for (int e = 0; e < 4; ++e) { const int t = 4 * q + e; Eb[bo + (size_t)(t >> 2) * 512 + (t & 3) * 16 + fr] = (bf16)(pk2(p4[e], 0.f) & 0xffffu); }
            }
        }
    }
    GSYNC();

    {
        PHASE_ARGS
        constexpr int NC = T / 16, NS = 10, SLOT = 12288;
        if (bid < 8) {
            const int h = bid;
            if (wave >= 4) {
                const int lw = wave - 4;
                const unsigned char* srcb[3]; unsigned ldso[3];
#pragma unroll
                for (int i = 0; i < 3; ++i) { const int p = (lw * 3 + i) * 64 + lane; const int blk = p >> 7, seg = (p >> 3) & 15, part = p & 7;
                    const bf16* base = blk == 0 ? Ab : (blk == 1 ? RSb : (blk == 2 ? KKb : (blk == 3 ? KPb : (blk == 4 ? Eb : VSb))));
                    srcb[i] = (const unsigned char*)(base + (size_t)seg * 512 + h * 64) + part * 16; ldso[i] = (unsigned)((lw * 3 + i) * 1024); }
#define RW_ISSUE(cc_) do { const int cq = (cc_) < NC ? (cc_) : NC - 1; const unsigned so = (unsigned)(((cc_) % NS) * SLOT); _Pragma("unroll") for (int i = 0; i < 3; ++i) \
        __builtin_amdgcn_global_load_lds((const unsigned*)(srcb[i] + (size_t)cq * 16 * 1024), (LAS unsigned*)(lds + so + ldso[i]), 16, 0, 16); } while (0)
                for (int c = 0; c < NS - 1; ++c) RW_ISSUE(c);
                asm volatile("s_waitcnt vmcnt(21)" ::: "memory");
                __builtin_amdgcn_s_barrier();
                for (int c = 0; c < NC; ++c) {
                    RW_ISSUE(c + NS - 1);
                    asm volatile("s_waitcnt vmcnt(21)" ::: "memory");
                    __builtin_amdgcn_s_barrier();
                }
                asm volatile("s_waitcnt vmcnt(0)" ::: "memory");
#undef RW_ISSUE
            } else {
                const int fr = lane & 15, q = lane >> 4;
                f32x4 ST[4];
#pragma unroll
                for (int m = 0; m < 4; ++m) ST[m] = (f32x4){0.f, 0.f, 0.f, 0.f};
                bf16x4 cw[4], cr[4], cb[4], ck[4], cp, cmb, cmk, cv; f32x4 cg[4];
#define RW_READ(cc_) do { const LAS unsigned char* sl = lds + ((cc_) % NS) * SLOT; \
        _Pragma("unroll") for (int m = 0; m < 4; ++m) { \
            cw[m] = *(const LAS bf16x4*)(sl + 0 * 2048 + fr * 128 + (16 * m + 4 * q) * 2); \
            cr[m] = *(const LAS bf16x4*)(sl + 1 * 2048 + fr * 128 + (16 * m + 4 * q) * 2); \
            cb[m] = *(const LAS bf16x4*)(sl + 2 * 2048 + (4 * m + (fr >> 2)) * 128 + ((fr & 3) * 16 + 4 * q) * 2); \
            ck[m] = *(const LAS bf16x4*)(sl + 3 * 2048 + (4 * m + (fr >> 2)) * 128 + ((fr & 3) * 16 + 4 * q) * 2); \
            cg[m] = *(const LAS f32x4*)(sl + 4 * 2048 + (12 + ((16 * m + 4 * q) >> 5)) * 128 + ((16 * m + 4 * q) & 31) * 4); } \
        cp  = *(const LAS bf16x4*)(sl + 4 * 2048 + (0 + (fr >> 2)) * 128 + ((fr & 3) * 16 + 4 * q) * 2); \
        cmb = *(const LAS bf16x4*)(sl + 4 * 2048 + (4 + (fr >> 2)) * 128 + ((fr & 3) * 16 + 4 * q) * 2); \
        cmk = *(const LAS bf16x4*)(sl + 4 * 2048 + (8 + (fr >> 2)) * 128 + ((fr & 3) * 16 + 4 * q) * 2); \
        _Pragma("unroll") for (int jj = 0; jj < 4; ++jj) cv[jj] = *(const LAS short*)(sl + 5 * 2048 + (4 * q + jj) * 128 + (16 * wave + fr) * 2); } while (0)
                __builtin_amdgcn_s_barrier();
                RW_READ(0);
                float* yout = (float*)(ws + WS_Y) + (size_t)h * 64 + 16 * wave + fr;
                for (int c = 0; c < NC; ++c) {
                    const bf16x4 w0 = cw[0], w1 = cw[1], w2 = cw[2], w3 = cw[3], r0 = cr[0], r1 = cr[1], r2 = cr[2], r3 = cr[3];
                    const bf16x4 b0 = cb[0], b1 = cb[1], b2 = cb[2], b3 = cb[3], k0 = ck[0], k1 = ck[1], k2 = ck[2], k3 = ck[3];
                    const bf16x4 pp_ = cp, mb_ = cmb, mk_ = cmk, vv_ = cv; const f32x4 g0 = cg[0], g1 = cg[1], g2 = cg[2], g3 = cg[3];
                    if (c + 1 < NC) RW_READ(c + 1);
                    bf16x4 sb[4];
#pragma unroll
                    for (int m = 0; m < 4; ++m) { u32x2 t2; t2.x = pk2(ST[m][0], ST[m][1]); t2.y = pk2(ST[m][2], ST[m][3]); sb[m] = __builtin_bit_cast(bf16x4, t2); }
                    f32x4 ua = __builtin_amdgcn_mfma_f32_16x16x16bf16_1k(pp_, vv_, (f32x4){0.f, 0.f, 0.f, 0.f}, 0, 0, 0);
                    f32x4 ub = __builtin_amdgcn_mfma_f32_16x16x16bf16_1k(w0, sb[0], (f32x4){0.f, 0.f, 0.f, 0.f}, 0, 0, 0);
                    ua = __builtin_amdgcn_mfma_f32_16x16x16bf16_1k(w1, sb[1], ua, 0, 0, 0);
                    ub = __builtin_amdgcn_mfma_f32_16x16x16bf16_1k(w2, sb[2], ub, 0, 0, 0);
                    ua = __builtin_amdgcn_mfma_f32_16x16x16bf16_1k(w3, sb[3], ua, 0, 0, 0);
                    f32x4 ya = __builtin_amdgcn_mfma_f32_16x16x16bf16_1k(mk_, vv_, (f32x4){0.f, 0.f, 0.f, 0.f}, 0, 0, 0);
                    f32x4 yb = __builtin_amdgcn_mfma_f32_16x16x16bf16_1k(r0, sb[0], (f32x4){0.f, 0.f, 0.f, 0.f}, 0, 0, 0);
                    ya = __builtin_amdgcn_mfma_f32_16x16x16bf16_1k(r1, sb[1], ya, 0, 0, 0);
                    yb = __builtin_amdgcn_mfma_f32_16x16x16bf16_1k(r2, sb[2], yb, 0, 0, 0);
                    ya = __builtin_amdgcn_mfma_f32_16x16x16bf16_1k(r3, sb[3], ya, 0, 0, 0);
                    ST[0] = __builtin_amdgcn_mfma_f32_16x16x16bf16_1k(k0, vv_, ST[0] * g0, 0, 0, 0);
                    ST[1] = __builtin_amdgcn_mfma_f32_16x16x16bf16_1k(k1, vv_, ST[1] * g1, 0, 0, 0);
                    ST[2] = __builtin_amdgcn_mfma_f32_16x16x16bf16_1k(k2, vv_, ST[2] * g2, 0, 0, 0);
                    ST[3] = __builtin_amdgcn_mfma_f32_16x16x16bf16_1k(k3, vv_, ST[3] * g3, 0, 0, 0);
                    const f32x4 ut = ua + ub;
                    u32x2 u2; u2.x = pk2(ut[0], ut[1]); u2.y = pk2(ut[2], ut[3]); const bf16x4 ubf = __builtin_bit_cast(bf16x4, u2);
                    ST[0] = __builtin_amdgcn_mfma_f32_16x16x16bf16_1k(b0, ubf, ST[0], 0, 0, 0);
                    ST[1] = __builtin_amdgcn_mfma_f32_16x16x16bf16_1k(b1, ubf, ST[1], 0, 0, 0);
                    ST[2] = __builtin_amdgcn_mfma_f32_16x16x16bf16_1k(b2, ubf, ST[2], 0, 0, 0);
                    ST[3] = __builtin_amdgcn_mfma_f32_16x16x16bf16_1k(b3, ubf, ST[3], 0, 0, 0);
                    ya = __builtin_amdgcn_mfma_f32_16x16x16bf16_1k(mb_, ubf, ya, 0, 0, 0);
                    const f32x4 yt = ya + yb;
#pragma unroll
                    for (int jj = 0; jj < 4; ++jj) yout[(size_t)(c * 16 + 4 * q + jj) * 512] = yt[jj];
                    __builtin_amdgcn_s_barrier();
                }
#undef RW_READ
            }
        }
    }
    GSYNC();

    {
        PHASE_ARGS
        const float* lnw = ka->in[13]; const float* lnb = ka->in[14];
        float lw[8], lb[8];
#pragma unroll
        for (int e = 0; e < 8; ++e) { const int ch = 8 * lane + e; lw[e] = lnw[ch]; lb[e] = lnb[ch]; }
        const float* YRp = (const float*)(ws + WS_Y);
        for (int t = gw; t < T; t += NGW) {
            const f32x4 ya = *((const f32x4*)(YRp + (size_t)t * 512) + 2 * lane), yb = *((const f32x4*)(YRp + (size_t)t * 512) + 2 * lane + 1);
            float y[8] = {ya[0], ya[1], ya[2], ya[3], yb[0], yb[1], yb[2], yb[3]};
            float vs[8], gv[8];
            unpack8(*((const u32x4*)(VSb + (size_t)t * 512) + lane), vs);
            unpack8(*((const u32x4*)(Gb + (size_t)t * 512) + lane), gv);
            float s = 0.f;
#pragma unroll
            for (int e = 0; e < 8; ++e) s += y[e];
            const float mean = sum8(s) * (1.f / 64.f); float qv = 0.f;
#pragma unroll
            for (int e = 0; e < 8; ++e) { y[e] -= mean; qv += y[e] * y[e]; }
            const float rstd = rsqrtf(sum8(qv) * (1.f / 64.f) + 64e-5f);
            const float bon = BON[(size_t)t * 8 + (lane >> 3)];
            float o[8];
#pragma unroll
            for (int e = 0; e < 8; ++e) o[e] = (y[e] * rstd * lw[e] + lb[e] + bon * vs[e]) * gv[e];
            *((u32x4*)(B2 + (size_t)t * D) + lane) = pack8(o);
        }
    }
    GSYNC();

    {
        PHASE_ARGS
        pg8::Gemm g{B2, (const bf16*)(ws + W_OUT), T, D, D}; pg8::StaticOrder S; S.init(T, D, G, bid);
        pg8::EpiRes<0> E{ka->in[0], ka->out, B1, nullptr, STB, nullptr};
        pg8::gemm_phase<pg8::EpiRes<0>, pg8::StaticOrder, true, true>(lds, g, S, E);
    }
    GSYNC();
    {
        PHASE_ARGS
        pg8::Gemm g{B1, (const bf16*)(ws + W_UP0), T, FF, D}; pg8::StaticOrder S; S.init(T, FF, G, bid);
        pg8::EpiB<2, 16> E{HID, nullptr, nullptr, STB, nullptr, nullptr, FF};
        pg8::gemm_phase<pg8::EpiB<2, 16>, pg8::StaticOrder, true, true>(lds, g, S, E);
    }
    GSYNC();
    {
        PHASE_ARGS
        pg8::Gemm g{HID, (const bf16*)(ws + W_DN0), T, D, FF}; pg8::StaticOrder S; S.init(T, D, G, bid);
        pg8::EpiRes<0> E{ka->out, ka->out, B1, nullptr, STA, nullptr};
        pg8::gemm_phase<pg8::EpiRes<0>, pg8::StaticOrder, true, true>(lds, g, S, E);
    }
    GSYNC();
    {
        PHASE_ARGS
        pg8::Gemm g{PBF, (const bf16*)(ws + W_P0), T, D, 256}; pg8::StaticOrder S; S.init(T, D, G, bid);
        pg8::EpiB<3, 16> E{PP, nullptr, nullptr, nullptr, nullptr, nullptr, D};
        pg8::gemm_phase<pg8::EpiB<3, 16>, pg8::StaticOrder, true, true>(lds, g, S, E);
    }
    GSYNC();
    {
        PHASE_ARGS
        pg8::Gemm g{B1, (const bf16*)(ws + W_G0), T, D, D}; pg8::StaticOrder S; S.init(T, D, G, bid);
        pg8::EpiRes<1> E{ka->out, ka->out, B2, STA, STB, PP};
        pg8::gemm_phase<pg8::EpiRes<1>, pg8::StaticOrder, true, true>(lds, g, S, E);
    }
    GSYNC();

#pragma unroll 1
    for (int pass = 0; pass < 2; ++pass) {
        PHASE_ARGS
        LAS float* UT = (LAS float*)(lds + wave * 12800);
        LAS bf16* HS = (LAS bf16*)(lds + wave * 12800 + 8192);
        const float* gm = ka->in[23]; const float* dsk = ka->in[31];
        for (int u = gw; u < 8192; u += NGW) {
            const int ck = u >> 6, g = u & 63, t0 = ck * 128;
#pragma unroll
            for (int q = 0; q < 2; ++q) {
                const int tk = lane + 64 * q, t = t0 + tk;
                const f32x4* sp = (const f32x4*)(STB + (size_t)t * 32); const f32x4 s0 = sp[0], s1 = sp[1], s2 = sp[2], s3 = sp[3];
                const float ssq = ((s0[0] + s0[1]) + (s0[2] + s0[3])) + ((s1[0] + s1[1]) + (s1[2] + s1[3])) + ((s2[0] + s2[1]) + (s2[2] + s2[3])) + ((s3[0] + s3[1]) + (s3[2] + s3[3]));
                const float rs = rsqrtf(ssq * (1.f / 1024.f) + 1e-6f);
                float f0[8], f1[8]; unpack8(*(const u32x4*)(B2 + (size_t)t * D + 16 * g), f0); unpack8(*(const u32x4*)(B2 + (size_t)t * D + 16 * g + 8), f1);
                const f32x4 g0 = *(const f32x4*)(gm + 16 * g), g1 = *(const f32x4*)(gm + 16 * g + 4), g2 = *(const f32x4*)(gm + 16 * g + 8), g3 = *(const f32x4*)(gm + 16 * g + 12);
                LAS f32x4* ud = (LAS f32x4*)(UT + tk * 16);
                ud[0] = (f32x4){f0[0] * rs * g0[0], f0[1] * rs * g0[1], f0[2] * rs * g0[2], f0[3] * rs * g0[3]};
                ud[1] = (f32x4){f0[4] * rs * g1[0], f0[5] * rs * g1[1], f0[6] * rs * g1[2], f0[7] * rs * g1[3]};
                ud[2] = (f32x4){f1[0] * rs * g2[0], f1[1] * rs * g2[1], f1[2] * rs * g2[2], f1[3] * rs * g2[3]};
                ud[3] = (f32x4){f1[4] * rs * g3[0], f1[5] * rs * g3[1], f1[6] * rs * g3[2], f1[7] * rs * g3[3]};
            }
            f32x2 bb[16];
#pragma unroll
            for (int c = 0; c < 16; ++c) bb[c] = BB[((size_t)g * 64 + lane) * 16 + c];
            const f32x2 lam = LB[g * 64 + lane];
            f32x2 hst = (f32x2){0.f, 0.f};
            if (pass == 0) {
#pragma unroll 4
                for (int tk = 0; tk < 128; ++tk) {
                    const LAS f32x4* up = (const LAS f32x4*)(UT + tk * 16); f32x2 bu = (f32x2){0.f, 0.f};
#pragma unroll
                    for (int c4 = 0; c4 < 4; ++c4) { const f32x4 uu = up[c4];
#pragma unroll
                        for (int e = 0; e < 4; ++e) bu += bb[4 * c4 + e] * uu[e]; }
                    const float nr = lam[0] * hst[0] - lam[1] * hst[1] + bu[0], ni = lam[0] * hst[1] + lam[1] * hst[0] + bu[1];
                    hst = (f32x2){nr, ni};
                }
                EST[((size_t)ck * 64 + g) * 64 + lane] = hst;
            } else {
                const f32x2 lL = LBL[g * 64 + lane];
                for (int c2 = 0; c2 < ck; ++c2) { const f32x2 e = EST[((size_t)c2 * 64 + g) * 64 + lane];
                    const float nr = lL[0] * hst[0] - lL[1] * hst[1] + e[0], ni = lL[0] * hst[1] + lL[1] * hst[0] + e[1]; hst = (f32x2){nr, ni}; }
                bf16x8 cf[4];
                {
                    const int ch = lane & 15, qd = lane >> 4;
#pragma unroll
                    for (int ks = 0; ks < 4; ++ks) {
                        const float* src = (ks < 2 ? ka->in[29] : ka->in[30]) + ((size_t)g * 16 + ch) * 64 + (ks & 1) * 32 + qd * 8;
                        const f32x4 x0 = *(const f32x4*)src, x1 = *(const f32x4*)(src + 4); const float sg = ks < 2 ? 1.f : -1.f;
                        u32x4 w; w.x = pk2(sg * x0[0], sg * x0[1]); w.y = pk2(sg * x0[2], sg * x0[3]); w.z = pk2(sg * x1[0], sg * x1[1]); w.w = pk2(sg * x1[2], sg * x1[3]);
                        cf[ks] = __builtin_bit_cast(bf16x8, w);
                    }
                }
                const float dk = dsk[16 * g + (lane & 15)];
                for (int tg = 0; tg < 8; ++tg) {
#pragma unroll 4
                    for (int tl = 0; tl < 16; ++tl) {
                        const int tk = tg * 16 + tl;
                        const LAS f32x4* up = (const LAS f32x4*)(UT + tk * 16); f32x2 bu = (f32x2){0.f, 0.f};
#pragma unroll
                        for (int c4 = 0; c4 < 4; ++c4) { const f32x4 uu = up[c4];
#pragma unroll
                            for (int e = 0; e < 4; ++e) bu += bb[4 * c4 + e] * uu[e]; }
                        const float nr = lam[0] * hst[0] - lam[1] * hst[1] + bu[0], ni = lam[0] * hst[1] + lam[1] * hst[0] + bu[1];
                        hst = (f32x2){nr, ni};
                        const unsigned hw = pk2(nr, ni);
                        HS[tl * 136 + lane] = (bf16)(hw & 0xffffu); HS[tl * 136 + 64 + lane] = (bf16)(hw >> 16);
                    }
                    f32x4 acc = (f32x4){0.f, 0.f, 0.f, 0.f};
#pragma unroll
                    for (int ks = 0; ks < 4; ++ks) { const bf16x8 af = *(const LAS bf16x8*)(HS + (lane & 15) * 136 + ks * 32 + (lane >> 4) * 8);
                        acc = __builtin_amdgcn_mfma_f32_16x16x32_bf16(af, cf[ks], acc, 0, 0, 0); }
#pragma unroll
                    for (int j = 0; j < 4; ++j) { const int tk = tg * 16 + (lane >> 4) * 4 + j; const float uv = UT[tk * 16 + (lane & 15)];
                        const float y = gelu_tanh(acc[j] + dk * uv);
                        YG[(size_t)(t0 + tk) * D + 16 * g + (lane & 15)] = (bf16)(pk2(y, 0.f) & 0xffffu); }
                }
            }
        }
        GSYNC();
    }

    {
        PHASE_ARGS
        pg8::Gemm g{YG, (const bf16*)(ws + W_GLU), T, 2048, D}; pg8::StaticOrder S; S.init(T, 2048, G, bid);
        pg8::EpiRes<2> E{ka->out, ka->out, B1, nullptr, STA, nullptr};
        pg8::gemm_phase<pg8::EpiRes<2>, pg8::StaticOrder, true, true>(lds, g, S, E);
    }
    GSYNC();
    {
        PHASE_ARGS
        pg8::Gemm g{B1, (const bf16*)(ws + W_UP1), T, FF, D}; pg8::StaticOrder S; S.init(T, FF, G, bid);
        pg8::EpiB<2, 32> E{HID, nullptr, nullptr, STA, nullptr, nullptr, FF};
        pg8::gemm_phase<pg8::EpiB<2, 32>, pg8::StaticOrder, true, true>(lds, g, S, E);
    }
    GSYNC();
    {
        PHASE_ARGS
        pg8::Gemm g{HID, (const bf16*)(ws + W_DN1), T, D, FF}; pg8::StaticOrder S; S.init(T, D, G, bid);
        pg8::EpiRes<0> E{ka->out, ka->out, B1, nullptr, STB, nullptr};
        pg8::gemm_phase<pg8::EpiRes<0>, pg8::StaticOrder, true, true>(lds, g, S, E);
    }
    GSYNC();
    {
        PHASE_ARGS
        pg8::Gemm g{PBF + (size_t)T * 256, (const bf16*)(ws + W_P1), T, D, 256}; pg8::StaticOrder S; S.init(T, D, G, bid);
        pg8::EpiB<3, 16> E{PP, nullptr, nullptr, nullptr, nullptr, nullptr, D};
        pg8::gemm_phase<pg8::EpiB<3, 16>, pg8::StaticOrder, true, true>(lds, g, S, E);
    }
    GSYNC();
    {
        PHASE_ARGS
        pg8::Gemm g{B1, (const bf16*)(ws + W_G1), T, D, D}; pg8::StaticOrder S; S.init(T, D, G, bid);
        pg8::EpiRes<1> E{ka->out, ka->out, nullptr, STB, STA, PP};
        pg8::gemm_phase<pg8::EpiRes<1>, pg8::StaticOrder, true, true>(lds, g, S, E);
    }
    GSYNC();
    {
        PHASE_ARGS
        const float* gf = ka->in[40];
        for (int m = gw; m < T; m += NGW) {
            const f32x4* sp = (const f32x4*)(STA + (size_t)m * 32); const f32x4 s0 = sp[0], s1 = sp[1], s2 = sp[2], s3 = sp[3];
            const float ssq = ((s0[0] + s0[1]) + (s0[2] + s0[3])) + ((s1[0] + s1[1]) + (s1[2] + s1[3])) + ((s2[0] + s2[1]) + (s2[2] + s2[3])) + ((s3[0] + s3[1]) + (s3[2] + s3[3]));
            const float rs = rsqrtf(ssq * (1.f / 1024.f) + 1e-6f);
            f32x4* xr = (f32x4*)(ka->out + (size_t)m * D) + lane;
#pragma unroll
            for (int j = 0; j < 4; ++j) { const f32x4 v = xr[64 * j]; const f32x4 gg = *((const f32x4*)gf + lane + 64 * j); xr[64 * j] = v * rs * gg; }
        }
    }
#undef GSYNC
}

extern "C" void kernel_launch(void* const* d_in, const int* in_sizes, int n_in, void* d_out, int out_size, void* d_ws, size_t ws_size, hipStream_t stream) {
    static int grid = 0;
    if (grid == 0) {
        if (n_in != 41 || out_size != T * D || ws_size < WS_END) { fprintf(stderr, "kernel_launch: unexpected shapes (n_in %d, out %d, ws %zu)\n", n_in, out_size, ws_size); grid = -1; return; }
        int dev = 0, cus = 0, per_cu = 0;
        hipGetDevice(&dev); hipDeviceGetAttribute(&cus, hipDeviceAttributeMultiprocessorCount, dev);
        if (hipFuncSetAttribute((const void*)mega_fwd, hipFuncAttributeMaxDynamicSharedMemorySize, LDS_BYTES) != hipSuccess) { fprintf(stderr, "kernel_launch: hipFuncSetAttribute failed\n"); grid = -1; return; }
        if (hipOccupancyMaxActiveBlocksPerMultiprocessor(&per_cu, (const void*)mega_fwd, NWAVES * 64, LDS_BYTES) != hipSuccess || per_cu < 1) { fprintf(stderr, "kernel_launch: occupancy query says %d\n", per_cu); per_cu = 1; }
        (void)hipGetLastError();
        grid = cus;
    }
    if (grid < 0) return;
    if (hipMemsetAsync((char*)d_ws + WS_BAR, 0, 16384, stream) != hipSuccess) { fprintf(stderr, "kernel_launch: memset failed\n"); return; }
    Args a{};
    for (int i = 0; i < 41; ++i) a.in[i] = (const float*)d_in[i];
    a.out = (float*)d_out; a.ws = (unsigned char*)d_ws;
    void* params[] = {&a};
    hipError_t e = hipLaunchCooperativeKernel((const void*)mega_fwd, dim3(grid), dim3(NWAVES * 64), params, LDS_BYTES, stream);
    if (e != hipSuccess) fprintf(stderr, "kernel_launch: cooperative launch failed: %s (grid %d)\n", hipGetErrorString(e), grid);
}
```

```cpp
#include <hip/hip_runtime.h>
#include <hip/hip_cooperative_groups.h>
#include <cstdio>
#include <cstdint>
namespace pg8 {
#define PG8_LAS __attribute__((address_space(3)))
typedef unsigned short bf16_t;
typedef short bf16x8 __attribute__((ext_vector_type(8)));
typedef float f32x4 __attribute__((ext_vector_type(4)));
typedef unsigned u32x4 __attribute__((ext_vector_type(4)));
constexpr int BM = 256, BK = 64, HALF = 128, HTB = HALF * BK * 2  , STAGE_BYTES = 8 * HTB, NXCD = 8, WGM = 8;

__host__ __device__ __forceinline__ int lds_byte(int r, int c) { const int st = (r >> 4) * 2 + (c >> 5), rr = r & 15, cc = c & 31, ob = rr * 64 + cc * 2; return st * 1024 + (ob ^ (((ob >> 9) & 1) << 5)); }
__host__ __device__ __forceinline__ void stage_rc(int b, int& R, int& C) { const int st = b / 1024, sb = b % 1024, swz = sb ^ (((sb >> 9) & 1) << 5); R = (st >> 1) * 16 + swz / 64; C = (st & 1) * 32 + (swz % 64) / 2; }
__host__ __device__ __forceinline__ int perm32(int rho) { const int n = rho >> 4, i = rho & 15; return 8 * (i >> 2) + 4 * n + (i & 3); }

struct Unit { int pm, pn; };
struct Gemm { const bf16_t* A; const bf16_t* Bt; int M, N, K; };

struct StaticOrder {
    int nM, nN, nwg, G, c;
    __host__ __device__ void init(int M, int N, int G_, int c_) { nM = M / BM; nN = N / BM; nwg = nM * nN; G = G_; c = c_; }
    __host__ __device__ bool next(int i, Unit& u) const {
        const long L = (long)i * G + c; if (L >= nwg) return false;
        int wgid = (int)L; { const int q = nwg / NXCD, r = nwg % NXCD, xcd = wgid % NXCD, off = wgid / NXCD; wgid = (xcd < r ? xcd * (q + 1) : r * (q + 1) + (xcd - r) * q) + off; }
        const int nig = WGM * nN, gid = wgid / nig, fm = gid * WGM, gsz = (nM - fm) < WGM ? (nM - fm) : WGM;
        u.pm = fm + ((wgid % nig) % gsz); u.pn = (wgid % nig) / gsz; return true;
    }
    __device__ __forceinline__ void a_ready(const Unit&) const {}
    __device__ __forceinline__ void done(const Unit&) const {}
};

typedef float f32x2n __attribute__((ext_vector_type(2))); typedef __bf16 hbf2n __attribute__((ext_vector_type(2)));
__device__ __forceinline__ unsigned cvt_pk_bf16(float lo, float hi) { const f32x2n v = {lo, hi}; const hbf2n b = __builtin_convertvector(v, hbf2n); return __builtin_bit_cast(unsigned, b); }
typedef float f32x2 __attribute__((ext_vector_type(2)));

constexpr int TT = 16384;
typedef unsigned u32x2 __attribute__((ext_vector_type(2)));
__device__ __forceinline__ float fsigmoid(float x) { return __builtin_amdgcn_rcpf(1.0f + __expf(-x)); }
template <int NSL> __device__ __forceinline__ float row_rstd(const float* st, int r, int fq) {
    const f32x4 v = *(const f32x4*)(st + (size_t)r * 32 + 4 * fq);
    float s = (v[0] + v[1]) + (v[2] + v[3]);
    if (NSL == 32) { const f32x4 w = *(const f32x4*)(st + (size_t)r * 32 + 16 + 4 * fq); s += (w[0] + w[1]) + (w[2] + w[3]); }
    s += __shfl_xor(s, 16); s += __shfl_xor(s, 32);
    return rsqrtf(s * (1.0f / 1024.0f) + 1e-6f);
}
template <int MODE, int NSL> struct EpiB {
    static constexpr bool PERM = true, AFTER_DRAIN = false;
    bf16_t* o0; bf16_t* o1; bf16_t* o2; const float* st; const float* c0; const float* c1; int ldc;
    __device__ __forceinline__ void operator()(const f32x4 (&acc)[2][2][4][2], const Unit& u, int wr, int wc, int fr, int fq) const {
        const int row0 = u.pm * BM + wr * 64 + fr; const int pn = u.pn;
        bf16_t* base; int ld, colt; int kind = 0;
        if (MODE == 0) {
            if (pn < 6) { base = o0 + (size_t)(pn >> 1) * TT * 512; ld = 512; colt = (pn & 1) * 256; }
            else if (pn == 6) { base = o1; ld = 256; colt = 0; }
            else { base = o2; ld = 1536; colt = (pn - 7) * 256; }
        } else if (MODE == 1) {
            kind = pn >> 1; base = o0 + (size_t)kind * TT * 512; if (kind == 2) base = o2; ld = 512; colt = (pn & 1) * 256;
        } else { base = o0; ld = ldc; colt = pn * 256; }
        const int col0 = colt + wc * 32 + 8 * fq;
        const float* cbias = c0; if (kind == 1) cbias = c1; cbias += col0;
        f32x4 bv00 = (f32x4){0.f, 0.f, 0.f, 0.f}, bv01 = bv00, bv10 = bv00, bv11 = bv00;
        if (MODE == 1) { if (kind < 2) { bv00 = *(const f32x4*)(cbias); bv01 = *(const f32x4*)(cbias + 4); bv10 = *(const f32x4*)(cbias + HALF); bv11 = *(const f32x4*)(cbias + HALF + 4); } }
#pragma unroll
        for (int ai = 0; ai < 2; ++ai)
#pragma unroll
            for (int m = 0; m < 4; ++m) {
                const int r = row0 + ai * HALF + m * 16;
                float rs = 1.f;
                if (MODE == 0 || MODE == 2) rs = row_rstd<NSL>(st, r, fq);
                bf16_t* rowp = base + (size_t)r * ld + col0;
#pragma unroll
                for (int bj = 0; bj < 2; ++bj) {
                    f32x4 v0 = acc[ai][bj][m][0], v1 = acc[ai][bj][m][1];
                    if (MODE == 0) { v0 = v0 * rs; v1 = v1 * rs; }
                    if (MODE == 2) {
#pragma unroll
                        for (int e = 0; e < 4; ++e) { float a = fmaxf(v0[e], 0.f) * rs, b = fmaxf(v1[e], 0.f) * rs; v0[e] = a * a; v1[e] = b * b; }
                    }
                    if (MODE == 1) {
                        if (kind < 2) {
                            const float sc = kind == 0 ? (0.6065306597f * 1.4426950409f) : 1.0f;
                            v0 = v0 + (bj == 0 ? bv00 : bv10); v1 = v1 + (bj == 0 ? bv01 : bv11);
#pragma unroll
                            for (int e = 0; e < 4; ++e) { v0[e] = sc * fsigmoid(v0[e]); v1[e] = sc * fsigmoid(v1[e]); }
                        }
                    }
                    u32x4 w; w.x = cvt_pk_bf16(v0[0], v0[1]); w.y = cvt_pk_bf16(v0[2], v0[3]); w.z = cvt_pk_bf16(v1[0], v1[1]); w.w = cvt_pk_bf16(v1[2], v1[3]);
                    if (MODE == 1 && kind < 2) { const int cc_ = col0 + bj * HALF; *(u32x4*)(base + ((size_t)(cc_ >> 6) * TT + r) * 64 + (cc_ & 63)) = w; }
                    else *(u32x4*)(rowp + bj * HALF) = w;
                }
                if (m & 1) asm volatile("" ::: "memory");
            }
    }
};
template <int MODE> struct EpiRes {
    static constexpr bool PERM = false, AFTER_DRAIN = false;
    const float* base; float* out; bf16_t* hb; const float* st_in; float* st_out; const bf16_t* pp;
    __device__ __forceinline__ void operator()(const f32x4 (&acc)[2][2][4][2], const Unit& u, int wr, int wc, int fr, int fq) const {
        const int row0 = u.pm * BM + wr * 64 + fr;
#pragma unroll
        for (int ai = 0; ai < 2; ++ai)
#pragma unroll
            for (int m = 0; m < 4; ++m) {
                const int r = row0 + ai * HALF + m * 16;
                float rs = 1.f;
                if (MODE == 1) rs = row_rstd<16>(st_in, r, fq);
                float ss = 0.f;
#pragma unroll
                for (int bj = 0; bj < (MODE == 2 ? 1 : 2); ++bj)
#pragma unroll
                    for (int n = 0; n < 2; ++n) {
                        const int c = (MODE == 2 ? u.pn * 128 : u.pn * BM + bj * HALF) + wc * 32 + n * 16 + 4 * fq;
                        const size_t off = (size_t)r * 1024 + c;
                        const f32x4 b = *(const f32x4*)(base + off);
                        f32x4 v = acc[ai][bj][m][n];
                        if (MODE == 1) {
                            const u32x2 pw = *(const u32x2*)(pp + off);
                            const float p0 = __uint_as_float(pw.x << 16), p1 = __uint_as_float(pw.x & 0xffff0000u), p2 = __uint_as_float(pw.y << 16), p3 = __uint_as_float(pw.y & 0xffff0000u);
                            v[0] = p0 * fsigmoid(v[0] * rs); v[1] = p1 * fsigmoid(v[1] * rs); v[2] = p2 * fsigmoid(v[2] * rs); v[3] = p3 * fsigmoid(v[3] * rs);
                        }
                        if (MODE == 2) {
                            const f32x4 g = acc[ai][1][m][n];
#pragma unroll
                            for (int e = 0; e < 4; ++e) v[e] = v[e] * fsigmoid(g[e]);
                        }
                        const f32x4 o = b + v;
                        *(f32x4*)(out + off) = o;
                        if (hb) { u32x2 w; w.x = cvt_pk_bf16(o[0], o[1]); w.y = cvt_pk_bf16(o[2], o[3]); *(u32x2*)(hb + off) = w; }
                        ss += (o[0] * o[0] + o[1] * o[1]) + (o[2] * o[2] + o[3] * o[3]);
                    }
                ss += __shfl_xor(ss, 16); ss += __shfl_xor(ss, 32);
                if (fq == 0) st_out[(size_t)r * 32 + u.pn * 4 + wc] = ss;
                asm volatile("" ::: "memory");
            }
    }
};

template <class Epi, class Sched, bool ALIGN_EPI = false, bool SP2 = false>
__device__ __forceinline__ void gemm_phase(PG8_LAS unsigned char* lds, const Gemm g, const Sched& S, const Epi& E) {
    int tid_l = threadIdx.x; asm volatile("" : "+v"(tid_l)); const int tid = tid_l, wid = __builtin_amdgcn_readfirstlane(tid >> 6), lane = tid & 63, wr = wid >> 2, wc = wid & 3, fr = lane & 15, fq = lane >> 4;
    int K = g.K; asm volatile("" : "+s"(K)); const int nt = K / BK;
    unsigned voffA[2], voffB[2];
#pragma unroll
    for (int i = 0; i < 2; ++i) { int R, C; stage_rc(tid * 16 + i * 8192, R, C); const int Rb = Epi::PERM ? ((R & ~31) + perm32(R & 31)) : R;
        voffA[i] = (unsigned)(R * K + C) * 2u; voffB[i] = (unsigned)(Rb * K + C) * 2u; }
    const size_t kstep = (size_t)(BK * 2);
    const size_t hstep = (size_t)HALF * K * 2;
    const size_t tstep = 2 * hstep;
    const unsigned ldsw = (unsigned)wid * 1024u;
    const int aoff = lds_byte(wr * 64 + fr, fq * 8), boff = lds_byte(wc * 32 + fr, fq * 8);
#define PG8_SA(b, h) (((b) * 2 + (h)) * HTB)
#define PG8_SB(b, h) ((4 + (b) * 2 + (h)) * HTB)
#define PG8_STAGE(bufoff, gbase, voff) do { _Pragma("unroll") for (int _i = 0; _i < 2; ++_i) \
        __builtin_amdgcn_global_load_lds((const unsigned*)((const char*)(gbase) + (voff)[_i]), (PG8_LAS unsigned*)(lds + (bufoff) + ldsw + _i * 8192), 16, 0, 0); } while (0)
#define PG8_LDA(dst, b, h) do { _Pragma("unroll") for (int m = 0; m < 4; ++m) _Pragma("unroll") for (int k = 0; k < 2; ++k) dst[m][k] = *(const PG8_LAS bf16x8*)(lds + PG8_SA(b, h) + aoff + m * 2048 + k * 1024); } while (0)
#define PG8_LDB(dst, b, h) do { _Pragma("unroll") for (int n = 0; n < 2; ++n) _Pragma("unroll") for (int k = 0; k < 2; ++k) dst[n][k] = *(const PG8_LAS bf16x8*)(lds + PG8_SB(b, h) + boff + n * 2048 + k * 1024); } while (0)
#define PG8_MMA(ai, bj, At, Bt) do { __builtin_amdgcn_s_setprio(1); _Pragma("unroll") for (int m = 0; m < 4; ++m) _Pragma("unroll") for (int n = 0; n < 2; ++n) _Pragma("unroll") for (int k = 0; k < 2; ++k) \
        acc[ai][bj][m][n] = __builtin_amdgcn_mfma_f32_16x16x32_bf16(Bt[n][k], At[m][k], acc[ai][bj][m][n], 0, 0, 0); __builtin_amdgcn_s_setprio(0); } while (0)
#define PG8_WAIT_V(n) asm volatile("s_waitcnt vmcnt(" #n ")" ::: "memory")
#define PG8_WAIT_L(n) asm volatile("s_waitcnt lgkmcnt(" #n ")" ::: "memory")
#define PG8_BAR __builtin_amdgcn_s_barrier()
#define PG8_SCHED __builtin_amdgcn_sched_barrier(0)
    Unit cur, nxt; int ui = 0;
    if (!S.next(0, cur)) return;
    f32x4 acc[2][2][4][2];
#pragma unroll
    for (int a = 0; a < 2; ++a)
#pragma unroll
        for (int b = 0; b < 2; ++b)
#pragma unroll
            for (int m = 0; m < 4; ++m)
#pragma unroll
                for (int n = 0; n < 2; ++n) acc[a][b][m][n] = (f32x4){0.f, 0.f, 0.f, 0.f};
    bf16x8 At[4][2], B0[2][2], B1[2][2];
    const char* cA = (const char*)g.A + (size_t)cur.pm * tstep; const char* cB = (const char*)g.Bt + (size_t)cur.pn * tstep;
    S.a_ready(cur);
    if constexpr (SP2) {
        PG8_STAGE(PG8_SB(0, 0), cB, voffB); PG8_STAGE(PG8_SB(0, 1), cB + hstep, voffB); PG8_STAGE(PG8_SA(0, 0), cA, voffA); PG8_STAGE(PG8_SA(0, 1), cA + hstep, voffA);
        if (wr == 1) PG8_BAR;
        PG8_WAIT_V(2); PG8_BAR;
        PG8_STAGE(PG8_SB(1, 0), cB + kstep, voffB); PG8_STAGE(PG8_SA(1, 0), cA + kstep, voffA); PG8_STAGE(PG8_SB(1, 1), cB + hstep + kstep, voffB);
        PG8_WAIT_V(6); PG8_BAR;
    } else {
        PG8_STAGE(PG8_SB(0, 0), cB, voffB); PG8_STAGE(PG8_SA(0, 0), cA, voffA); PG8_STAGE(PG8_SB(0, 1), cB + hstep, voffB); PG8_STAGE(PG8_SA(0, 1), cA + hstep, voffA);
        if (wr == 1) PG8_BAR;
        PG8_WAIT_V(4); PG8_BAR;
        PG8_STAGE(PG8_SB(1, 0), cB + kstep, voffB); PG8_STAGE(PG8_SA(1, 0), cA + kstep, voffA); PG8_STAGE(PG8_SB(1, 1), cB + hstep + kstep, voffB);
        PG8_WAIT_V(6); PG8_BAR;
    }
    for (;;) {
        const bool has_next = S.next(ui + 1, nxt);
        const char* nA = has_next ? (const char*)g.A + (size_t)nxt.pm * tstep : cA; const char* nB = has_next ? (const char*)g.Bt + (size_t)nxt.pn * tstep : cB;
        for (int t = 0; t < nt; t += 2) {
            const bool last = (t == nt - 2);
            const char* a1 = cA + (size_t)(t + 1) * kstep;
            const char* a2 = last ? nA : cA + (size_t)(t + 2) * kstep; const char* b2 = last ? nB : cB + (size_t)(t + 2) * kstep;
            const char* a3 = a2 + kstep; const char* b3 = b2 + kstep;
            if (last && has_next) S.a_ready(nxt);
            if constexpr (SP2) {
            PG8_LDB(B0, 0, 0); PG8_LDB(B1, 0, 1); PG8_SCHED; PG8_LDA(At, 0, 0); PG8_STAGE(PG8_SA(1, 1), a1 + hstep, voffA);
            PG8_WAIT_V(8); PG8_WAIT_L(0); PG8_BAR; PG8_MMA(0, 0, At, B0); PG8_MMA(0, 1, At, B1); PG8_BAR; PG8_SCHED;
            PG8_LDA(At, 0, 1); PG8_STAGE(PG8_SB(0, 0), b2, voffB); PG8_STAGE(PG8_SB(0, 1), b2 + hstep, voffB); PG8_STAGE(PG8_SA(0, 0), a2, voffA);
            PG8_WAIT_V(8); PG8_WAIT_L(0); PG8_BAR; PG8_MMA(1, 0, At, B0); PG8_MMA(1, 1, At, B1); PG8_BAR; PG8_SCHED;
            PG8_LDB(B0, 1, 0); PG8_LDB(B1, 1, 1); PG8_SCHED; PG8_LDA(At, 1, 0); PG8_STAGE(PG8_SA(0, 1), a2 + hstep, voffA);
            PG8_WAIT_V(8); PG8_WAIT_L(0); PG8_BAR; PG8_MMA(0, 0, At, B0); PG8_MMA(0, 1, At, B1); PG8_BAR; PG8_SCHED;
            PG8_LDA(At, 1, 1); PG8_STAGE(PG8_SB(1, 0), b3, voffB); PG8_STAGE(PG8_SB(1, 1), b3 + hstep, voffB); PG8_STAGE(PG8_SA(1, 0), a3, voffA);
            PG8_WAIT_V(8); PG8_WAIT_L(0); PG8_BAR; PG8_MMA(1, 0, At, B0); PG8_MMA(1, 1, At, B1); PG8_BAR; PG8_SCHED;
            } else {
            PG8_LDB(B0, 0, 0); PG8_SCHED; PG8_LDA(At, 0, 0); PG8_STAGE(PG8_SA(1, 1), a1 + hstep, voffA);
            PG8_WAIT_L(8); PG8_BAR; PG8_WAIT_L(0); PG8_MMA(0, 0, At, B0); PG8_BAR; PG8_SCHED;
            PG8_LDB(B1, 0, 1); PG8_STAGE(PG8_SB(0, 0), b2, voffB);
            PG8_BAR; PG8_WAIT_L(0); PG8_MMA(0, 1, At, B1); PG8_BAR;
            PG8_LDA(At, 0, 1); PG8_STAGE(PG8_SA(0, 0), a2, voffA);
            PG8_BAR; PG8_WAIT_L(0); PG8_MMA(1, 0, At, B0); PG8_BAR; PG8_SCHED;
            PG8_STAGE(PG8_SB(0, 1), b2 + hstep, voffB);
            PG8_WAIT_V(6); PG8_BAR; PG8_MMA(1, 1, At, B1); PG8_BAR;
            PG8_LDB(B0, 1, 0); PG8_SCHED; PG8_LDA(At, 1, 0); PG8_STAGE(PG8_SA(0, 1), a2 + hstep, voffA);
            PG8_WAIT_L(8); PG8_BAR; PG8_WAIT_L(0); PG8_MMA(0, 0, At, B0); PG8_BAR; PG8_SCHED;
            PG8_LDB(B1, 1, 1); PG8_STAGE(PG8_SB(1, 0), b3, voffB);
            PG8_BAR; PG8_WAIT_L(0); PG8_MMA(0, 1, At, B1); PG8_BAR;
            PG8_LDA(At, 1, 1); PG8_STAGE(PG8_SA(1, 0), a3, voffA);
            PG8_BAR; PG8_WAIT_L(0); PG8_MMA(1, 0, At, B0); PG8_BAR; PG8_SCHED;
            PG8_STAGE(PG8_SB(1, 1), b3 + hstep, voffB);
            PG8_WAIT_V(6); PG8_BAR; PG8_MMA(1, 1, At, B1); PG8_BAR;
            }
        }
        if constexpr (ALIGN_EPI) { if (wr == 0) PG8_BAR; }
        if constexpr (!Epi::AFTER_DRAIN) { E(acc, cur, wr, wc, fr, fq); S.done(cur); }
        if (!has_next) break;
#pragma unroll
        for (int a = 0; a < 2; ++a)
#pragma unroll
            for (int b = 0; b < 2; ++b)
#pragma unroll
                for (int m = 0; m < 4; ++m)
#pragma unroll
                    for (int n = 0; n < 2; ++n) acc[a][b][m][n] = (f32x4){0.f, 0.f, 0.f, 0.f};
        cur = nxt; cA = nA; cB = nB; ++ui;
        if constexpr (ALIGN_EPI) { if (wr == 1) PG8_BAR; }
    }
    PG8_WAIT_V(0);
    if constexpr (!ALIGN_EPI) { if (wr == 0) PG8_BAR; }
    PG8_BAR;
    if constexpr (Epi::AFTER_DRAIN) { E.fused(acc, cur, wr, wc, fr, fq, lds, wid, lane); S.done(cur); }
#undef PG8_SA
#undef PG8_SB
#undef PG8_STAGE
#undef PG8_LDA
#undef PG8_LDB
#undef PG8_MMA
#undef PG8_WAIT_V
#undef PG8_WAIT_L
#undef PG8_BAR
#undef PG8_SCHED
}
}

namespace cg = cooperative_groups;
#define LAS __attribute__((address_space(3)))
typedef unsigned short bf16;
typedef float f32x4 __attribute__((ext_vector_type(4)));
typedef float f32x2 __attribute__((ext_vector_type(2)));
typedef unsigned u32x4 __attribute__((ext_vector_type(4)));
typedef unsigned u32x2 __attribute__((ext_vector_type(2)));
typedef short bf16x8 __attribute__((ext_vector_type(8)));
typedef short bf16x4 __attribute__((ext_vector_type(4)));

constexpr int T = 16384, D = 1024, FF = 4096, DIN = 3328, NWAVES = 8;
constexpr int LDS_BYTES = 147456;
constexpr size_t KiB = 1024, MiB = 1024 * 1024;
constexpr size_t WS_BON = 0;
constexpr size_t WS_EST = 1 * MiB;
constexpr size_t WS_S5P = 5 * MiB;
constexpr size_t WS_STA = 8 * MiB, WS_STB = 10 * MiB;
constexpr size_t W_IN = 12 * MiB, W_LORA = W_IN + 6656 * KiB, W_OUT = W_LORA + 768 * KiB, W_UP0 = W_OUT + 2 * MiB, W_DN0 = W_UP0 + 8 * MiB, W_G0 = W_DN0 + 8 * MiB,
                 W_P0 = W_G0 + 2 * MiB, W_GLU = W_P0 + 512 * KiB, W_UP1 = W_GLU + 4 * MiB, W_DN1 = W_UP1 + 8 * MiB, W_G1 = W_DN1 + 8 * MiB, W_P1 = W_G1 + 2 * MiB;
static_assert(W_P1 + 512 * KiB <= 64 * MiB, "weights");
constexpr size_t WS_PBF = 64 * MiB;
constexpr size_t WS_B1 = 80 * MiB, WS_B2 = 112 * MiB;
constexpr size_t WS_R = 144 * MiB, WS_E = 192 * MiB, WS_A = 208 * MiB, WS_KP = 224 * MiB;
constexpr size_t WS_HID = 112 * MiB;
constexpr size_t WS_PP = 144 * MiB, WS_YG = 144 * MiB;
constexpr size_t WS_END = 240 * MiB;
constexpr size_t DO_ZB = 0, DO_X = 48 * MiB, DO_AP = 56 * MiB, DO_KK = 48 * MiB, DO_G = 0, DO_RS = 16 * MiB, DO_VS = 32 * MiB;
constexpr size_t WS_Y = 144 * MiB;

__device__ __forceinline__ size_t hm8(int t, int lane) { return ((size_t)(lane >> 3) * T + t) * 64 + (lane & 7) * 8; }
__device__ __forceinline__ float bflo(unsigned w) { return __uint_as_float(w << 16); }
__device__ __forceinline__ float bfhi(unsigned w) { return __uint_as_float(w & 0xffff0000u); }
__device__ __forceinline__ unsigned pk2(float lo, float hi) { return pg8::cvt_pk_bf16(lo, hi); }
__device__ __forceinline__ void unpack8(const u32x4 w, float (&f)[8]) { f[0] = bflo(w.x); f[1] = bfhi(w.x); f[2] = bflo(w.y); f[3] = bfhi(w.y); f[4] = bflo(w.z); f[5] = bfhi(w.z); f[6] = bflo(w.w); f[7] = bfhi(w.w); }
__device__ __forceinline__ u32x4 pack8(const float (&f)[8]) { u32x4 w; w.x = pk2(f[0], f[1]); w.y = pk2(f[2], f[3]); w.z = pk2(f[4], f[5]); w.w = pk2(f[6], f[7]); return w; }
__device__ __forceinline__ float wave_sum(float v) {
#pragma unroll
    for (int o = 1; o < 64; o <<= 1) v += __shfl_xor(v, o);
    return v;
}
__device__ __forceinline__ float sum8(float v) { v += __shfl_xor(v, 1); v += __shfl_xor(v, 2); v += __shfl_xor(v, 4); return v; }
template <int CTRL, int RM> __device__ __forceinline__ float dpp0(float x) {
    return __builtin_bit_cast(float, __builtin_amdgcn_update_dpp(0, __builtin_bit_cast(int, x), CTRL, RM, 0xf, false));
}
__device__ __forceinline__ float wave_sum_dpp(float x) {
    x += dpp0<0xB1, 0xf>(x);
    x += dpp0<0x4E, 0xf>(x);
    x += dpp0<0x141, 0xf>(x);
    x += dpp0<0x140, 0xf>(x);
    x += dpp0<0x142, 0xa>(x);
    x += dpp0<0x143, 0xc>(x);
    return __builtin_bit_cast(float, __builtin_amdgcn_readlane(__builtin_bit_cast(int, x), 63));
}
__device__ __forceinline__ float gelu_tanh(float x) {
    const float u = 0.7978845608f * (x + 0.044715f * x * x * x);
    const float e = __expf(2.0f * u);
    const float th = 1.0f - 2.0f * __builtin_amdgcn_rcpf(e + 1.0f);
    return 0.5f * x * (1.0f + th);
}

__device__ __forceinline__ void tr_item(const float* W, int K, int N, bf16* WT, int mode, const float* gain, LAS float* scr, int item, int lane) {
    const int nblk = N / 32, kb = item / nblk, nb = item % nblk, k0 = 64 * kb, n0 = 32 * nb;
#pragma unroll 8
    for (int i = 0; i < 32; ++i) { const int kk = 2 * i + (lane >> 5); float v = W[(size_t)(k0 + kk) * N + n0 + (lane & 31)]; if (gain) v *= gain[k0 + kk]; scr[kk * 33 + (lane & 31)] = v; }
    asm volatile("s_waitcnt lgkmcnt(0)" ::: "memory");
    const int c = lane & 7;
#pragma unroll
    for (int j = 0; j < 4; ++j) { const int n = (lane >> 3) + 8 * j; const LAS float* s = scr + (8 * c) * 33 + n;
        u32x4 o; o.x = pk2(s[0 * 33], s[1 * 33]); o.y = pk2(s[2 * 33], s[3 * 33]); o.z = pk2(s[4 * 33], s[5 * 33]); o.w = pk2(s[6 * 33], s[7 * 33]);
        const int ng = n0 + n; const int row = mode == 0 ? ng : (256 * (ng >> 7) + (ng & 127) + (mode == 2 ? 128 : 0));
        *(u32x4*)(WT + (size_t)row * K + k0 + 8 * c) = o; }
    asm volatile("s_waitcnt lgkmcnt(0)" ::: "memory");
}

#define RLX_AGENT __ATOMIC_RELAXED, __HIP_MEMORY_SCOPE_AGENT
#define XB_TMO      128
#define XB_XCNT(j)  (256  + 64 * (j))
#define XB_XSUB(j)  (1280 + 64 * (j))
#define XB_XGEN(j)  (2304 + 64 * (j))
#define XB_TOP      3328
#define XB_TOPGEN   3392
#define XCD_BAR_WORDS 3456
#define XB_SPIN_CAP (1u << 18)

__device__ __forceinline__ unsigned xb_ld(unsigned* p)              { return __hip_atomic_load(p, __ATOMIC_RELAXED, __HIP_MEMORY_SCOPE_AGENT); }
__device__ __forceinline__ unsigned xb_add(unsigned* p, unsigned v) { return __hip_atomic_fetch_add(p, v, __ATOMIC_RELAXED, __HIP_MEMORY_SCOPE_AGENT); }
__device__ __forceinline__ unsigned xb_xcc_id() { return (unsigned)__builtin_amdgcn_s_getreg((3 << 11) | 20) & 0xFu; }
#define XB_SPIN(cond, bar) do { unsigned _sp = 0; while (cond) { __builtin_amdgcn_s_sleep(1); \
    if ((++_sp & 255u) == 0u) { if (xb_ld(&(bar)[XB_TMO])) break; if (_sp > XB_SPIN_CAP) { atomicAdd(&(bar)[XB_TMO], 1u); break; } } } } while (0)

struct XcdBarrier {
    unsigned* bar; unsigned x;
    volatile LAS unsigned* st;
};

__device__ __forceinline__ XcdBarrier xcd_barrier_post(unsigned* bar, volatile LAS unsigned* st) {
    XcdBarrier b; b.bar = bar; b.x = xb_xcc_id(); b.st = st;
    if (threadIdx.x == 0) (void)xb_add(&bar[XB_XCNT(b.x)], 1u);
    return b;
}
__device__ __forceinline__ void xcd_barrier_complete(unsigned* bar, unsigned x, unsigned& nloc, unsigned& nx) {
    const unsigned G = gridDim.x * gridDim.y * gridDim.z;
    unsigned sum, cnt, mine, sp = 0u;
    for (;;) {
        sum = 0u; cnt = 0u; mine = 0u;
#pragma unroll
        for (unsigned j = 0; j < 16; ++j) { const unsigned c = xb_ld(&bar[XB_XCNT(j)]); sum += c; cnt += (c > 0u) ? 1u : 0u; mine = (j == x) ? c : mine; }
        if (sum == G) break;
        __builtin_amdgcn_s_sleep(1);
        if ((++sp & 255u) == 0u) { if (xb_ld(&bar[XB_TMO])) break; if (sp > XB_SPIN_CAP) { atomicAdd(&bar[XB_TMO], 1u); break; } }
    }
    nloc = mine > 0u ? mine : 1u; nx = cnt > 0u ? cnt : 1u;
}

__device__ __forceinline__ void xcd_barrier(const XcdBarrier& b) {
    asm volatile("s_waitcnt vmcnt(0)" ::: "memory");
    __syncthreads();
    if (threadIdx.x == 0) {
        unsigned* bar = b.bar;
        __builtin_amdgcn_s_waitcnt(0);
        unsigned nloc = b.st[0], nx = b.st[1];
        if (nloc == 0u) { xcd_barrier_complete(bar, b.x, nloc, nx); b.st[0] = nloc; b.st[1] = nx; }
        const unsigned old = xb_add(&bar[XB_XSUB(b.x)], 1u);
        const unsigned gen = old / nloc;
        if (old + 1u == (gen + 1u) * nloc) {
            __builtin_amdgcn_fence(__ATOMIC_RELEASE, "agent");
            asm volatile("s_waitcnt vmcnt(0)" ::: "memory");
            const unsigned og = xb_add(&bar[XB_TOP], 1u);
            const unsigned tg = og / nx;
            if (og + 1u == (tg + 1u) * nx) xb_add(&bar[XB_TOPGEN], 1u);
            else XB_SPIN(xb_ld(&bar[XB_TOPGEN]) == tg, bar);
            __builtin_amdgcn_fence(__ATOMIC_ACQUIRE, "agent");
            xb_add(&bar[XB_XGEN(b.x)], 1u);
            asm volatile("s_waitcnt vmcnt(0)" ::: "memory");
        } else {
            XB_SPIN(xb_ld(&bar[XB_XGEN(b.x)]) == gen, bar);
            __builtin_amdgcn_fence(__ATOMIC_ACQUIRE, "agent");
            asm volatile("s_waitcnt vmcnt(0)" ::: "memory");
        }
    }
    __syncthreads();
}

constexpr size_t WS_BAR = 6 * MiB;
struct Args { const float* in[41]; float* out; unsigned char* ws; };
typedef const __attribute__((address_space(4))) Args* KArgs;
__device__ __forceinline__ KArgs kargs() { KArgs p = (KArgs)__builtin_amdgcn_kernarg_segment_ptr(); asm volatile("" : "+s"(p)); return p; }

__global__ void __launch_bounds__(NWAVES * 64, 2) mega_fwd(Args a) {
    extern __shared__ __attribute__((aligned(16))) unsigned char lds_raw[];
    LAS unsigned char* lds = (LAS unsigned char*)lds_raw;
    cg::grid_group grid = cg::this_grid();
    const int G = gridDim.x, bid = blockIdx.x;
    volatile LAS unsigned* xst = (volatile LAS unsigned*)(lds + 131072);
    if (threadIdx.x < 2) xst[threadIdx.x] = 0u;
    __syncthreads();
    XcdBarrier xbar = xcd_barrier_post((unsigned*)(((KArgs)__builtin_amdgcn_kernarg_segment_ptr())->ws + WS_BAR), xst);
#define GSYNC() xcd_barrier(xbar)
#define GSYNC_CG() do { asm volatile("s_waitcnt vmcnt(0)" ::: "memory"); __syncthreads(); if (threadIdx.x == 0) __builtin_amdgcn_fence(__ATOMIC_RELEASE, "agent"); grid.sync(); __builtin_amdgcn_fence(__ATOMIC_ACQUIRE, "agent"); asm volatile("s_waitcnt vmcnt(0)" ::: "memory"); } while (0)

#define STA ((float*)(ws + WS_STA))
#define STB ((float*)(ws + WS_STB))
#define B1 ((bf16*)(ws + WS_B1))
#define B2 ((bf16*)(ws + WS_B2))
#define Rb ((bf16*)(ws + WS_R))
#define Kb (Rb + (size_t)T * 512)
#define Vb (Rb + (size_t)T * 1024)
#define Eb ((bf16*)(ws + WS_E))
#define Ab ((bf16*)(ws + WS_A))
#define KPb ((bf16*)(ws + WS_KP))
#define ZB ((bf16*)(dob + DO_ZB))
#define Xb ((bf16*)(dob + DO_X))
#define APb ((bf16*)(dob + DO_AP))
#define KKb ((bf16*)(dob + DO_KK))
#define Gb ((bf16*)(dob + DO_G))
#define RSb ((bf16*)(dob + DO_RS))
#define VSb ((bf16*)(dob + DO_VS))
#define BON ((float*)(ws + WS_BON))
#define HID ((bf16*)(ws + WS_HID))
#define PP ((bf16*)(ws + WS_PP))
#define YG ((bf16*)(ws + WS_YG))
#define PBF ((bf16*)(ws + WS_PBF))
#define EST ((f32x2*)(ws + WS_EST))
#define LB ((f32x2*)(ws + WS_S5P))
#define LBL (LB + 4096)
#define BB (LB + 8192)
#define PHASE_ARGS KArgs ka = kargs(); unsigned char* const ws = ka->ws; unsigned char* const dob = (unsigned char*)ka->out; (void)dob; int tid_p = threadIdx.x; asm volatile("" : "+v"(tid_p)); const int tid = tid_p, lane = tid & 63, wave = __builtin_amdgcn_readfirstlane(tid >> 6), gw = bid * NWAVES + wave, NGW = G * NWAVES; (void)gw; (void)NGW; (void)lane;
    {
        PHASE_ARGS
        LAS float* scr = (LAS float*)(lds + wave * 16384);
        constexpr int I_IN = 16 * (DIN / 32), I_SQ = 16 * 32, I_UP = 16 * 128, I_DN = 64 * 32, I_PR = 4 * 32;
        constexpr int NITEMS = I_IN + I_SQ + I_UP + I_DN + I_SQ + I_PR + 2 * I_SQ + I_UP + I_DN + I_SQ + I_PR;
        for (int it = gw; it < NITEMS; it += NGW) {
            int r = it;
            if (r < I_IN) { tr_item(ka->in[3], D, DIN, (bf16*)(ws + W_IN), 0, ka->in[2], scr, r, lane); continue; } r -= I_IN;
            if (r < I_SQ) { tr_item(ka->in[16], D, D, (bf16*)(ws + W_OUT), 0, nullptr, scr, r, lane); continue; } r -= I_SQ;
            if (r < I_UP) { tr_item(ka->in[18], D, FF, (bf16*)(ws + W_UP0), 0, ka->in[17], scr, r, lane); continue; } r -= I_UP;
            if (r < I_DN) { tr_item(ka->in[19], FF, D, (bf16*)(ws + W_DN0), 0, nullptr, scr, r, lane); continue; } r -= I_DN;
            if (r < I_SQ) { tr_item(ka->in[21], D, D, (bf16*)(ws + W_G0), 0, ka->in[20], scr, r, lane); continue; } r -= I_SQ;
            if (r < I_PR) { tr_item(ka->in[22], 256, D, (bf16*)(ws + W_P0), 0, nullptr, scr, r, lane); continue; } r -= I_PR;
            if (r < I_SQ) { tr_item(ka->in[32], D, D, (bf16*)(ws + W_GLU), 1, nullptr, scr, r, lane); continue; } r -= I_SQ;
            if (r < I_SQ) { tr_item(ka->in[33], D, D, (bf16*)(ws + W_GLU), 2, nullptr, scr, r, lane); continue; } r -= I_SQ;
            if (r < I_UP) { tr_item(ka->in[35], D, FF, (bf16*)(ws + W_UP1), 0, ka->in[34], scr, r, lane); continue; } r -= I_UP;
            if (r < I_DN) { tr_item(ka->in[36], FF, D, (bf16*)(ws + W_DN1), 0, nullptr, scr, r, lane); continue; } r -= I_DN;
            if (r < I_SQ) { tr_item(ka->in[38], D, D, (bf16*)(ws + W_G1), 0, ka->in[37], scr, r, lane); continue; } r -= I_SQ;
            tr_item(ka->in[39], 256, D, (bf16*)(ws + W_P1), 0, nullptr, scr, r, lane);
        }
        {
            bf16* WL = (bf16*)(ws + W_LORA); const float* wl = ka->in[6]; const float* al = ka->in[8]; const float* gl = ka->in[9];
            for (int i = bid * 512 + tid; i < 1536 * 256; i += G * 512) {
                const int n = i >> 8, k = i & 255; float v = 0.f;
                if (n < 512) { if (k < 64) v = wl[k * 512 + n]; }
                else if (n < 1024) { if (k >= 64 && k < 128) v = al[(k - 64) * 512 + (n - 512)]; }
                else { if (k >= 128) v = gl[(k - 128) * 512 + (n - 1024)]; }
                WL[i] = (bf16)(pk2(v, 0.f) & 0xffffu);
            }
        }
        for (int m = gw; m < T; m += NGW) {
            const f32x4* xr = (const f32x4*)(ka->in[0] + (size_t)m * D) + lane; f32x4 v[4]; float s = 0.f;
#pragma unroll
            for (int j = 0; j < 4; ++j) { v[j] = xr[64 * j]; s += (v[j][0] * v[j][0] + v[j][1] * v[j][1]) + (v[j][2] * v[j][2] + v[j][3] * v[j][3]); }
            s = wave_sum(s);
            u32x2* o8 = (u32x2*)(B1 + (size_t)m * D) + lane;
#pragma unroll
            for (int j = 0; j < 4; ++j) { u32x2 w; w.x = pk2(v[j][0], v[j][1]); w.y = pk2(v[j][2], v[j][3]); o8[64 * j] = w; }
            if (lane < 16) STA[(size_t)m * 32 + lane] = lane == 0 ? s : 0.f;
        }
        {
            const f32x4* ps = (const f32x4*)ka->in[1]; u32x2* pd = (u32x2*)PBF;
            for (int i = bid * 512 + tid; i < 2 * T * 256 / 4; i += G * 512) { const f32x4 v = ps[i]; u32x2 w; w.x = pk2(v[0], v[1]); w.y = pk2(v[2], v[3]); pd[i] = w; }
        }
        for (int i = bid * 512 + tid; i < 4096; i += G * 512) {
            const int g = i >> 6;
            const float step = expf(ka->in[26][g]); const float lre = fminf(ka->in[24][i], -1e-4f), lim = ka->in[25][i];
            const float x = lre * step, ang = lim * step; float sn, cs; sincosf(ang, &sn, &cs);
            const float er = expf(x); const float lbr = er * cs, lbi = er * sn;
            const float sh = sinf(0.5f * ang); const float nr = expm1f(x) * cs - 2.f * sh * sh, ni = lbi;
            const float d = lre * lre + lim * lim; const float qr = (nr * lre + ni * lim) / d, qi = (ni * lre - nr * lim) / d;
            LB[i] = (f32x2){lbr, lbi};
            float pr = lbr, pi = lbi;
#pragma unroll
            for (int q = 0; q < 7; ++q) { const float tr = pr * pr - pi * pi, ti = 2.f * pr * pi; pr = tr; pi = ti; }
            LBL[i] = (f32x2){pr, pi};
            for (int c = 0; c < 16; ++c) { const float br = ka->in[27][(size_t)i * 16 + c], bi = ka->in[28][(size_t)i * 16 + c]; BB[(size_t)i * 16 + c] = (f32x2){qr * br - qi * bi, qr * bi + qi * br}; }
        }
    }
    GSYNC_CG();

    {
        PHASE_ARGS
        pg8::Gemm g{B1, (const bf16*)(ws + W_IN), T, DIN, D}; pg8::StaticOrder S; S.init(T, DIN, G, bid);
        pg8::EpiB<0, 16> E{Rb, Xb, ZB, STA, nullptr, nullptr, 0};
        pg8::gemm_phase<pg8::EpiB<0, 16>, pg8::StaticOrder, true, true>(lds, g, S, E);
    }
    GSYNC();

    {
        PHASE_ARGS
        const float* mu = ka->in[4]; const float* cw = ka->in[15];
        for (int t = gw; t < T; t += NGW) {
            {
                const u32x2 x0 = *((const u32x2*)(Xb + (size_t)t * 256) + lane);
                u32x2 x1 = (u32x2){0u, 0u}; if (t > 0) x1 = *((const u32x2*)(Xb + (size_t)(t - 1) * 256) + lane);
                const f32x4 m4 = *((const f32x4*)(mu + 1536) + lane);
                float c[4] = {bflo(x0.x), bfhi(x0.x), bflo(x0.y), bfhi(x0.y)}, p[4] = {bflo(x1.x), bfhi(x1.x), bflo(x1.y), bfhi(x1.y)}, o[4];
#pragma unroll
                for (int e = 0; e < 4; ++e) { const float xs = c[e] + m4[e] * (p[e] - c[e]);
                    o[e] = lane < 16 ? tanhf(xs) : (lane < 32 ? xs : pg8::fsigmoid(xs)); }
                u32x2 w; w.x = pk2(o[0], o[1]); w.y = pk2(o[2], o[3]); *((u32x2*)(APb + (size_t)t * 256) + lane) = w;
            }
            {
                const bf16* z0 = ZB + (size_t)t * 1536; float bg[8], c0[8], x0[8], c1[8], x1[8], c2[8], x2[8];
                unpack8(*((const u32x4*)z0 + lane), bg); unpack8(*((const u32x4*)(z0 + 512) + lane), c0); unpack8(*((const u32x4*)(z0 + 1024) + lane), x0);
                const u32x4 zz = (u32x4){0u, 0u, 0u, 0u};
                unpack8(t > 0 ? *((const u32x4*)(z0 - 1536 + 512) + lane) : zz, c1); unpack8(t > 0 ? *((const u32x4*)(z0 - 1536 + 1024) + lane) : zz, x1);
                unpack8(t > 1 ? *((const u32x4*)(z0 - 3072 + 512) + lane) : zz, c2); unpack8(t > 1 ? *((const u32x4*)(z0 - 3072 + 1024) + lane) : zz, x2);
                float o[8];
#pragma unroll
                for (int e = 0; e < 8; ++e) { const int ch = 8 * lane + e; o[e] = bg[e] * (cw[ch] * (c0[e] * x0[e]) + cw[512 + ch] * (c1[e] * x1[e]) + cw[1024 + ch] * (c2[e] * x2[e])); }
                *((u32x4*)(B2 + (size_t)t * D + 512) + lane) = pack8(o);
            }
        }
    }
    GSYNC();

    {
        PHASE_ARGS
        pg8::Gemm g{APb, (const bf16*)(ws + W_LORA), T, 1536, 256}; pg8::StaticOrder S; S.init(T, 1536, G, bid);
        pg8::EpiB<1, 16> E{Eb, Ab, Gb, nullptr, ka->in[5], ka->in[7], 0};
        pg8::gemm_phase<pg8::EpiB<1, 16>, pg8::StaticOrder, true, true>(lds, g, S, E);
    }
    GSYNC();

    {
        PHASE_ARGS
        const float* mu = ka->in[4]; const float* k_k = ka->in[10]; const float* k_a = ka->in[11]; const float* r_k = ka->in[12];
        float mr[8], mk[8], mv[8], kk_[8], ka_[8], rk_[8];
#pragma unroll
        for (int e = 0; e < 8; ++e) { const int ch = 8 * lane + e; mr[e] = mu[ch]; mk[e] = mu[512 + ch]; mv[e] = mu[1024 + ch]; kk_[e] = k_k[ch]; ka_[e] = k_a[ch]; rk_[e] = r_k[ch]; }
        for (int t = gw; t < T; t += NGW) {
            float k0[8], k1[8], r0[8], r1[8], v0[8], v1[8], av[8];
            const u32x4 zz = (u32x4){0u, 0u, 0u, 0u};
            unpack8(*((const u32x4*)(Kb + (size_t)t * 512) + lane), k0); unpack8(t > 0 ? *((const u32x4*)(Kb + (size_t)(t - 1) * 512) + lane) : zz, k1);
            unpack8(*((const u32x4*)(Rb + (size_t)t * 512) + lane), r0); unpack8(t > 0 ? *((const u32x4*)(Rb + (size_t)(t - 1) * 512) + lane) : zz, r1);
            unpack8(*((const u32x4*)(Vb + (size_t)t * 512) + lane), v0); unpack8(t > 0 ? *((const u32x4*)(Vb + (size_t)(t - 1) * 512) + lane) : zz, v1);
            unpack8(*(const u32x4*)(Ab + hm8(t, lane)), av);
            float kp[8], kn[8], rs[8], vs[8]; float ss = 0.f, bs = 0.f;
#pragma unroll
            for (int e = 0; e < 8; ++e) {
                const float ks = k0[e] + mk[e] * (k1[e] - k0[e]); rs[e] = r0[e] + mr[e] * (r1[e] - r0[e]); vs[e] = v0[e] + mv[e] * (v1[e] - v0[e]);
                kn[e] = ks * kk_[e]; ss += kn[e] * kn[e];
                kp[e] = ks * (1.f + (av[e] - 1.f) * ka_[e]); bs += rs[e] * kp[e] * rk_[e];
            }
            ss = sum8(ss); bs = sum8(bs);
            const float inv = 1.f / fmaxf(sqrtf(ss), 1e-12f);
#pragma unroll
            for (int e = 0; e < 8; ++e) kn[e] *= inv;
            *(u32x4*)(KPb + hm8(t, lane)) = pack8(kp);
            *(u32x4*)(KKb + hm8(t, lane)) = pack8(kn);
            *(u32x4*)(RSb + hm8(t, lane)) = pack8(rs);
            *(u32x4*)(VSb + hm8(t, lane)) = pack8(vs);
            if ((lane & 7) == 0) BON[(size_t)t * 8 + (lane >> 3)] = bs;
        }
    }
    GSYNC();

    {
        PHASE_ARGS
        constexpr int TS = 68;
        LAS bf16* TA = (LAS bf16*)(lds + wave * 12288);
        LAS bf16* TBh = TA + 16 * TS; LAS bf16* TKh = TBh + 16 * TS; LAS bf16* TR = TKh + 16 * TS;
        LAS float* MAB = (LAS float*)(lds + wave * 12288 + 8704);
        LAS float* MAK = MAB + 256; LAS float* TM = MAK + 256;
        for (int u = gw; u < 8192; u += NGW) {
            const int c = u >> 3, h = u & 7; const size_t bo = ((size_t)h * T + c * 16) * 64;
            float at[16], bh[16], kh[16], rt[16];
            {
                unsigned short e_[16], k_[16], a_[16], p_[16], r_[16];
#pragma unroll
                for (int t = 0; t < 16; ++t) { const size_t o = bo + (size_t)t * 64 + lane; e_[t] = Eb[o]; k_[t] = KKb[o]; a_[t] = Ab[o]; p_[t] = KPb[o]; r_[t] = RSb[o]; }
                float g = 1.f;
#pragma unroll
                for (int t = 0; t < 16; ++t) {
                    const float w = __builtin_amdgcn_exp2f(-bflo(e_[t])); const float gp = g; g *= w; const float gi = 1.0f / g;
                    const float kkv = bflo(k_[t]);
                    at[t] = -kkv * gp; bh[t] = kkv * bflo(a_[t]) * gi; kh[t] = bflo(p_[t]) * gi; rt[t] = bflo(r_[t]) * g;
                    TA[t * TS + lane] = (bf16)(pk2(at[t], 0.f) & 0xffffu); TBh[t * TS + lane] = (bf16)(pk2(bh[t], 0.f) & 0xffffu);
                    TKh[t * TS + lane] = (bf16)(pk2(kh[t], 0.f) & 0xffffu); TR[t * TS + lane] = (bf16)(pk2(rt[t], 0.f) & 0xffffu);
                }
                bf16* bbp = KKb + bo + (size_t)(lane >> 2) * 64 + (lane & 3) * 16; bf16* kbp = KPb + bo + (size_t)(lane >> 2) * 64 + (lane & 3) * 16;
                float tb[8], tk[8];
#pragma unroll
                for (int hh = 0; hh < 2; ++hh) {
#pragma unroll
                    for (int e = 0; e < 8; ++e) { tb[e] = bh[hh * 8 + e] * g; tk[e] = kh[hh * 8 + e] * g; }
                    *(u32x4*)(bbp + hh * 8) = pack8(tb); *(u32x4*)(kbp + hh * 8) = pack8(tk);
                }
                ((float*)(Eb + bo + (size_t)(12 + (lane >> 5)) * 64))[lane & 31] = g;
#pragma unroll
                for (int t = 0; t < 16; ++t) RSb[bo + (size_t)t * 64 + lane] = (bf16)(pk2(rt[t], 0.f) & 0xffffu);
            }
            const int fr = lane & 15, q = lane >> 4;
            f32x4 mab = (f32x4){0.f, 0.f, 0.f, 0.f}, mak = mab, mbr = mab, mkr = mab;
#pragma unroll
            for (int m = 0; m < 4; ++m) {
                const bf16x4 fb = *(const LAS bf16x4*)(TBh + fr * TS + 16 * m + 4 * q), fk = *(const LAS bf16x4*)(TKh + fr * TS + 16 * m + 4 * q);
                const bf16x4 fa = *(const LAS bf16x4*)(TA + fr * TS + 16 * m + 4 * q), frr = *(const LAS bf16x4*)(TR + fr * TS + 16 * m + 4 * q);
                mab = __builtin_amdgcn_mfma_f32_16x16x16bf16_1k(fb, fa, mab, 0, 0, 0); mak = __builtin_amdgcn_mfma_f32_16x16x16bf16_1k(fk, fa, mak, 0, 0, 0);
                mbr = __builtin_amdgcn_mfma_f32_16x16x16bf16_1k(fb, frr, mbr, 0, 0, 0); mkr = __builtin_amdgcn_mfma_f32_16x16x16bf16_1k(fk, frr, mkr, 0, 0, 0);
            }
#pragma unroll
            for (int jj = 0; jj < 4; ++jj) { const int s = 4 * q + jj;
                MAB[s * 16 + fr] = s < fr ? mab[jj] : 0.f; MAK[s * 16 + fr] = s < fr ? mak[jj] : 0.f;
                mbr[jj] = s <= fr ? mbr[jj] : 0.f; mkr[jj] = s <= fr ? mkr[jj] : 0.f; }
            {
                u32x2 w1, w2; w1.x = pk2(mbr[0], mbr[1]); w1.y = pk2(mbr[2], mbr[3]); w2.x = pk2(mkr[0], mkr[1]); w2.y = pk2(mkr[2], mkr[3]);
                *(u32x2*)(Eb + bo + (size_t)(4 + (fr >> 2)) * 64 + (fr & 3) * 16 + 4 * q) = w1;
                *(u32x2*)(Eb + bo + (size_t)(8 + (fr >> 2)) * 64 + (fr & 3) * 16 + 4 * q) = w2;
            }
            float tm[16];
#pragma unroll
            for (int t = 0; t < 16; ++t) { float acc = (t == fr) ? 1.f : 0.f;
#pragma unroll
                for (int s = 0; s < t; ++s) acc += tm[s] * MAB[s * 16 + t];
                tm[t] = acc; }
            if (q == 0) {
#pragma unroll
                for (int t = 0; t < 16; ++t) TM[fr * 16 + t] = tm[t];
            }
#pragma unroll
            for (int t = 0; t < 16; ++t) { float acc = 0.f;
#pragma unroll
                for (int s = 0; s <= t; ++s) acc += TM[s * 16 + t] * at[s];
                Ab[bo + (size_t)t * 64 + lane] = (bf16)(pk2(acc, 0.f) & 0xffffu); }
            {
                float p4[4] = {0.f, 0.f, 0.f, 0.f};
#pragma unroll
                for (int s2 = 0; s2 < 16; ++s2) { const float mk_ = MAK[fr * 16 + s2];
#pragma unroll
                    for (int e = 0; e < 4; ++e) p4[e] += mk_ * TM[s2 * 16 + 4 * q + e]; }
#pragma unroll
                for (int e = 0; e < 4; ++e) { const int t = 4 * q + e; Eb[bo + (size_t)(t >> 2) * 64 + (t & 3) * 16 + fr] = (bf16)(pk2(p4[e], 0.f) & 0xffffu); }
            }
        }
    }
    GSYNC();

    {
        PHASE_ARGS
        constexpr int NC = T / 16, NS = 10, SLOT = 12288;
        if (bid < 8) {
            const int h = bid;
            if (wave >= 4) {
                const int lw = wave - 4;
                const unsigned char* srcb[3]; unsigned ldso[3];
#pragma unroll
                for (int i = 0; i < 3; ++i) { const int p = (lw * 3 + i) * 64 + lane; const int blk = p >> 7, seg = (p >> 3) & 15, part = (p & 7) ^ ((seg >> 1) & 7);
                    const bf16* base = blk == 0 ? Ab : (blk == 1 ? RSb : (blk == 2 ? KKb : (blk == 3 ? KPb : (blk == 4 ? Eb : VSb))));
                    srcb[i] = (const unsigned char*)(base + ((size_t)h * T + seg) * 64) + part * 16; ldso[i] = (unsigned)((lw * 3 + i) * 1024); }
#define RW_ISSUE(cc_) do { const int cq = (cc_) < NC ? (cc_) : NC - 1; const unsigned so = (unsigned)(((cc_) % NS) * SLOT); _Pragma("unroll") for (int i = 0; i < 3; ++i) \
        __builtin_amdgcn_global_load_lds((const unsigned*)(srcb[i] + (size_t)cq * 2048), (LAS unsigned*)(lds + so + ldso[i]), 16, 0, 0); } while (0)
                for (int c = 0; c < NS - 1; ++c) RW_ISSUE(c);
                asm volatile("s_waitcnt vmcnt(21)" ::: "memory");
                __builtin_amdgcn_s_barrier();
                for (int c = 0; c < NC; ++c) {
                    RW_ISSUE(c + NS - 1);
                    asm volatile("s_waitcnt vmcnt(21)" ::: "memory");
                    __builtin_amdgcn_s_barrier();
                }
                asm volatile("s_waitcnt vmcnt(0)" ::: "memory");
#undef RW_ISSUE
            } else {
                const int fr = lane & 15, q = lane >> 4;
                f32x4 ST[4];
#pragma unroll
                for (int m = 0; m < 4; ++m) ST[m] = (f32x4){0.f, 0.f, 0.f, 0.f};
                bf16x4 cw[4], cr[4], cb[4], ck[4], cp, cmb, cmk, cv; f32x4 cg[4];
#define RW_SW(seg_, pc_) ((((pc_) ^ (((seg_) >> 1) & 7))) * 16)
#define RW_READ(cc_) do { const LAS unsigned char* sl = lds + ((cc_) % NS) * SLOT; \
        _Pragma("unroll") for (int m = 0; m < 4; ++m) { const int sg_ = 4 * m + (fr >> 2), gs_ = 12 + ((16 * m + 4 * q) >> 5); \
            cw[m] = *(const LAS bf16x4*)(sl + 0 * 2048 + fr * 128 + RW_SW(fr, 2 * m + (q >> 1)) + (q & 1) * 8); \
            cr[m] = *(const LAS bf16x4*)(sl + 1 * 2048 + fr * 128 + RW_SW(fr, 2 * m + (q >> 1)) + (q & 1) * 8); \
            cb[m] = *(const LAS bf16x4*)(sl + 2 * 2048 + sg_ * 128 + RW_SW(sg_, (fr & 3) * 2 + (q >> 1)) + (q & 1) * 8); \
            ck[m] = *(const LAS bf16x4*)(sl + 3 * 2048 + sg_ * 128 + RW_SW(sg_, (fr & 3) * 2 + (q >> 1)) + (q & 1) * 8); \
            cg[m] = *(const LAS f32x4*)(sl + 4 * 2048 + gs_ * 128 + RW_SW(gs_, ((16 * m + 4 * q) & 31) >> 2)); } \
        { const int s0_ = fr >> 2, s1_ = 4 + (fr >> 2), s2_ = 8 + (fr >> 2), pc_ = (fr & 3) * 2 + (q >> 1); \
        cp  = *(const LAS bf16x4*)(sl + 4 * 2048 + s0_ * 128 + RW_SW(s0_, pc_) + (q & 1) * 8); \
        cmb = *(const LAS bf16x4*)(sl + 4 * 2048 + s1_ * 128 + RW_SW(s1_, pc_) + (q & 1) * 8); \
        cmk = *(const LAS bf16x4*)(sl + 4 * 2048 + s2_ * 128 + RW_SW(s2_, pc_) + (q & 1) * 8); } \
        _Pragma("unroll") for (int jj = 0; jj < 4; ++jj) cv[jj] = *(const LAS short*)(sl + 5 * 2048 + (4 * q + jj) * 128 + RW_SW(4 * q + jj, 2 * wave + (fr >> 3)) + (fr & 7) * 2); } while (0)
                __builtin_amdgcn_s_barrier();
                RW_READ(0);
                float* yout = (float*)(ws + WS_Y) + (size_t)h * T * 64 + 16 * wave + fr;
                for (int c = 0; c < NC; ++c) {
                    const bf16x4 w0 = cw[0], w1 = cw[1], w2 = cw[2], w3 = cw[3], r0 = cr[0], r1 = cr[1], r2 = cr[2], r3 = cr[3];
                    const bf16x4 b0 = cb[0], b1 = cb[1], b2 = cb[2], b3 = cb[3], k0 = ck[0], k1 = ck[1], k2 = ck[2], k3 = ck[3];
                    const bf16x4 pp_ = cp, mb_ = cmb, mk_ = cmk, vv_ = cv; const f32x4 g0 = cg[0], g1 = cg[1], g2 = cg[2], g3 = cg[3];
                    if (c + 1 < NC) RW_READ(c + 1);
                    bf16x4 sb[4];
#pragma unroll
                    for (int m = 0; m < 4; ++m) { u32x2 t2; t2.x = pk2(ST[m][0], ST[m][1]); t2.y = pk2(ST[m][2], ST[m][3]); sb[m] = __builtin_bit_cast(bf16x4, t2); }
                    f32x4 ua = __builtin_amdgcn_mfma_f32_16x16x16bf16_1k(pp_, vv_, (f32x4){0.f, 0.f, 0.f, 0.f}, 0, 0, 0);
                    f32x4 ub = __builtin_amdgcn_mfma_f32_16x16x16bf16_1k(w0, sb[0], (f32x4){0.f, 0.f, 0.f, 0.f}, 0, 0, 0);
                    ua = __builtin_amdgcn_mfma_f32_16x16x16bf16_1k(w1, sb[1], ua, 0, 0, 0);
                    ub = __builtin_amdgcn_mfma_f32_16x16x16bf16_1k(w2, sb[2], ub, 0, 0, 0);
                    ua = __builtin_amdgcn_mfma_f32_16x16x16bf16_1k(w3, sb[3], ua, 0, 0, 0);
                    f32x4 ya = __builtin_amdgcn_mfma_f32_16x16x16bf16_1k(mk_, vv_, (f32x4){0.f, 0.f, 0.f, 0.f}, 0, 0, 0);
                    f32x4 yb = __builtin_amdgcn_mfma_f32_16x16x16bf16_1k(r0, sb[0], (f32x4){0.f, 0.f, 0.f, 0.f}, 0, 0, 0);
                    ya = __builtin_amdgcn_mfma_f32_16x16x16bf16_1k(r1, sb[1], ya, 0, 0, 0);
                    yb = __builtin_amdgcn_mfma_f32_16x16x16bf16_1k(r2, sb[2], yb, 0, 0, 0);
                    ya = __builtin_amdgcn_mfma_f32_16x16x16bf16_1k(r3, sb[3], ya, 0, 0, 0);
                    ST[0] = __builtin_amdgcn_mfma_f32_16x16x16bf16_1k(k0, vv_, ST[0] * g0, 0, 0, 0);
                    ST[1] = __builtin_amdgcn_mfma_f32_16x16x16bf16_1k(k1, vv_, ST[1] * g1, 0, 0, 0);
                    ST[2] = __builtin_amdgcn_mfma_f32_16x16x16bf16_1k(k2, vv_, ST[2] * g2, 0, 0, 0);
                    ST[3] = __builtin_amdgcn_mfma_f32_16x16x16bf16_1k(k3, vv_, ST[3] * g3, 0, 0, 0);
                    const f32x4 ut = ua + ub;
                    u32x2 u2; u2.x = pk2(ut[0], ut[1]); u2.y = pk2(ut[2], ut[3]); const bf16x4 ubf = __builtin_bit_cast(bf16x4, u2);
                    ST[0] = __builtin_amdgcn_mfma_f32_16x16x16bf16_1k(b0, ubf, ST[0], 0, 0, 0);
                    ST[1] = __builtin_amdgcn_mfma_f32_16x16x16bf16_1k(b1, ubf, ST[1], 0, 0, 0);
                    ST[2] = __builtin_amdgcn_mfma_f32_16x16x16bf16_1k(b2, ubf, ST[2], 0, 0, 0);
                    ST[3] = __builtin_amdgcn_mfma_f32_16x16x16bf16_1k(b3, ubf, ST[3], 0, 0, 0);
                    ya = __builtin_amdgcn_mfma_f32_16x16x16bf16_1k(mb_, ubf, ya, 0, 0, 0);
                    const f32x4 yt = ya + yb;
#pragma unroll
                    for (int jj = 0; jj < 4; ++jj) yout[(size_t)(c * 16 + 4 * q + jj) * 64] = yt[jj];
                    __builtin_amdgcn_s_barrier();
                }
#undef RW_READ
#undef RW_SW
            }
        }
    }
    GSYNC();

    {
        PHASE_ARGS
        const float* lnw = ka->in[13]; const float* lnb = ka->in[14];
        float lw[8], lb[8];
#pragma unroll
        for (int e = 0; e < 8; ++e) { const int ch = 8 * lane + e; lw[e] = lnw[ch]; lb[e] = lnb[ch]; }
        const float* YRp = (const float*)(ws + WS_Y);
        for (int t = gw; t < T; t += NGW) {
            const f32x4 ya = *(const f32x4*)(YRp + hm8(t, lane)), yb = *(const f32x4*)(YRp + hm8(t, lane) + 4);
            float y[8] = {ya[0], ya[1], ya[2], ya[3], yb[0], yb[1], yb[2], yb[3]};
            float vs[8], gv[8];
            unpack8(*(const u32x4*)(VSb + hm8(t, lane)), vs);
            unpack8(*((const u32x4*)(Gb + (size_t)t * 512) + lane), gv);
            float s = 0.f;
#pragma unroll
            for (int e = 0; e < 8; ++e) s += y[e];
            const float mean = sum8(s) * (1.f / 64.f); float qv = 0.f;
#pragma unroll
            for (int e = 0; e < 8; ++e) { y[e] -= mean; qv += y[e] * y[e]; }
            const float rstd = rsqrtf(sum8(qv) * (1.f / 64.f) + 64e-5f);
            const float bon = BON[(size_t)t * 8 + (lane >> 3)];
            float o[8];
#pragma unroll
            for (int e = 0; e < 8; ++e) o[e] = (y[e] * rstd * lw[e] + lb[e] + bon * vs[e]) * gv[e];
            *((u32x4*)(B2 + (size_t)t * D) + lane) = pack8(o);
        }
    }
    GSYNC();

    {
        PHASE_ARGS
        pg8::Gemm g{B2, (const bf16*)(ws + W_OUT), T, D, D}; pg8::StaticOrder S; S.init(T, D, G, bid);
        pg8::EpiRes<0> E{ka->in[0], ka->out, B1, nullptr, STB, nullptr};
        pg8::gemm_phase<pg8::EpiRes<0>, pg8::StaticOrder, true, true>(lds, g, S, E);
    }
    GSYNC();
    {
        PHASE_ARGS
        pg8::Gemm g{B1, (const bf16*)(ws + W_UP0), T, FF, D}; pg8::StaticOrder S; S.init(T, FF, G, bid);
        pg8::EpiB<2, 16> E{HID, nullptr, nullptr, STB, nullptr, nullptr, FF};
        pg8::gemm_phase<pg8::EpiB<2, 16>, pg8::StaticOrder, true, true>(lds, g, S, E);
    }
    GSYNC();
    {
        PHASE_ARGS
        pg8::Gemm g{HID, (const bf16*)(ws + W_DN0), T, D, FF}; pg8::StaticOrder S; S.init(T, D, G, bid);
        pg8::EpiRes<0> E{ka->out, ka->out, B1, nullptr, STA, nullptr};
        pg8::gemm_phase<pg8::EpiRes<0>, pg8::StaticOrder, true, true>(lds, g, S, E);
    }
    GSYNC();
    {
        PHASE_ARGS
        pg8::Gemm g{PBF, (const bf16*)(ws + W_P0), T, D, 256}; pg8::StaticOrder S; S.init(T, D, G, bid);
        pg8::EpiB<3, 16> E{PP, nullptr, nullptr, nullptr, nullptr, nullptr, D};
        pg8::gemm_phase<pg8::EpiB<3, 16>, pg8::StaticOrder, true, true>(lds, g, S, E);
    }
    GSYNC();
    {
        PHASE_ARGS
        pg8::Gemm g{B1, (const bf16*)(ws + W_G0), T, D, D}; pg8::StaticOrder S; S.init(T, D, G, bid);
        pg8::EpiRes<1> E{ka->out, ka->out, B2, STA, STB, PP};
        pg8::gemm_phase<pg8::EpiRes<1>, pg8::StaticOrder, true, true>(lds, g, S, E);
    }
    GSYNC();

#pragma unroll 1
    for (int pass = 0; pass < 2; ++pass) {
        PHASE_ARGS
        LAS float* UT = (LAS float*)(lds + wave * 12800);
        LAS bf16* HS = (LAS bf16*)(lds + wave * 12800 + 8192);
        const float* gm = ka->in[23]; const float* dsk = ka->in[31];
        for (int u = gw; u < 8192; u += NGW) {
            const int ck = u >> 6, g = u & 63, t0 = ck * 128;
#pragma unroll
            for (int q = 0; q < 2; ++q) {
                const int tk = lane + 64 * q, t = t0 + tk;
                const f32x4* sp = (const f32x4*)(STB + (size_t)t * 32); const f32x4 s0 = sp[0], s1 = sp[1], s2 = sp[2], s3 = sp[3];
                const float ssq = ((s0[0] + s0[1]) + (s0[2] + s0[3])) + ((s1[0] + s1[1]) + (s1[2] + s1[3])) + ((s2[0] + s2[1]) + (s2[2] + s2[3])) + ((s3[0] + s3[1]) + (s3[2] + s3[3]));
                const float rs = rsqrtf(ssq * (1.f / 1024.f) + 1e-6f);
                float f0[8], f1[8]; unpack8(*(const u32x4*)(B2 + (size_t)t * D + 16 * g), f0); unpack8(*(const u32x4*)(B2 + (size_t)t * D + 16 * g + 8), f1);
                const f32x4 g0 = *(const f32x4*)(gm + 16 * g), g1 = *(const f32x4*)(gm + 16 * g + 4), g2 = *(const f32x4*)(gm + 16 * g + 8), g3 = *(const f32x4*)(gm + 16 * g + 12);
                LAS f32x4* ud = (LAS f32x4*)(UT + tk * 16);
                ud[0] = (f32x4){f0[0] * rs * g0[0], f0[1] * rs * g0[1], f0[2] * rs * g0[2], f0[3] * rs * g0[3]};
                ud[1] = (f32x4){f0[4] * rs * g1[0], f0[5] * rs * g1[1], f0[6] * rs * g1[2], f0[7] * rs * g1[3]};
                ud[2] = (f32x4){f1[0] * rs * g2[0], f1[1] * rs * g2[1], f1[2] * rs * g2[2], f1[3] * rs * g2[3]};
                ud[3] = (f32x4){f1[4] * rs * g3[0], f1[5] * rs * g3[1], f1[6] * rs * g3[2], f1[7] * rs * g3[3]};
            }
            f32x2 bb[16];
#pragma unroll
            for (int c = 0; c < 16; ++c) bb[c] = BB[((size_t)g * 64 + lane) * 16 + c];
            const f32x2 lam = LB[g * 64 + lane];
            f32x2 hst = (f32x2){0.f, 0.f};
            if (pass == 0) {
#pragma unroll 4
                for (int tk = 0; tk < 128; ++tk) {
                    const LAS f32x4* up = (const LAS f32x4*)(UT + tk * 16); f32x2 bu = (f32x2){0.f, 0.f};
#pragma unroll
                    for (int c4 = 0; c4 < 4; ++c4) { const f32x4 uu = up[c4];
#pragma unroll
                        for (int e = 0; e < 4; ++e) bu += bb[4 * c4 + e] * uu[e]; }
                    const float nr = lam[0] * hst[0] - lam[1] * hst[1] + bu[0], ni = lam[0] * hst[1] + lam[1] * hst[0] + bu[1];
                    hst = (f32x2){nr, ni};
                }
                EST[((size_t)ck * 64 + g) * 64 + lane] = hst;
            } else {
                const f32x2 lL = LBL[g * 64 + lane];
                for (int c2 = 0; c2 < ck; ++c2) { const f32x2 e = EST[((size_t)c2 * 64 + g) * 64 + lane];
                    const float nr = lL[0] * hst[0] - lL[1] * hst[1] + e[0], ni = lL[0] * hst[1] + lL[1] * hst[0] + e[1]; hst = (f32x2){nr, ni}; }
                bf16x8 cf[4];
                {
                    const int ch = lane & 15, qd = lane >> 4;
#pragma unroll
                    for (int ks = 0; ks < 4; ++ks) {
                        const float* src = (ks < 2 ? ka->in[29] : ka->in[30]) + ((size_t)g * 16 + ch) * 64 + (ks & 1) * 32 + qd * 8;
                        const f32x4 x0 = *(const f32x4*)src, x1 = *(const f32x4*)(src + 4); const float sg = ks < 2 ? 1.f : -1.f;
                        u32x4 w; w.x = pk2(sg * x0[0], sg * x0[1]); w.y = pk2(sg * x0[2], sg * x0[3]); w.z = pk2(sg * x1[0], sg * x1[1]); w.w = pk2(sg * x1[2], sg * x1[3]);
                        cf[ks] = __builtin_bit_cast(bf16x8, w);
                    }
                }
                const float dk = dsk[16 * g + (lane & 15)];
                for (int tg = 0; tg < 8; ++tg) {
#pragma unroll 4
                    for (int tl = 0; tl < 16; ++tl) {
                        const int tk = tg * 16 + tl;
                        const LAS f32x4* up = (const LAS f32x4*)(UT + tk * 16); f32x2 bu = (f32x2){0.f, 0.f};
#pragma unroll
                        for (int c4 = 0; c4 < 4; ++c4) { const f32x4 uu = up[c4];
#pragma unroll
                            for (int e = 0; e < 4; ++e) bu += bb[4 * c4 + e] * uu[e]; }
                        const float nr = lam[0] * hst[0] - lam[1] * hst[1] + bu[0], ni = lam[0] * hst[1] + lam[1] * hst[0] + bu[1];
                        hst = (f32x2){nr, ni};
                        const unsigned hw = pk2(nr, ni);
                        HS[tl * 136 + lane] = (bf16)(hw & 0xffffu); HS[tl * 136 + 64 + lane] = (bf16)(hw >> 16);
                    }
                    f32x4 acc = (f32x4){0.f, 0.f, 0.f, 0.f};
#pragma unroll
                    for (int ks = 0; ks < 4; ++ks) { const bf16x8 af = *(const LAS bf16x8*)(HS + (lane & 15) * 136 + ks * 32 + (lane >> 4) * 8);
                        acc = __builtin_amdgcn_mfma_f32_16x16x32_bf16(af, cf[ks], acc, 0, 0, 0); }
#pragma unroll
                    for (int j = 0; j < 4; ++j) { const int tk = tg * 16 + (lane >> 4) * 4 + j; const float uv = UT[tk * 16 + (lane & 15)];
                        const float y = gelu_tanh(acc[j] + dk * uv);
                        YG[(size_t)(t0 + tk) * D + 16 * g + (lane & 15)] = (bf16)(pk2(y, 0.f) & 0xffffu); }
                }
            }
        }
        GSYNC();
    }

    {
        PHASE_ARGS
        pg8::Gemm g{YG, (const bf16*)(ws + W_GLU), T, 2048, D}; pg8::StaticOrder S; S.init(T, 2048, G, bid);
        pg8::EpiRes<2> E{ka->out, ka->out, B1, nullptr, STA, nullptr};
        pg8::gemm_phase<pg8::EpiRes<2>, pg8::StaticOrder, true, true>(lds, g, S, E);
    }
    GSYNC();
    {
        PHASE_ARGS
        pg8::Gemm g{B1, (const bf16*)(ws + W_UP1), T, FF, D}; pg8::StaticOrder S; S.init(T, FF, G, bid);
        pg8::EpiB<2, 32> E{HID, nullptr, nullptr, STA, nullptr, nullptr, FF};
        pg8::gemm_phase<pg8::EpiB<2, 32>, pg8::StaticOrder, true, true>(lds, g, S, E);
    }
    GSYNC();
    {
        PHASE_ARGS
        pg8::Gemm g{HID, (const bf16*)(ws + W_DN1), T, D, FF}; pg8::StaticOrder S; S.init(T, D, G, bid);
        pg8::EpiRes<0> E{ka->out, ka->out, B1, nullptr, STB, nullptr};
        pg8::gemm_phase<pg8::EpiRes<0>, pg8::StaticOrder, true, true>(lds, g, S, E);
    }
    GSYNC();
    {
        PHASE_ARGS
        pg8::Gemm g{PBF + (size_t)T * 256, (const bf16*)(ws + W_P1), T, D, 256}; pg8::StaticOrder S; S.init(T, D, G, bid);
        pg8::EpiB<3, 16> E{PP, nullptr, nullptr, nullptr, nullptr, nullptr, D};
        pg8::gemm_phase<pg8::EpiB<3, 16>, pg8::StaticOrder, true, true>(lds, g, S, E);
    }
    GSYNC();
    {
        PHASE_ARGS
        pg8::Gemm g{B1, (const bf16*)(ws + W_G1), T, D, D}; pg8::StaticOrder S; S.init(T, D, G, bid);
        pg8::EpiRes<1> E{ka->out, ka->out, nullptr, STB, STA, PP};
        pg8::gemm_phase<pg8::EpiRes<1>, pg8::StaticOrder, true, true>(lds, g, S, E);
    }
    GSYNC();
    {
        PHASE_ARGS
        const float* gf = ka->in[40];
        for (int m = gw; m < T; m += NGW) {
            const f32x4* sp = (const f32x4*)(STA + (size_t)m * 32); const f32x4 s0 = sp[0], s1 = sp[1], s2 = sp[2], s3 = sp[3];
            const float ssq = ((s0[0] + s0[1]) + (s0[2] + s0[3])) + ((s1[0] + s1[1]) + (s1[2] + s1[3])) + ((s2[0] + s2[1]) + (s2[2] + s2[3])) + ((s3[0] + s3[1]) + (s3[2] + s3[3]));
            const float rs = rsqrtf(ssq * (1.f / 1024.f) + 1e-6f);
            f32x4* xr = (f32x4*)(ka->out + (size_t)m * D) + lane;
#pragma unroll
            for (int j = 0; j < 4; ++j) { const f32x4 v = xr[64 * j]; const f32x4 gg = *((const f32x4*)gf + lane + 64 * j); xr[64 * j] = v * rs * gg; }
        }
    }
#undef GSYNC
}

extern "C" void kernel_launch(void* const* d_in, const int* in_sizes, int n_in, void* d_out, int out_size, void* d_ws, size_t ws_size, hipStream_t stream) {
    static int grid = 0;
    if (grid == 0) {
        if (n_in != 41 || out_size != T * D || ws_size < WS_END) { fprintf(stderr, "kernel_launch: unexpected shapes (n_in %d, out %d, ws %zu)\n", n_in, out_size, ws_size); grid = -1; return; }
        int dev = 0, cus = 0, per_cu = 0;
        hipGetDevice(&dev); hipDeviceGetAttribute(&cus, hipDeviceAttributeMultiprocessorCount, dev);
        if (hipFuncSetAttribute((const void*)mega_fwd, hipFuncAttributeMaxDynamicSharedMemorySize, LDS_BYTES) != hipSuccess) { fprintf(stderr, "kernel_launch: hipFuncSetAttribute failed\n"); grid = -1; return; }
        if (hipOccupancyMaxActiveBlocksPerMultiprocessor(&per_cu, (const void*)mega_fwd, NWAVES * 64, LDS_BYTES) != hipSuccess || per_cu < 1) { fprintf(stderr, "kernel_launch: occupancy query says %d\n", per_cu); per_cu = 1; }
        (void)hipGetLastError();
        grid = cus;
    }
    if (grid < 0) return;
    if (hipMemsetAsync((char*)d_ws + WS_BAR, 0, 16384, stream) != hipSuccess) { fprintf(stderr, "kernel_launch: memset failed\n"); return; }
    Args a{};
    for (int i = 0; i < 41; ++i) a.in[i] = (const float*)d_in[i];
    a.out = (float*)d_out; a.ws = (unsigned char*)d_ws;
    void* params[] = {&a};
    hipError_t e = hipLaunchCooperativeKernel((const void*)mega_fwd, dim3(grid), dim3(NWAVES * 64), params, LDS_BYTES, stream);
    if (e != hipSuccess) fprintf(stderr, "kernel_launch: cooperative launch failed: %s (grid %d)\n", hipGetErrorString(e), grid);
}
```

```cpp
#include <hip/hip_runtime.h>
#include <hip/hip_cooperative_groups.h>
#include <cstdio>
#include <cstdint>
namespace pg8 {
#define PG8_LAS __attribute__((address_space(3)))
typedef unsigned short bf16_t;
typedef short bf16x8 __attribute__((ext_vector_type(8)));
typedef float f32x4 __attribute__((ext_vector_type(4)));
typedef unsigned u32x4 __attribute__((ext_vector_type(4)));
constexpr int BM = 256, BK = 64, HALF = 128, HTB = HALF * BK * 2  , STAGE_BYTES = 8 * HTB, NXCD = 8, WGM = 8;

__host__ __device__ __forceinline__ int lds_byte(int r, int c) { const int st = (r >> 4) * 2 + (c >> 5), rr = r & 15, cc = c & 31, ob = rr * 64 + cc * 2; return st * 1024 + (ob ^ (((ob >> 9) & 1) << 5)); }
__host__ __device__ __forceinline__ void stage_rc(int b, int& R, int& C) { const int st = b / 1024, sb = b % 1024, swz = sb ^ (((sb >> 9) & 1) << 5); R = (st >> 1) * 16 + swz / 64; C = (st & 1) * 32 + (swz % 64) / 2; }
__host__ __device__ __forceinline__ int perm32(int rho) { const int n = rho >> 4, i = rho & 15; return 8 * (i >> 2) + 4 * n + (i & 3); }

struct Unit { int pm, pn; };
struct Gemm { const bf16_t* A; const bf16_t* Bt; int M, N, K; };

struct StaticOrder {
    int nM, nN, nwg, G, c;
    __host__ __device__ void init(int M, int N, int G_, int c_) { nM = M / BM; nN = N / BM; nwg = nM * nN; G = G_; c = c_; }
    __host__ __device__ bool next(int i, Unit& u) const {
        const long L = (long)i * G + c; if (L >= nwg) return false;
        int wgid = (int)L; { const int q = nwg / NXCD, r = nwg % NXCD, xcd = wgid % NXCD, off = wgid / NXCD; wgid = (xcd < r ? xcd * (q + 1) : r * (q + 1) + (xcd - r) * q) + off; }
        const int nig = WGM * nN, gid = wgid / nig, fm = gid * WGM, gsz = (nM - fm) < WGM ? (nM - fm) : WGM;
        u.pm = fm + ((wgid % nig) % gsz); u.pn = (wgid % nig) / gsz; return true;
    }
    __device__ __forceinline__ void a_ready(const Unit&) const {}
    __device__ __forceinline__ void done(const Unit&) const {}
};

typedef float f32x2n __attribute__((ext_vector_type(2))); typedef __bf16 hbf2n __attribute__((ext_vector_type(2)));
__device__ __forceinline__ unsigned cvt_pk_bf16(float lo, float hi) { const f32x2n v = {lo, hi}; const hbf2n b = __builtin_convertvector(v, hbf2n); return __builtin_bit_cast(unsigned, b); }
typedef float f32x2 __attribute__((ext_vector_type(2)));

constexpr int TT = 16384;
typedef unsigned u32x2 __attribute__((ext_vector_type(2)));
__device__ __forceinline__ float fsigmoid(float x) { return __builtin_amdgcn_rcpf(1.0f + __expf(-x)); }
template <int NSL> __device__ __forceinline__ float row_rstd(const float* st, int r, int fq) {
    const f32x4 v = *(const f32x4*)(st + (size_t)r * 32 + 4 * fq);
    float s = (v[0] + v[1]) + (v[2] + v[3]);
    if (NSL == 32) { const f32x4 w = *(const f32x4*)(st + (size_t)r * 32 + 16 + 4 * fq); s += (w[0] + w[1]) + (w[2] + w[3]); }
    s += __shfl_xor(s, 16); s += __shfl_xor(s, 32);
    return rsqrtf(s * (1.0f / 1024.0f) + 1e-6f);
}
template <int MODE, int NSL> struct EpiB {
    static constexpr bool PERM = true, AFTER_DRAIN = false;
    bf16_t* o0; bf16_t* o1; bf16_t* o2; const float* st; const float* c0; const float* c1; int ldc;
    __device__ __forceinline__ void operator()(const f32x4 (&acc)[2][2][4][2], const Unit& u, int wr, int wc, int fr, int fq) const {
        const int row0 = u.pm * BM + wr * 64 + fr; const int pn = u.pn;
        bf16_t* base; int ld, colt; int kind = 0;
        if (MODE == 0) {
            if (pn < 6) { base = o0 + (size_t)(pn >> 1) * TT * 512; ld = 512; colt = (pn & 1) * 256; }
            else if (pn == 6) { base = o1; ld = 256; colt = 0; }
            else { base = o2; ld = 1536; colt = (pn - 7) * 256; }
        } else if (MODE == 1) {
            kind = pn >> 1; base = o0 + (size_t)kind * TT * 512; if (kind == 2) base = o2; ld = 512; colt = (pn & 1) * 256;
        } else { base = o0; ld = ldc; colt = pn * 256; }
        const int col0 = colt + wc * 32 + 8 * fq;
        const float* cbias = c0; if (kind == 1) cbias = c1; cbias += col0;
        f32x4 bv00 = (f32x4){0.f, 0.f, 0.f, 0.f}, bv01 = bv00, bv10 = bv00, bv11 = bv00;
        if (MODE == 1) { if (kind < 2) { bv00 = *(const f32x4*)(cbias); bv01 = *(const f32x4*)(cbias + 4); bv10 = *(const f32x4*)(cbias + HALF); bv11 = *(const f32x4*)(cbias + HALF + 4); } }
#pragma unroll
        for (int ai = 0; ai < 2; ++ai)
#pragma unroll
            for (int m = 0; m < 4; ++m) {
                const int r = row0 + ai * HALF + m * 16;
                float rs = 1.f;
                if (MODE == 0 || MODE == 2) rs = row_rstd<NSL>(st, r, fq);
                bf16_t* rowp = base + (size_t)r * ld + col0;
#pragma unroll
                for (int bj = 0; bj < 2; ++bj) {
                    f32x4 v0 = acc[ai][bj][m][0], v1 = acc[ai][bj][m][1];
                    if (MODE == 0) { v0 = v0 * rs; v1 = v1 * rs; }
                    if (MODE == 2) {
#pragma unroll
                        for (int e = 0; e < 4; ++e) { float a = fmaxf(v0[e], 0.f) * rs, b = fmaxf(v1[e], 0.f) * rs; v0[e] = a * a; v1[e] = b * b; }
                    }
                    if (MODE == 1) {
                        if (kind < 2) {
                            const float sc = kind == 0 ? (0.6065306597f * 1.4426950409f) : 1.0f;
                            v0 = v0 + (bj == 0 ? bv00 : bv10); v1 = v1 + (bj == 0 ? bv01 : bv11);
#pragma unroll
                            for (int e = 0; e < 4; ++e) { v0[e] = sc * fsigmoid(v0[e]); v1[e] = sc * fsigmoid(v1[e]); }
                        }
                    }
                    u32x4 w; w.x = cvt_pk_bf16(v0[0], v0[1]); w.y = cvt_pk_bf16(v0[2], v0[3]); w.z = cvt_pk_bf16(v1[0], v1[1]); w.w = cvt_pk_bf16(v1[2], v1[3]);
                    if (MODE == 1 && kind < 2) { const int cc_ = col0 + bj * HALF; *(u32x4*)(base + ((size_t)(cc_ >> 6) * TT + r) * 64 + (cc_ & 63)) = w; }
                    else *(u32x4*)(rowp + bj * HALF) = w;
                }
                if (m & 1) asm volatile("" ::: "memory");
            }
    }
};
template <int MODE> struct EpiRes {
    static constexpr bool PERM = false, AFTER_DRAIN = false;
    const float* base; float* out; bf16_t* hb; const float* st_in; float* st_out; const bf16_t* pp;
    __device__ __forceinline__ void operator()(const f32x4 (&acc)[2][2][4][2], const Unit& u, int wr, int wc, int fr, int fq) const {
        const int row0 = u.pm * BM + wr * 64 + fr;
#pragma unroll
        for (int ai = 0; ai < 2; ++ai)
#pragma unroll
            for (int m = 0; m < 4; ++m) {
                const int r = row0 + ai * HALF + m * 16;
                float rs = 1.f;
                if (MODE == 1) rs = row_rstd<16>(st_in, r, fq);
                float ss = 0.f;
#pragma unroll
                for (int bj = 0; bj < (MODE == 2 ? 1 : 2); ++bj)
#pragma unroll
                    for (int n = 0; n < 2; ++n) {
                        const int c = (MODE == 2 ? u.pn * 128 : u.pn * BM + bj * HALF) + wc * 32 + n * 16 + 4 * fq;
                        const size_t off = (size_t)r * 1024 + c;
                        const f32x4 b = *(const f32x4*)(base + off);
                        f32x4 v = acc[ai][bj][m][n];
                        if (MODE == 1) {
                            const u32x2 pw = *(const u32x2*)(pp + off);
                            const float p0 = __uint_as_float(pw.x << 16), p1 = __uint_as_float(pw.x & 0xffff0000u), p2 = __uint_as_float(pw.y << 16), p3 = __uint_as_float(pw.y & 0xffff0000u);
                            v[0] = p0 * fsigmoid(v[0] * rs); v[1] = p1 * fsigmoid(v[1] * rs); v[2] = p2 * fsigmoid(v[2] * rs); v[3] = p3 * fsigmoid(v[3] * rs);
                        }
                        if (MODE == 2) {
                            const f32x4 g = acc[ai][1][m][n];
#pragma unroll
                            for (int e = 0; e < 4; ++e) v[e] = v[e] * fsigmoid(g[e]);
                        }
                        const f32x4 o = b + v;
                        *(f32x4*)(out + off) = o;
                        if (hb) { u32x2 w; w.x = cvt_pk_bf16(o[0], o[1]); w.y = cvt_pk_bf16(o[2], o[3]); *(u32x2*)(hb + off) = w; }
                        ss += (o[0] * o[0] + o[1] * o[1]) + (o[2] * o[2] + o[3] * o[3]);
                    }
                ss += __shfl_xor(ss, 16); ss += __shfl_xor(ss, 32);
                if (fq == 0) st_out[(size_t)r * 32 + u.pn * 4 + wc] = ss;
                asm volatile("" ::: "memory");
            }
    }
};

template <class Epi, class Sched, bool ALIGN_EPI = false, bool SP2 = false>
__device__ __forceinline__ void gemm_phase(PG8_LAS unsigned char* lds, const Gemm g, const Sched& S, const Epi& E) {
    int tid_l = threadIdx.x; asm volatile("" : "+v"(tid_l)); const int tid = tid_l, wid = __builtin_amdgcn_readfirstlane(tid >> 6), lane = tid & 63, wr = wid >> 2, wc = wid & 3, fr = lane & 15, fq = lane >> 4;
    int K = g.K; asm volatile("" : "+s"(K)); const int nt = K / BK;
    unsigned voffA[2], voffB[2];
#pragma unroll
    for (int i = 0; i < 2; ++i) { int R, C; stage_rc(tid * 16 + i * 8192, R, C); const int Rb = Epi::PERM ? ((R & ~31) + perm32(R & 31)) : R;
        voffA[i] = (unsigned)(R * K + C) * 2u; voffB[i] = (unsigned)(Rb * K + C) * 2u; }
    const size_t kstep = (size_t)(BK * 2);
    const size_t hstep = (size_t)HALF * K * 2;
    const size_t tstep = 2 * hstep;
    const unsigned ldsw = (unsigned)wid * 1024u;
    const int aoff = lds_byte(wr * 64 + fr, fq * 8), boff = lds_byte(wc * 32 + fr, fq * 8);
#define PG8_SA(b, h) (((b) * 2 + (h)) * HTB)
#define PG8_SB(b, h) ((4 + (b) * 2 + (h)) * HTB)
#define PG8_STAGE(bufoff, gbase, voff) do { _Pragma("unroll") for (int _i = 0; _i < 2; ++_i) \
        __builtin_amdgcn_global_load_lds((const unsigned*)((const char*)(gbase) + (voff)[_i]), (PG8_LAS unsigned*)(lds + (bufoff) + ldsw + _i * 8192), 16, 0, 0); } while (0)
#define PG8_LDA(dst, b, h) do { _Pragma("unroll") for (int m = 0; m < 4; ++m) _Pragma("unroll") for (int k = 0; k < 2; ++k) dst[m][k] = *(const PG8_LAS bf16x8*)(lds + PG8_SA(b, h) + aoff + m * 2048 + k * 1024); } while (0)
#define PG8_LDB(dst, b, h) do { _Pragma("unroll") for (int n = 0; n < 2; ++n) _Pragma("unroll") for (int k = 0; k < 2; ++k) dst[n][k] = *(const PG8_LAS bf16x8*)(lds + PG8_SB(b, h) + boff + n * 2048 + k * 1024); } while (0)
#define PG8_MMA(ai, bj, At, Bt) do { __builtin_amdgcn_s_setprio(1); _Pragma("unroll") for (int m = 0; m < 4; ++m) _Pragma("unroll") for (int n = 0; n < 2; ++n) _Pragma("unroll") for (int k = 0; k < 2; ++k) \
        acc[ai][bj][m][n] = __builtin_amdgcn_mfma_f32_16x16x32_bf16(Bt[n][k], At[m][k], acc[ai][bj][m][n], 0, 0, 0); __builtin_amdgcn_s_setprio(0); } while (0)
#define PG8_WAIT_V(n) asm volatile("s_waitcnt vmcnt(" #n ")" ::: "memory")
#define PG8_WAIT_L(n) asm volatile("s_waitcnt lgkmcnt(" #n ")" ::: "memory")
#define PG8_BAR __builtin_amdgcn_s_barrier()
#define PG8_SCHED __builtin_amdgcn_sched_barrier(0)
    Unit cur, nxt; int ui = 0;
    if (!S.next(0, cur)) return;
    f32x4 acc[2][2][4][2];
#pragma unroll
    for (int a = 0; a < 2; ++a)
#pragma unroll
        for (int b = 0; b < 2; ++b)
#pragma unroll
            for (int m = 0; m < 4; ++m)
#pragma unroll
                for (int n = 0; n < 2; ++n) acc[a][b][m][n] = (f32x4){0.f, 0.f, 0.f, 0.f};
    bf16x8 At[4][2], B0[2][2], B1[2][2];
    const char* cA = (const char*)g.A + (size_t)cur.pm * tstep; const char* cB = (const char*)g.Bt + (size_t)cur.pn * tstep;
    S.a_ready(cur);
    if constexpr (SP2) {
        PG8_STAGE(PG8_SB(0, 0), cB, voffB); PG8_STAGE(PG8_SB(0, 1), cB + hstep, voffB); PG8_STAGE(PG8_SA(0, 0), cA, voffA); PG8_STAGE(PG8_SA(0, 1), cA + hstep, voffA);
        if (wr == 1) PG8_BAR;
        PG8_WAIT_V(2); PG8_BAR;
        PG8_STAGE(PG8_SB(1, 0), cB + kstep, voffB); PG8_STAGE(PG8_SA(1, 0), cA + kstep, voffA); PG8_STAGE(PG8_SB(1, 1), cB + hstep + kstep, voffB);
        PG8_WAIT_V(6); PG8_BAR;
    } else {
        PG8_STAGE(PG8_SB(0, 0), cB, voffB); PG8_STAGE(PG8_SA(0, 0), cA, voffA); PG8_STAGE(PG8_SB(0, 1), cB + hstep, voffB); PG8_STAGE(PG8_SA(0, 1), cA + hstep, voffA);
        if (wr == 1) PG8_BAR;
        PG8_WAIT_V(4); PG8_BAR;
        PG8_STAGE(PG8_SB(1, 0), cB + kstep, voffB); PG8_STAGE(PG8_SA(1, 0), cA + kstep, voffA); PG8_STAGE(PG8_SB(1, 1), cB + hstep + kstep, voffB);
        PG8_WAIT_V(6); PG8_BAR;
    }
    for (;;) {
        const bool has_next = S.next(ui + 1, nxt);
        const char* nA = has_next ? (const char*)g.A + (size_t)nxt.pm * tstep : cA; const char* nB = has_next ? (const char*)g.Bt + (size_t)nxt.pn * tstep : cB;
        for (int t = 0; t < nt; t += 2) {
            const bool last = (t == nt - 2);
            const char* a1 = cA + (size_t)(t + 1) * kstep;
            const char* a2 = last ? nA : cA + (size_t)(t + 2) * kstep; const char* b2 = last ? nB : cB + (size_t)(t + 2) * kstep;
            const char* a3 = a2 + kstep; const char* b3 = b2 + kstep;
            if (last && has_next) S.a_ready(nxt);
            if constexpr (SP2) {
            PG8_LDB(B0, 0, 0); PG8_LDB(B1, 0, 1); PG8_SCHED; PG8_LDA(At, 0, 0); PG8_STAGE(PG8_SA(1, 1), a1 + hstep, voffA);
            PG8_WAIT_V(8); PG8_WAIT_L(0); PG8_BAR; PG8_MMA(0, 0, At, B0); PG8_MMA(0, 1, At, B1); PG8_BAR; PG8_SCHED;
            PG8_LDA(At, 0, 1); PG8_STAGE(PG8_SB(0, 0), b2, voffB); PG8_STAGE(PG8_SB(0, 1), b2 + hstep, voffB); PG8_STAGE(PG8_SA(0, 0), a2, voffA);
            PG8_WAIT_V(8); PG8_WAIT_L(0); PG8_BAR; PG8_MMA(1, 0, At, B0); PG8_MMA(1, 1, At, B1); PG8_BAR; PG8_SCHED;
            PG8_LDB(B0, 1, 0); PG8_LDB(B1, 1, 1); PG8_SCHED; PG8_LDA(At, 1, 0); PG8_STAGE(PG8_SA(0, 1), a2 + hstep, voffA);
            PG8_WAIT_V(8); PG8_WAIT_L(0); PG8_BAR; PG8_MMA(0, 0, At, B0); PG8_MMA(0, 1, At, B1); PG8_BAR; PG8_SCHED;
            PG8_LDA(At, 1, 1); PG8_STAGE(PG8_SB(1, 0), b3, voffB); PG8_STAGE(PG8_SB(1, 1), b3 + hstep, voffB); PG8_STAGE(PG8_SA(1, 0), a3, voffA);
            PG8_WAIT_V(8); PG8_WAIT_L(0); PG8_BAR; PG8_MMA(1, 0, At, B0); PG8_MMA(1, 1, At, B1); PG8_BAR; PG8_SCHED;
            } else {
            PG8_LDB(B0, 0, 0); PG8_SCHED; PG8_LDA(At, 0, 0); PG8_STAGE(PG8_SA(1, 1), a1 + hstep, voffA);
            PG8_WAIT_L(8); PG8_BAR; PG8_WAIT_L(0); PG8_MMA(0, 0, At, B0); PG8_BAR; PG8_SCHED;
            PG8_LDB(B1, 0, 1); PG8_STAGE(PG8_SB(0, 0), b2, voffB);
            PG8_BAR; PG8_WAIT_L(0); PG8_MMA(0, 1, At, B1); PG8_BAR;
            PG8_LDA(At, 0, 1); PG8_STAGE(PG8_SA(0, 0), a2, voffA);
            PG8_BAR; PG8_WAIT_L(0); PG8_MMA(1, 0, At, B0); PG8_BAR; PG8_SCHED;
            PG8_STAGE(PG8_SB(0, 1), b2 + hstep, voffB);
            PG8_WAIT_V(6); PG8_BAR; PG8_MMA(1, 1, At, B1); PG8_BAR;
            PG8_LDB(B0, 1, 0); PG8_SCHED; PG8_LDA(At, 1, 0); PG8_STAGE(PG8_SA(0, 1), a2 + hstep, voffA);
            PG8_WAIT_L(8); PG8_BAR; PG8_WAIT_L(0); PG8_MMA(0, 0, At, B0); PG8_BAR; PG8_SCHED;
            PG8_LDB(B1, 1, 1); PG8_STAGE(PG8_SB(1, 0), b3, voffB);
            PG8_BAR; PG8_WAIT_L(0); PG8_MMA(0, 1, At, B1); PG8_BAR;
            PG8_LDA(At, 1, 1); PG8_STAGE(PG8_SA(1, 0), a3, voffA);
            PG8_BAR; PG8_WAIT_L(0); PG8_MMA(1, 0, At, B0); PG8_BAR; PG8_SCHED;
            PG8_STAGE(PG8_SB(1, 1), b3 + hstep, voffB);
            PG8_WAIT_V(6); PG8_BAR; PG8_MMA(1, 1, At, B1); PG8_BAR;
            }
        }
        if constexpr (ALIGN_EPI) { if (wr == 0) PG8_BAR; }
        if constexpr (!Epi::AFTER_DRAIN) { E(acc, cur, wr, wc, fr, fq); S.done(cur); }
        if (!has_next) break;
#pragma unroll
        for (int a = 0; a < 2; ++a)
#pragma unroll
            for (int b = 0; b < 2; ++b)
#pragma unroll
                for (int m = 0; m < 4; ++m)
#pragma unroll
                    for (int n = 0; n < 2; ++n) acc[a][b][m][n] = (f32x4){0.f, 0.f, 0.f, 0.f};
        cur = nxt; cA = nA; cB = nB; ++ui;
        if constexpr (ALIGN_EPI) { if (wr == 1) PG8_BAR; }
    }
    PG8_WAIT_V(0);
    if constexpr (!ALIGN_EPI) { if (wr == 0) PG8_BAR; }
    PG8_BAR;
    if constexpr (Epi::AFTER_DRAIN) { E.fused(acc, cur, wr, wc, fr, fq, lds, wid, lane); S.done(cur); }
#undef PG8_SA
#undef PG8_SB
#undef PG8_STAGE
#undef PG8_LDA
#undef PG8_LDB
#undef PG8_MMA
#undef PG8_WAIT_V
#undef PG8_WAIT_L
#undef PG8_BAR
#undef PG8_SCHED
}
}

namespace cg = cooperative_groups;
#define LAS __attribute__((address_space(3)))
typedef unsigned short bf16;
typedef float f32x4 __attribute__((ext_vector_type(4)));
typedef float f32x2 __attribute__((ext_vector_type(2)));
typedef unsigned u32x4 __attribute__((ext_vector_type(4)));
typedef unsigned u32x2 __attribute__((ext_vector_type(2)));
typedef short bf16x8 __attribute__((ext_vector_type(8)));
typedef short bf16x4 __attribute__((ext_vector_type(4)));

constexpr int T = 16384, D = 1024, FF = 4096, DIN = 3328, NWAVES = 8;
constexpr int LDS_BYTES = 147456;
constexpr size_t KiB = 1024, MiB = 1024 * 1024;
constexpr size_t WS_BON = 0;
constexpr size_t WS_EST = 1 * MiB;
constexpr size_t WS_S5P = 5 * MiB;
constexpr size_t WS_STA = 8 * MiB, WS_STB = 10 * MiB;
constexpr size_t W_IN = 12 * MiB, W_LORA = W_IN + 6656 * KiB, W_OUT = W_LORA + 768 * KiB, W_UP0 = W_OUT + 2 * MiB, W_DN0 = W_UP0 + 8 * MiB, W_G0 = W_DN0 + 8 * MiB,
                 W_P0 = W_G0 + 2 * MiB, W_GLU = W_P0 + 512 * KiB, W_UP1 = W_GLU + 4 * MiB, W_DN1 = W_UP1 + 8 * MiB, W_G1 = W_DN1 + 8 * MiB, W_P1 = W_G1 + 2 * MiB;
static_assert(W_P1 + 512 * KiB <= 64 * MiB, "weights");
constexpr size_t WS_PBF = 64 * MiB;
constexpr size_t WS_B1 = 80 * MiB, WS_B2 = 112 * MiB;
constexpr size_t WS_R = 144 * MiB, WS_E = 192 * MiB, WS_A = 208 * MiB, WS_KP = 224 * MiB;
constexpr size_t WS_HID = 112 * MiB;
constexpr size_t WS_PP = 144 * MiB, WS_YG = 144 * MiB;
constexpr size_t WS_ESEG = 1 * MiB, WS_MSEG = 240 * MiB;
constexpr size_t WS_END = 244 * MiB;
constexpr size_t DO_ZB = 0, DO_X = 48 * MiB, DO_AP = 56 * MiB, DO_KK = 48 * MiB, DO_G = 0, DO_RS = 16 * MiB, DO_VS = 32 * MiB;
constexpr size_t WS_Y = 144 * MiB;

__device__ __forceinline__ size_t hm8(int t, int lane) { return ((size_t)(lane >> 3) * T + t) * 64 + (lane & 7) * 8; }
__device__ __forceinline__ float bflo(unsigned w) { return __uint_as_float(w << 16); }
__device__ __forceinline__ float bfhi(unsigned w) { return __uint_as_float(w & 0xffff0000u); }
__device__ __forceinline__ unsigned pk2(float lo, float hi) { return pg8::cvt_pk_bf16(lo, hi); }
__device__ __forceinline__ void unpack8(const u32x4 w, float (&f)[8]) { f[0] = bflo(w.x); f[1] = bfhi(w.x); f[2] = bflo(w.y); f[3] = bfhi(w.y); f[4] = bflo(w.z); f[5] = bfhi(w.z); f[6] = bflo(w.w); f[7] = bfhi(w.w); }
__device__ __forceinline__ u32x4 pack8(const float (&f)[8]) { u32x4 w; w.x = pk2(f[0], f[1]); w.y = pk2(f[2], f[3]); w.z = pk2(f[4], f[5]); w.w = pk2(f[6], f[7]); return w; }
__device__ __forceinline__ float wave_sum(float v) {
#pragma unroll
    for (int o = 1; o < 64; o <<= 1) v += __shfl_xor(v, o);
    return v;
}
__device__ __forceinline__ float sum8(float v) { v += __shfl_xor(v, 1); v += __shfl_xor(v, 2); v += __shfl_xor(v, 4); return v; }
template <int CTRL, int RM> __device__ __forceinline__ float dpp0(float x) {
    return __builtin_bit_cast(float, __builtin_amdgcn_update_dpp(0, __builtin_bit_cast(int, x), CTRL, RM, 0xf, false));
}
__device__ __forceinline__ float wave_sum_dpp(float x) {
    x += dpp0<0xB1, 0xf>(x);
    x += dpp0<0x4E, 0xf>(x);
    x += dpp0<0x141, 0xf>(x);
    x += dpp0<0x140, 0xf>(x);
    x += dpp0<0x142, 0xa>(x);
    x += dpp0<0x143, 0xc>(x);
    return __builtin_bit_cast(float, __builtin_amdgcn_readlane(__builtin_bit_cast(int, x), 63));
}
__device__ __forceinline__ float gelu_tanh(float x) {
    const float u = 0.7978845608f * (x + 0.044715f * x * x * x);
    const float e = __expf(2.0f * u);
    const float th = 1.0f - 2.0f * __builtin_amdgcn_rcpf(e + 1.0f);
    return 0.5f * x * (1.0f + th);
}

__device__ __forceinline__ void tr_item(const float* W, int K, int N, bf16* WT, int mode, const float* gain, LAS float* scr, int item, int lane) {
    const int nblk = N / 32, kb = item / nblk, nb = item % nblk, k0 = 64 * kb, n0 = 32 * nb;
#pragma unroll 8
    for (int i = 0; i < 32; ++i) { const int kk = 2 * i + (lane >> 5); float v = W[(size_t)(k0 + kk) * N + n0 + (lane & 31)]; if (gain) v *= gain[k0 + kk]; scr[kk * 33 + (lane & 31)] = v; }
    asm volatile("s_waitcnt lgkmcnt(0)" ::: "memory");
    const int c = lane & 7;
#pragma unroll
    for (int j = 0; j < 4; ++j) { const int n = (lane >> 3) + 8 * j; const LAS float* s = scr + (8 * c) * 33 + n;
        u32x4 o; o.x = pk2(s[0 * 33], s[1 * 33]); o.y = pk2(s[2 * 33], s[3 * 33]); o.z = pk2(s[4 * 33], s[5 * 33]); o.w = pk2(s[6 * 33], s[7 * 33]);
        const int ng = n0 + n; const int row = mode == 0 ? ng : (256 * (ng >> 7) + (ng & 127) + (mode == 2 ? 128 : 0));
        *(u32x4*)(WT + (size_t)row * K + k0 + 8 * c) = o; }
    asm volatile("s_waitcnt lgkmcnt(0)" ::: "memory");
}

#define RLX_AGENT __ATOMIC_RELAXED, __HIP_MEMORY_SCOPE_AGENT
#define XB_TMO      128
#define XB_XCNT(j)  (256  + 64 * (j))
#define XB_XSUB(j)  (1280 + 64 * (j))
#define XB_XGEN(j)  (2304 + 64 * (j))
#define XB_TOP      3328
#define XB_TOPGEN   3392
#define XCD_BAR_WORDS 3456
#define XB_SPIN_CAP (1u << 18)

__device__ __forceinline__ unsigned xb_ld(unsigned* p)              { return __hip_atomic_load(p, __ATOMIC_RELAXED, __HIP_MEMORY_SCOPE_AGENT); }
__device__ __forceinline__ unsigned xb_add(unsigned* p, unsigned v) { return __hip_atomic_fetch_add(p, v, __ATOMIC_RELAXED, __HIP_MEMORY_SCOPE_AGENT); }
__device__ __forceinline__ unsigned xb_xcc_id() { return (unsigned)__builtin_amdgcn_s_getreg((3 << 11) | 20) & 0xFu; }
#define XB_SPIN(cond, bar) do { unsigned _sp = 0; while (cond) { __builtin_amdgcn_s_sleep(1); \
    if ((++_sp & 255u) == 0u) { if (xb_ld(&(bar)[XB_TMO])) break; if (_sp > XB_SPIN_CAP) { atomicAdd(&(bar)[XB_TMO], 1u); break; } } } } while (0)

struct XcdBarrier {
    unsigned* bar; unsigned x;
    volatile LAS unsigned* st;
};

__device__ __forceinline__ XcdBarrier xcd_barrier_post(unsigned* bar, volatile LAS unsigned* st) {
    XcdBarrier b; b.bar = bar; b.x = xb_xcc_id(); b.st = st;
    if (threadIdx.x == 0) (void)xb_add(&bar[XB_XCNT(b.x)], 1u);
    return b;
}
__device__ __forceinline__ void xcd_barrier_complete(unsigned* bar, unsigned x, unsigned& nloc, unsigned& nx) {
    const unsigned G = gridDim.x * gridDim.y * gridDim.z;
    unsigned sum, cnt, mine, sp = 0u;
    for (;;) {
        sum = 0u; cnt = 0u; mine = 0u;
#pragma unroll
        for (unsigned j = 0; j < 16; ++j) { const unsigned c = xb_ld(&bar[XB_XCNT(j)]); sum += c; cnt += (c > 0u) ? 1u : 0u; mine = (j == x) ? c : mine; }
        if (sum == G) break;
        __builtin_amdgcn_s_sleep(1);
        if ((++sp & 255u) == 0u) { if (xb_ld(&bar[XB_TMO])) break; if (sp > XB_SPIN_CAP) { atomicAdd(&bar[XB_TMO], 1u); break; } }
    }
    nloc = mine > 0u ? mine : 1u; nx = cnt > 0u ? cnt : 1u;
}

__device__ __forceinline__ void xcd_barrier(const XcdBarrier& b) {
    asm volatile("s_waitcnt vmcnt(0)" ::: "memory");
    __syncthreads();
    if (threadIdx.x == 0) {
        unsigned* bar = b.bar;
        __builtin_amdgcn_s_waitcnt(0);
        unsigned nloc = b.st[0], nx = b.st[1];
        if (nloc == 0u) { xcd_barrier_complete(bar, b.x, nloc, nx); b.st[0] = nloc; b.st[1] = nx; }
        const unsigned old = xb_add(&bar[XB_XSUB(b.x)], 1u);
        const unsigned gen = old / nloc;
        if (old + 1u == (gen + 1u) * nloc) {
            __builtin_amdgcn_fence(__ATOMIC_RELEASE, "agent");
            asm volatile("s_waitcnt vmcnt(0)" ::: "memory");
            const unsigned og = xb_add(&bar[XB_TOP], 1u);
            const unsigned tg = og / nx;
            if (og + 1u == (tg + 1u) * nx) xb_add(&bar[XB_TOPGEN], 1u);
            else XB_SPIN(xb_ld(&bar[XB_TOPGEN]) == tg, bar);
            __builtin_amdgcn_fence(__ATOMIC_ACQUIRE, "agent");
            xb_add(&bar[XB_XGEN(b.x)], 1u);
            asm volatile("s_waitcnt vmcnt(0)" ::: "memory");
        } else {
            XB_SPIN(xb_ld(&bar[XB_XGEN(b.x)]) == gen, bar);
            __builtin_amdgcn_fence(__ATOMIC_ACQUIRE, "agent");
            asm volatile("s_waitcnt vmcnt(0)" ::: "memory");
        }
    }
    __syncthreads();
}

constexpr size_t WS_BAR = 6 * MiB;
struct Args { const float* in[41]; float* out; unsigned char* ws; };
typedef const __attribute__((address_space(4))) Args* KArgs;
__device__ __forceinline__ KArgs kargs() { KArgs p = (KArgs)__builtin_amdgcn_kernarg_segment_ptr(); asm volatile("" : "+s"(p)); return p; }


#define STA ((float*)(ws + WS_STA))
#define STB ((float*)(ws + WS_STB))
#define B1 ((bf16*)(ws + WS_B1))
#define B2 ((bf16*)(ws + WS_B2))
#define Rb ((bf16*)(ws + WS_R))
#define Kb (Rb + (size_t)T * 512)
#define Vb (Rb + (size_t)T * 1024)
#define Eb ((bf16*)(ws + WS_E))
#define Ab ((bf16*)(ws + WS_A))
#define KPb ((bf16*)(ws + WS_KP))
#define ZB ((bf16*)(dob + DO_ZB))
#define Xb ((bf16*)(dob + DO_X))
#define APb ((bf16*)(dob + DO_AP))
#define KKb ((bf16*)(dob + DO_KK))
#define Gb ((bf16*)(dob + DO_G))
#define RSb ((bf16*)(dob + DO_RS))
#define VSb ((bf16*)(dob + DO_VS))
#define BON ((float*)(ws + WS_BON))
#define HID ((bf16*)(ws + WS_HID))
#define PP ((bf16*)(ws + WS_PP))
#define YG ((bf16*)(ws + WS_YG))
#define PBF ((bf16*)(ws + WS_PBF))
#define EST ((f32x2*)(ws + WS_EST))
#define LB ((f32x2*)(ws + WS_S5P))
#define LBL (LB + 4096)
#define BB (LB + 8192)
#define PHASE_ARGS KArgs ka = kargs(); unsigned char* const ws = ka->ws; unsigned char* const dob = (unsigned char*)ka->out; (void)dob; int tid_p = threadIdx.x; asm volatile("" : "+v"(tid_p)); const int tid = tid_p, lane = tid & 63, wave = __builtin_amdgcn_readfirstlane(tid >> 6), gw = bid * NWAVES + wave, NGW = G * NWAVES; (void)gw; (void)NGW; (void)lane;

template <int pass> __device__ __forceinline__ void rwkv_seg_pass(LAS unsigned char* lds, unsigned char* const ws, unsigned char* const dob, const int bid, const int G, const int tid) {
    const int lane = tid & 63, wave = __builtin_amdgcn_readfirstlane(tid >> 6);
        constexpr int NCL = 32, NS = 10, SLOT = 12288;
        float* ESEG = (float*)(ws + WS_ESEG); float* MSEG = (float*)(ws + WS_MSEG);
        for (int job = bid; job < 256; job += G) {
            const int h = job & 7, sg = job >> 3, c0 = sg * NCL;
            __syncthreads();
            if (wave >= 4) {
                const int lw = wave - 4;
                const unsigned char* srcb[3]; unsigned ldso[3];
#pragma unroll
                for (int i = 0; i < 3; ++i) { const int p = (lw * 3 + i) * 64 + lane; const int blk = p >> 7, seg = (p >> 3) & 15, part = (p & 7) ^ ((seg >> 1) & 7);
                    const bf16* base = blk == 0 ? Ab : (blk == 1 ? RSb : (blk == 2 ? KKb : (blk == 3 ? KPb : (blk == 4 ? Eb : VSb))));
                    srcb[i] = (const unsigned char*)(base + ((size_t)h * T + seg) * 64) + part * 16; ldso[i] = (unsigned)((lw * 3 + i) * 1024); }
#define RW_ISSUE(cc_) do { const int cq = c0 + ((cc_) < NCL ? (cc_) : NCL - 1); const unsigned so = (unsigned)(((cc_) % NS) * SLOT); _Pragma("unroll") for (int i = 0; i < 3; ++i) \
        __builtin_amdgcn_global_load_lds((const unsigned*)(srcb[i] + (size_t)cq * 2048), (LAS unsigned*)(lds + so + ldso[i]), 16, 0, 0); } while (0)
                for (int c = 0; c < NS - 1; ++c) RW_ISSUE(c);
                asm volatile("s_waitcnt vmcnt(21)" ::: "memory");
                __builtin_amdgcn_s_barrier();
                for (int c = 0; c < NCL; ++c) {
                    RW_ISSUE(c + NS - 1);
                    asm volatile("s_waitcnt vmcnt(21)" ::: "memory");
                    __builtin_amdgcn_s_barrier();
                }
                asm volatile("s_waitcnt vmcnt(0)" ::: "memory");
#undef RW_ISSUE
            } else {
                const int fr = lane & 15, q = lane >> 4;
                f32x4 ST[4], SI[4];
#pragma unroll
                for (int m = 0; m < 4; ++m) { ST[m] = (f32x4){0.f, 0.f, 0.f, 0.f}; const int d_ = 16 * wave + fr - 16 * m - 4 * q;
                    SI[m] = (f32x4){d_ == 0 ? 1.f : 0.f, d_ == 1 ? 1.f : 0.f, d_ == 2 ? 1.f : 0.f, d_ == 3 ? 1.f : 0.f}; }
                if (pass == 1) {
                    const float* Mh = MSEG + (size_t)h * 32 * 4096; const float* Eh = ESEG + (size_t)h * 32 * 4096;
                    for (int s = 0; s < sg; ++s) {
                        const float* Ms = Mh + (size_t)s * 4096; const float* Es = Eh + (size_t)s * 4096;
                        bf16x4 shi[4], slo[4];
#pragma unroll
                        for (int k = 0; k < 4; ++k) { const f32x4 x = ST[k]; u32x2 hw; hw.x = pk2(x[0], x[1]); hw.y = pk2(x[2], x[3]);
                            const f32x4 xh = (f32x4){bflo(hw.x), bfhi(hw.x), bflo(hw.y), bfhi(hw.y)}; const f32x4 xl = x - xh; u32x2 lw2; lw2.x = pk2(xl[0], xl[1]); lw2.y = pk2(xl[2], xl[3]);
                            shi[k] = __builtin_bit_cast(bf16x4, hw); slo[k] = __builtin_bit_cast(bf16x4, lw2); }
                        f32x4 nw[4];
#pragma unroll
                        for (int m = 0; m < 4; ++m) { const float* ep_ = Es + (size_t)(16 * m + 4 * q) * 64 + 16 * wave + fr; nw[m] = (f32x4){ep_[0], ep_[64], ep_[128], ep_[192]}; }
#pragma unroll
                        for (int m = 0; m < 4; ++m) {
#pragma unroll
                            for (int k = 0; k < 4; ++k) {
                                const f32x4 x = *(const f32x4*)(Ms + (size_t)(16 * m + fr) * 64 + 16 * k + 4 * q);
                                u32x2 hw; hw.x = pk2(x[0], x[1]); hw.y = pk2(x[2], x[3]);
                                const f32x4 xh = (f32x4){bflo(hw.x), bfhi(hw.x), bflo(hw.y), bfhi(hw.y)}; const f32x4 xl = x - xh; u32x2 lw2; lw2.x = pk2(xl[0], xl[1]); lw2.y = pk2(xl[2], xl[3]);
                                const bf16x4 ahi = __builtin_bit_cast(bf16x4, hw), alo = __builtin_bit_cast(bf16x4, lw2);
                                nw[m] = __builtin_amdgcn_mfma_f32_16x16x16bf16_1k(ahi, shi[k], nw[m], 0, 0, 0);
                                nw[m] = __builtin_amdgcn_mfma_f32_16x16x16bf16_1k(ahi, slo[k], nw[m], 0, 0, 0);
                                nw[m] = __builtin_amdgcn_mfma_f32_16x16x16bf16_1k(alo, shi[k], nw[m], 0, 0, 0);
                            }
                            asm volatile("" ::: "memory");
                        }
#pragma unroll
                        for (int m = 0; m < 4; ++m) ST[m] = nw[m];
                    }
                }
                bf16x4 cw[4], cr[4], cb[4], ck[4], cp, cmb, cmk, cv; f32x4 cg[4];
#define RW_SW(seg_, pc_) ((((pc_) ^ (((seg_) >> 1) & 7))) * 16)
#define RW_READ(cc_) do { const LAS unsigned char* sl = lds + ((cc_) % NS) * SLOT; \
        _Pragma("unroll") for (int m = 0; m < 4; ++m) { const int sg_ = 4 * m + (fr >> 2), gs_ = 12 + ((16 * m + 4 * q) >> 5); \
            cw[m] = *(const LAS bf16x4*)(sl + 0 * 2048 + fr * 128 + RW_SW(fr, 2 * m + (q >> 1)) + (q & 1) * 8); \
            cr[m] = *(const LAS bf16x4*)(sl + 1 * 2048 + fr * 128 + RW_SW(fr, 2 * m + (q >> 1)) + (q & 1) * 8); \
            cb[m] = *(const LAS bf16x4*)(sl + 2 * 2048 + sg_ * 128 + RW_SW(sg_, (fr & 3) * 2 + (q >> 1)) + (q & 1) * 8); \
            ck[m] = *(const LAS bf16x4*)(sl + 3 * 2048 + sg_ * 128 + RW_SW(sg_, (fr & 3) * 2 + (q >> 1)) + (q & 1) * 8); \
            cg[m] = *(const LAS f32x4*)(sl + 4 * 2048 + gs_ * 128 + RW_SW(gs_, ((16 * m + 4 * q) & 31) >> 2)); } \
        { const int s0_ = fr >> 2, s1_ = 4 + (fr >> 2), s2_ = 8 + (fr >> 2), pc_ = (fr & 3) * 2 + (q >> 1); \
        cp  = *(const LAS bf16x4*)(sl + 4 * 2048 + s0_ * 128 + RW_SW(s0_, pc_) + (q & 1) * 8); \
        cmb = *(const LAS bf16x4*)(sl + 4 * 2048 + s1_ * 128 + RW_SW(s1_, pc_) + (q & 1) * 8); \
        cmk = *(const LAS bf16x4*)(sl + 4 * 2048 + s2_ * 128 + RW_SW(s2_, pc_) + (q & 1) * 8); } \
        _Pragma("unroll") for (int jj = 0; jj < 4; ++jj) cv[jj] = *(const LAS short*)(sl + 5 * 2048 + (4 * q + jj) * 128 + RW_SW(4 * q + jj, 2 * wave + (fr >> 3)) + (fr & 7) * 2); } while (0)
                __builtin_amdgcn_s_barrier();
                RW_READ(0);
                float* yout = (float*)(ws + WS_Y) + ((size_t)h * T + (size_t)c0 * 16) * 64 + 16 * wave + fr;
                for (int c = 0; c < NCL; ++c) {
                    const bf16x4 w0 = cw[0], w1 = cw[1], w2 = cw[2], w3 = cw[3], r0 = cr[0], r1 = cr[1], r2 = cr[2], r3 = cr[3];
                    const bf16x4 b0 = cb[0], b1 = cb[1], b2 = cb[2], b3 = cb[3], k0 = ck[0], k1 = ck[1], k2 = ck[2], k3 = ck[3];
                    const bf16x4 pp_ = cp, mb_ = cmb, mk_ = cmk, vv_ = cv; const f32x4 g0 = cg[0], g1 = cg[1], g2 = cg[2], g3 = cg[3];
                    if (c + 1 < NCL) RW_READ(c + 1);
                    bf16x4 sb[4];
#pragma unroll
                    for (int m = 0; m < 4; ++m) { u32x2 t2; t2.x = pk2(ST[m][0], ST[m][1]); t2.y = pk2(ST[m][2], ST[m][3]); sb[m] = __builtin_bit_cast(bf16x4, t2); }
                    const f32x4 z4 = (f32x4){0.f, 0.f, 0.f, 0.f};
                    f32x4 ua = __builtin_amdgcn_mfma_f32_16x16x16bf16_1k(pp_, vv_, z4, 0, 0, 0);
                    f32x4 ub = __builtin_amdgcn_mfma_f32_16x16x16bf16_1k(w0, sb[0], z4, 0, 0, 0);
                    ua = __builtin_amdgcn_mfma_f32_16x16x16bf16_1k(w1, sb[1], ua, 0, 0, 0);
                    ub = __builtin_amdgcn_mfma_f32_16x16x16bf16_1k(w2, sb[2], ub, 0, 0, 0);
                    ua = __builtin_amdgcn_mfma_f32_16x16x16bf16_1k(w3, sb[3], ua, 0, 0, 0);
                    if (pass == 0) {
                        bf16x4 si[4];
#pragma unroll
                        for (int m = 0; m < 4; ++m) { u32x2 t2; t2.x = pk2(SI[m][0], SI[m][1]); t2.y = pk2(SI[m][2], SI[m][3]); si[m] = __builtin_bit_cast(bf16x4, t2); }
                        f32x4 va = __builtin_amdgcn_mfma_f32_16x16x16bf16_1k(w0, si[0], z4, 0, 0, 0);
                        f32x4 vb = __builtin_amdgcn_mfma_f32_16x16x16bf16_1k(w1, si[1], z4, 0, 0, 0);
                        va = __builtin_amdgcn_mfma_f32_16x16x16bf16_1k(w2, si[2], va, 0, 0, 0);
                        vb = __builtin_amdgcn_mfma_f32_16x16x16bf16_1k(w3, si[3], vb, 0, 0, 0);
                        const f32x4 vt = va + vb; u32x2 v2; v2.x = pk2(vt[0], vt[1]); v2.y = pk2(vt[2], vt[3]); const bf16x4 vbf = __builtin_bit_cast(bf16x4, v2);
                        SI[0] = __builtin_amdgcn_mfma_f32_16x16x16bf16_1k(b0, vbf, SI[0] * g0, 0, 0, 0);
                        SI[1] = __builtin_amdgcn_mfma_f32_16x16x16bf16_1k(b1, vbf, SI[1] * g1, 0, 0, 0);
                        SI[2] = __builtin_amdgcn_mfma_f32_16x16x16bf16_1k(b2, vbf, SI[2] * g2, 0, 0, 0);
                        SI[3] = __builtin_amdgcn_mfma_f32_16x16x16bf16_1k(b3, vbf, SI[3] * g3, 0, 0, 0);
                    }
                    f32x4 ya = z4, yb = z4;
                    if (pass == 1) {
                        ya = __builtin_amdgcn_mfma_f32_16x16x16bf16_1k(mk_, vv_, z4, 0, 0, 0);
                        yb = __builtin_amdgcn_mfma_f32_16x16x16bf16_1k(r0, sb[0], z4, 0, 0, 0);
                        ya = __builtin_amdgcn_mfma_f32_16x16x16bf16_1k(r1, sb[1], ya, 0, 0, 0);
                        yb = __builtin_amdgcn_mfma_f32_16x16x16bf16_1k(r2, sb[2], yb, 0, 0, 0);
                        ya = __builtin_amdgcn_mfma_f32_16x16x16bf16_1k(r3, sb[3], ya, 0, 0, 0);
                    }
                    ST[0] = __builtin_amdgcn_mfma_f32_16x16x16bf16_1k(k0, vv_, ST[0] * g0, 0, 0, 0);
                    ST[1] = __builtin_amdgcn_mfma_f32_16x16x16bf16_1k(k1, vv_, ST[1] * g1, 0, 0, 0);
                    ST[2] = __builtin_amdgcn_mfma_f32_16x16x16bf16_1k(k2, vv_, ST[2] * g2, 0, 0, 0);
                    ST[3] = __builtin_amdgcn_mfma_f32_16x16x16bf16_1k(k3, vv_, ST[3] * g3, 0, 0, 0);
                    const f32x4 ut = ua + ub;
                    u32x2 u2; u2.x = pk2(ut[0], ut[1]); u2.y = pk2(ut[2], ut[3]); const bf16x4 ubf = __builtin_bit_cast(bf16x4, u2);
                    ST[0] = __builtin_amdgcn_mfma_f32_16x16x16bf16_1k(b0, ubf, ST[0], 0, 0, 0);
                    ST[1] = __builtin_amdgcn_mfma_f32_16x16x16bf16_1k(b1, ubf, ST[1], 0, 0, 0);
                    ST[2] = __builtin_amdgcn_mfma_f32_16x16x16bf16_1k(b2, ubf, ST[2], 0, 0, 0);
                    ST[3] = __builtin_amdgcn_mfma_f32_16x16x16bf16_1k(b3, ubf, ST[3], 0, 0, 0);
                    if (pass == 1) {
                        ya = __builtin_amdgcn_mfma_f32_16x16x16bf16_1k(mb_, ubf, ya, 0, 0, 0);
                        const f32x4 yt = ya + yb;
#pragma unroll
                        for (int jj = 0; jj < 4; ++jj) yout[(size_t)(c * 16 + 4 * q + jj) * 64] = yt[jj];
                    }
                    __builtin_amdgcn_s_barrier();
                }
#undef RW_READ
#undef RW_SW
                if (pass == 0) {
                    float* Es = ESEG + ((size_t)h * 32 + sg) * 4096; float* Ms = MSEG + ((size_t)h * 32 + sg) * 4096;
#pragma unroll
                    for (int m = 0; m < 4; ++m)
#pragma unroll
                        for (int v = 0; v < 4; ++v) { const size_t o = (size_t)(16 * m + 4 * q + v) * 64 + 16 * wave + fr; Es[o] = ST[m][v]; Ms[o] = SI[m][v]; }
                }
            }
        }
}

__global__ void __launch_bounds__(NWAVES * 64, 2) mega_fwd(Args a) {
    extern __shared__ __attribute__((aligned(16))) unsigned char lds_raw[];
    LAS unsigned char* lds = (LAS unsigned char*)lds_raw;
    cg::grid_group grid = cg::this_grid();
    const int G = gridDim.x, bid = blockIdx.x;
    volatile LAS unsigned* xst = (volatile LAS unsigned*)(lds + 131072);
    if (threadIdx.x < 2) xst[threadIdx.x] = 0u;
    __syncthreads();
    XcdBarrier xbar = xcd_barrier_post((unsigned*)(((KArgs)__builtin_amdgcn_kernarg_segment_ptr())->ws + WS_BAR), xst);
#define GSYNC() xcd_barrier(xbar)
#define GSYNC_CG() do { asm volatile("s_waitcnt vmcnt(0)" ::: "memory"); __syncthreads(); if (threadIdx.x == 0) __builtin_amdgcn_fence(__ATOMIC_RELEASE, "agent"); grid.sync(); __builtin_amdgcn_fence(__ATOMIC_ACQUIRE, "agent"); asm volatile("s_waitcnt vmcnt(0)" ::: "memory"); } while (0)

    {
        PHASE_ARGS
        LAS float* scr = (LAS float*)(lds + wave * 16384);
        constexpr int I_IN = 16 * (DIN / 32), I_SQ = 16 * 32, I_UP = 16 * 128, I_DN = 64 * 32, I_PR = 4 * 32;
        constexpr int NITEMS = I_IN + I_SQ + I_UP + I_DN + I_SQ + I_PR + 2 * I_SQ + I_UP + I_DN + I_SQ + I_PR;
        for (int it = gw; it < NITEMS; it += NGW) {
            int r = it;
            if (r < I_IN) { tr_item(ka->in[3], D, DIN, (bf16*)(ws + W_IN), 0, ka->in[2], scr, r, lane); continue; } r -= I_IN;
            if (r < I_SQ) { tr_item(ka->in[16], D, D, (bf16*)(ws + W_OUT), 0, nullptr, scr, r, lane); continue; } r -= I_SQ;
            if (r < I_UP) { tr_item(ka->in[18], D, FF, (bf16*)(ws + W_UP0), 0, ka->in[17], scr, r, lane); continue; } r -= I_UP;
            if (r < I_DN) { tr_item(ka->in[19], FF, D, (bf16*)(ws + W_DN0), 0, nullptr, scr, r, lane); continue; } r -= I_DN;
            if (r < I_SQ) { tr_item(ka->in[21], D, D, (bf16*)(ws + W_G0), 0, ka->in[20], scr, r, lane); continue; } r -= I_SQ;
            if (r < I_PR) { tr_item(ka->in[22], 256, D, (bf16*)(ws + W_P0), 0, nullptr, scr, r, lane); continue; } r -= I_PR;
            if (r < I_SQ) { tr_item(ka->in[32], D, D, (bf16*)(ws + W_GLU), 1, nullptr, scr, r, lane); continue; } r -= I_SQ;
            if (r < I_SQ) { tr_item(ka->in[33], D, D, (bf16*)(ws + W_GLU), 2, nullptr, scr, r, lane); continue; } r -= I_SQ;
            if (r < I_UP) { tr_item(ka->in[35], D, FF, (bf16*)(ws + W_UP1), 0, ka->in[34], scr, r, lane); continue; } r -= I_UP;
            if (r < I_DN) { tr_item(ka->in[36], FF, D, (bf16*)(ws + W_DN1), 0, nullptr, scr, r, lane); continue; } r -= I_DN;
            if (r < I_SQ) { tr_item(ka->in[38], D, D, (bf16*)(ws + W_G1), 0, ka->in[37], scr, r, lane); continue; } r -= I_SQ;
            tr_item(ka->in[39], 256, D, (bf16*)(ws + W_P1), 0, nullptr, scr, r, lane);
        }
        {
            bf16* WL = (bf16*)(ws + W_LORA); const float* wl = ka->in[6]; const float* al = ka->in[8]; const float* gl = ka->in[9];
            for (int i = bid * 512 + tid; i < 1536 * 256; i += G * 512) {
                const int n = i >> 8, k = i & 255; float v = 0.f;
                if (n < 512) { if (k < 64) v = wl[k * 512 + n]; }
                else if (n < 1024) { if (k >= 64 && k < 128) v = al[(k - 64) * 512 + (n - 512)]; }
                else { if (k >= 128) v = gl[(k - 128) * 512 + (n - 1024)]; }
                WL[i] = (bf16)(pk2(v, 0.f) & 0xffffu);
            }
        }
        for (int m = gw; m < T; m += NGW) {
            const f32x4* xr = (const f32x4*)(ka->in[0] + (size_t)m * D) + lane; f32x4 v[4]; float s = 0.f;
#pragma unroll
            for (int j = 0; j < 4; ++j) { v[j] = xr[64 * j]; s += (v[j][0] * v[j][0] + v[j][1] * v[j][1]) + (v[j][2] * v[j][2] + v[j][3] * v[j][3]); }
            s = wave_sum(s);
            u32x2* o8 = (u32x2*)(B1 + (size_t)m * D) + lane;
#pragma unroll
            for (int j = 0; j < 4; ++j) { u32x2 w; w.x = pk2(v[j][0], v[j][1]); w.y = pk2(v[j][2], v[j][3]); o8[64 * j] = w; }
            if (lane < 16) STA[(size_t)m * 32 + lane] = lane == 0 ? s : 0.f;
        }
        {
            const f32x4* ps = (const f32x4*)ka->in[1]; u32x2* pd = (u32x2*)PBF;
            for (int i = bid * 512 + tid; i < 2 * T * 256 / 4; i += G * 512) { const f32x4 v = ps[i]; u32x2 w; w.x = pk2(v[0], v[1]); w.y = pk2(v[2], v[3]); pd[i] = w; }
        }
        for (int i = bid * 512 + tid; i < 4096; i += G * 512) {
            const int g = i >> 6;
            const float step = expf(ka->in[26][g]); const float lre = fminf(ka->in[24][i], -1e-4f), lim = ka->in[25][i];
            const float x = lre * step, ang = lim * step; float sn, cs; sincosf(ang, &sn, &cs);
            const float er = expf(x); const float lbr = er * cs, lbi = er * sn;
            const float sh = sinf(0.5f * ang); const float nr = expm1f(x) * cs - 2.f * sh * sh, ni = lbi;
            const float d = lre * lre + lim * lim; const float qr = (nr * lre + ni * lim) / d, qi = (ni * lre - nr * lim) / d;
            LB[i] = (f32x2){lbr, lbi};
            float pr = lbr, pi = lbi;
#pragma unroll
            for (int q = 0; q < 7; ++q) { const float tr = pr * pr - pi * pi, ti = 2.f * pr * pi; pr = tr; pi = ti; }
            LBL[i] = (f32x2){pr, pi};
            for (int c = 0; c < 16; ++c) { const float br = ka->in[27][(size_t)i * 16 + c], bi = ka->in[28][(size_t)i * 16 + c]; BB[(size_t)i * 16 + c] = (f32x2){qr * br - qi * bi, qr * bi + qi * br}; }
        }
    }
    GSYNC_CG();

    {
        PHASE_ARGS
        pg8::Gemm g{B1, (const bf16*)(ws + W_IN), T, DIN, D}; pg8::StaticOrder S; S.init(T, DIN, G, bid);
        pg8::EpiB<0, 16> E{Rb, Xb, ZB, STA, nullptr, nullptr, 0};
        pg8::gemm_phase<pg8::EpiB<0, 16>, pg8::StaticOrder, true, true>(lds, g, S, E);
    }
    GSYNC();

    {
        PHASE_ARGS
        const float* mu = ka->in[4]; const float* cw = ka->in[15];
        for (int t = gw; t < T; t += NGW) {
            {
                const u32x2 x0 = *((const u32x2*)(Xb + (size_t)t * 256) + lane);
                u32x2 x1 = (u32x2){0u, 0u}; if (t > 0) x1 = *((const u32x2*)(Xb + (size_t)(t - 1) * 256) + lane);
                const f32x4 m4 = *((const f32x4*)(mu + 1536) + lane);
                float c[4] = {bflo(x0.x), bfhi(x0.x), bflo(x0.y), bfhi(x0.y)}, p[4] = {bflo(x1.x), bfhi(x1.x), bflo(x1.y), bfhi(x1.y)}, o[4];
#pragma unroll
                for (int e = 0; e < 4; ++e) { const float xs = c[e] + m4[e] * (p[e] - c[e]);
                    o[e] = lane < 16 ? tanhf(xs) : (lane < 32 ? xs : pg8::fsigmoid(xs)); }
                u32x2 w; w.x = pk2(o[0], o[1]); w.y = pk2(o[2], o[3]); *((u32x2*)(APb + (size_t)t * 256) + lane) = w;
            }
            {
                const bf16* z0 = ZB + (size_t)t * 1536; float bg[8], c0[8], x0[8], c1[8], x1[8], c2[8], x2[8];
                unpack8(*((const u32x4*)z0 + lane), bg); unpack8(*((const u32x4*)(z0 + 512) + lane), c0); unpack8(*((const u32x4*)(z0 + 1024) + lane), x0);
                const u32x4 zz = (u32x4){0u, 0u, 0u, 0u};
                unpack8(t > 0 ? *((const u32x4*)(z0 - 1536 + 512) + lane) : zz, c1); unpack8(t > 0 ? *((const u32x4*)(z0 - 1536 + 1024) + lane) : zz, x1);
                unpack8(t > 1 ? *((const u32x4*)(z0 - 3072 + 512) + lane) : zz, c2); unpack8(t > 1 ? *((const u32x4*)(z0 - 3072 + 1024) + lane) : zz, x2);
                float o[8];
#pragma unroll
                for (int e = 0; e < 8; ++e) { const int ch = 8 * lane + e; o[e] = bg[e] * (cw[ch] * (c0[e] * x0[e]) + cw[512 + ch] * (c1[e] * x1[e]) + cw[1024 + ch] * (c2[e] * x2[e])); }
                *((u32x4*)(B2 + (size_t)t * D + 512) + lane) = pack8(o);
            }
        }
    }
    GSYNC();

    {
        PHASE_ARGS
        pg8::Gemm g{APb, (const bf16*)(ws + W_LORA), T, 1536, 256}; pg8::StaticOrder S; S.init(T, 1536, G, bid);
        pg8::EpiB<1, 16> E{Eb, Ab, Gb, nullptr, ka->in[5], ka->in[7], 0};
        pg8::gemm_phase<pg8::EpiB<1, 16>, pg8::StaticOrder, true, true>(lds, g, S, E);
    }
    GSYNC();

    {
        PHASE_ARGS
        const float* mu = ka->in[4]; const float* k_k = ka->in[10]; const float* k_a = ka->in[11]; const float* r_k = ka->in[12];
        float mr[8], mk[8], mv[8], kk_[8], ka_[8], rk_[8];
#pragma unroll
        for (int e = 0; e < 8; ++e) { const int ch = 8 * lane + e; mr[e] = mu[ch]; mk[e] = mu[512 + ch]; mv[e] = mu[1024 + ch]; kk_[e] = k_k[ch]; ka_[e] = k_a[ch]; rk_[e] = r_k[ch]; }
        for (int t = gw; t < T; t += NGW) {
            float k0[8], k1[8], r0[8], r1[8], v0[8], v1[8], av[8];
            const u32x4 zz = (u32x4){0u, 0u, 0u, 0u};
            unpack8(*((const u32x4*)(Kb + (size_t)t * 512) + lane), k0); unpack8(t > 0 ? *((const u32x4*)(Kb + (size_t)(t - 1) * 512) + lane) : zz, k1);
            unpack8(*((const u32x4*)(Rb + (size_t)t * 512) + lane), r0); unpack8(t > 0 ? *((const u32x4*)(Rb + (size_t)(t - 1) * 512) + lane) : zz, r1);
            unpack8(*((const u32x4*)(Vb + (size_t)t * 512) + lane), v0); unpack8(t > 0 ? *((const u32x4*)(Vb + (size_t)(t - 1) * 512) + lane) : zz, v1);
            unpack8(*(const u32x4*)(Ab + hm8(t, lane)), av);
            float kp[8], kn[8], rs[8], vs[8]; float ss = 0.f, bs = 0.f;
#pragma unroll
            for (int e = 0; e < 8; ++e) {
                const float ks = k0[e] + mk[e] * (k1[e] - k0[e]); rs[e] = r0[e] + mr[e] * (r1[e] - r0[e]); vs[e] = v0[e] + mv[e] * (v1[e] - v0[e]);
                kn[e] = ks * kk_[e]; ss += kn[e] * kn[e];
                kp[e] = ks * (1.f + (av[e] - 1.f) * ka_[e]); bs += rs[e] * kp[e] * rk_[e];
            }
            ss = sum8(ss); bs = sum8(bs);
            const float inv = 1.f / fmaxf(sqrtf(ss), 1e-12f);
#pragma unroll
            for (int e = 0; e < 8; ++e) kn[e] *= inv;
            *(u32x4*)(KPb + hm8(t, lane)) = pack8(kp);
            *(u32x4*)(KKb + hm8(t, lane)) = pack8(kn);
            *(u32x4*)(RSb + hm8(t, lane)) = pack8(rs);
            *(u32x4*)(VSb + hm8(t, lane)) = pack8(vs);
            if ((lane & 7) == 0) BON[(size_t)t * 8 + (lane >> 3)] = bs;
        }
    }
    GSYNC();

    {
        PHASE_ARGS
        constexpr int TS = 68;
        LAS bf16* TA = (LAS bf16*)(lds + wave * 12288);
        LAS bf16* TBh = TA + 16 * TS; LAS bf16* TKh = TBh + 16 * TS; LAS bf16* TR = TKh + 16 * TS;
        LAS float* MAB = (LAS float*)(lds + wave * 12288 + 8704);
        LAS float* MAK = MAB + 256; LAS float* TM = MAK + 256;
        for (int u = gw; u < 8192; u += NGW) {
            const int c = u >> 3, h = u & 7; const size_t bo = ((size_t)h * T + c * 16) * 64;
            float at[16], bh[16], kh[16], rt[16];
            {
                unsigned short e_[16], k_[16], a_[16], p_[16], r_[16];
#pragma unroll
                for (int t = 0; t < 16; ++t) { const size_t o = bo + (size_t)t * 64 + lane; e_[t] = Eb[o]; k_[t] = KKb[o]; a_[t] = Ab[o]; p_[t] = KPb[o]; r_[t] = RSb[o]; }
                float g = 1.f;
#pragma unroll
                for (int t = 0; t < 16; ++t) {
                    const float w = __builtin_amdgcn_exp2f(-bflo(e_[t])); const float gp = g; g *= w; const float gi = 1.0f / g;
                    const float kkv = bflo(k_[t]);
                    at[t] = -kkv * gp; bh[t] = kkv * bflo(a_[t]) * gi; kh[t] = bflo(p_[t]) * gi; rt[t] = bflo(r_[t]) * g;
                    TA[t * TS + lane] = (bf16)(pk2(at[t], 0.f) & 0xffffu); TBh[t * TS + lane] = (bf16)(pk2(bh[t], 0.f) & 0xffffu);
                    TKh[t * TS + lane] = (bf16)(pk2(kh[t], 0.f) & 0xffffu); TR[t * TS + lane] = (bf16)(pk2(rt[t], 0.f) & 0xffffu);
                }
                bf16* bbp = KKb + bo + (size_t)(lane >> 2) * 64 + (lane & 3) * 16; bf16* kbp = KPb + bo + (size_t)(lane >> 2) * 64 + (lane & 3) * 16;
                float tb[8], tk[8];
#pragma unroll
                for (int hh = 0; hh < 2; ++hh) {
#pragma unroll
                    for (int e = 0; e < 8; ++e) { tb[e] = bh[hh * 8 + e] * g; tk[e] = kh[hh * 8 + e] * g; }
                    *(u32x4*)(bbp + hh * 8) = pack8(tb); *(u32x4*)(kbp + hh * 8) = pack8(tk);
                }
                ((float*)(Eb + bo + (size_t)(12 + (lane >> 5)) * 64))[lane & 31] = g;
#pragma unroll
                for (int t = 0; t < 16; ++t) RSb[bo + (size_t)t * 64 + lane] = (bf16)(pk2(rt[t], 0.f) & 0xffffu);
            }
            const int fr = lane & 15, q = lane >> 4;
            f32x4 mab = (f32x4){0.f, 0.f, 0.f, 0.f}, mak = mab, mbr = mab, mkr = mab;
#pragma unroll
            for (int m = 0; m < 4; ++m) {
                const bf16x4 fb = *(const LAS bf16x4*)(TBh + fr * TS + 16 * m + 4 * q), fk = *(const LAS bf16x4*)(TKh + fr * TS + 16 * m + 4 * q);
                const bf16x4 fa = *(const LAS bf16x4*)(TA + fr * TS + 16 * m + 4 * q), frr = *(const LAS bf16x4*)(TR + fr * TS + 16 * m + 4 * q);
                mab = __builtin_amdgcn_mfma_f32_16x16x16bf16_1k(fb, fa, mab, 0, 0, 0); mak = __builtin_amdgcn_mfma_f32_16x16x16bf16_1k(fk, fa, mak, 0, 0, 0);
                mbr = __builtin_amdgcn_mfma_f32_16x16x16bf16_1k(fb, frr, mbr, 0, 0, 0); mkr = __builtin_amdgcn_mfma_f32_16x16x16bf16_1k(fk, frr, mkr, 0, 0, 0);
            }
#pragma unroll
            for (int jj = 0; jj < 4; ++jj) { const int s = 4 * q + jj;
                MAB[s * 16 + fr] = s < fr ? mab[jj] : 0.f; MAK[s * 16 + fr] = s < fr ? mak[jj] : 0.f;
                mbr[jj] = s <= fr ? mbr[jj] : 0.f; mkr[jj] = s <= fr ? mkr[jj] : 0.f; }
            {
                u32x2 w1, w2; w1.x = pk2(mbr[0], mbr[1]); w1.y = pk2(mbr[2], mbr[3]); w2.x = pk2(mkr[0], mkr[1]); w2.y = pk2(mkr[2], mkr[3]);
                *(u32x2*)(Eb + bo + (size_t)(4 + (fr >> 2)) * 64 + (fr & 3) * 16 + 4 * q) = w1;
                *(u32x2*)(Eb + bo + (size_t)(8 + (fr >> 2)) * 64 + (fr & 3) * 16 + 4 * q) = w2;
            }
            float tm[16];
#pragma unroll
            for (int t = 0; t < 16; ++t) { float acc = (t == fr) ? 1.f : 0.f;
#pragma unroll
                for (int s = 0; s < t; ++s) acc += tm[s] * MAB[s * 16 + t];
                tm[t] = acc; }
            if (q == 0) {
#pragma unroll
                for (int t = 0; t < 16; ++t) TM[fr * 16 + t] = tm[t];
            }
#pragma unroll
            for (int t = 0; t < 16; ++t) { float acc = 0.f;
#pragma unroll
                for (int s = 0; s <= t; ++s) acc += TM[s * 16 + t] * at[s];
                Ab[bo + (size_t)t * 64 + lane] = (bf16)(pk2(acc, 0.f) & 0xffffu); }
            {
                float p4[4] = {0.f, 0.f, 0.f, 0.f};
#pragma unroll
                for (int s2 = 0; s2 < 16; ++s2) { const float mk_ = MAK[fr * 16 + s2];
#pragma unroll
                    for (int e = 0; e < 4; ++e) p4[e] += mk_ * TM[s2 * 16 + 4 * q + e]; }
#pragma unroll
                for (int e = 0; e < 4; ++e) { const int t = 4 * q + e; Eb[bo + (size_t)(t >> 2) * 64 + (t & 3) * 16 + fr] = (bf16)(pk2(p4[e], 0.f) & 0xffffu); }
            }
        }
    }
    GSYNC();

    { PHASE_ARGS rwkv_seg_pass<0>(lds, ws, dob, bid, G, tid); }
    GSYNC();
    { PHASE_ARGS rwkv_seg_pass<1>(lds, ws, dob, bid, G, tid); }
    GSYNC();

    {
        PHASE_ARGS
        const float* lnw = ka->in[13]; const float* lnb = ka->in[14];
        float lw[8], lb[8];
#pragma unroll
        for (int e = 0; e < 8; ++e) { const int ch = 8 * lane + e; lw[e] = lnw[ch]; lb[e] = lnb[ch]; }
        const float* YRp = (const float*)(ws + WS_Y);
        for (int t = gw; t < T; t += NGW) {
            const f32x4 ya = *(const f32x4*)(YRp + hm8(t, lane)), yb = *(const f32x4*)(YRp + hm8(t, lane) + 4);
            float y[8] = {ya[0], ya[1], ya[2], ya[3], yb[0], yb[1], yb[2], yb[3]};
            float vs[8], gv[8];
            unpack8(*(const u32x4*)(VSb + hm8(t, lane)), vs);
            unpack8(*((const u32x4*)(Gb + (size_t)t * 512) + lane), gv);
            float s = 0.f;
#pragma unroll
            for (int e = 0; e < 8; ++e) s += y[e];
            const float mean = sum8(s) * (1.f / 64.f); float qv = 0.f;
#pragma unroll
            for (int e = 0; e < 8; ++e) { y[e] -= mean; qv += y[e] * y[e]; }
            const float rstd = rsqrtf(sum8(qv) * (1.f / 64.f) + 64e-5f);
            const float bon = BON[(size_t)t * 8 + (lane >> 3)];
            float o[8];
#pragma unroll
            for (int e = 0; e < 8; ++e) o[e] = (y[e] * rstd * lw[e] + lb[e] + bon * vs[e]) * gv[e];
            *((u32x4*)(B2 + (size_t)t * D) + lane) = pack8(o);
        }
    }
    GSYNC();

    {
        PHASE_ARGS
        pg8::Gemm g{B2, (const bf16*)(ws + W_OUT), T, D, D}; pg8::StaticOrder S; S.init(T, D, G, bid);
        pg8::EpiRes<0> E{ka->in[0], ka->out, B1, nullptr, STB, nullptr};
        pg8::gemm_phase<pg8::EpiRes<0>, pg8::StaticOrder, true, true>(lds, g, S, E);
    }
    GSYNC();
    {
        PHASE_ARGS
        pg8::Gemm g{B1, (const bf16*)(ws + W_UP0), T, FF, D}; pg8::StaticOrder S; S.init(T, FF, G, bid);
        pg8::EpiB<2, 16> E{HID, nullptr, nullptr, STB, nullptr, nullptr, FF};
        pg8::gemm_phase<pg8::EpiB<2, 16>, pg8::StaticOrder, true, true>(lds, g, S, E);
    }
    GSYNC();
    {
        PHASE_ARGS
        pg8::Gemm g{HID, (const bf16*)(ws + W_DN0), T, D, FF}; pg8::StaticOrder S; S.init(T, D, G, bid);
        pg8::EpiRes<0> E{ka->out, ka->out, B1, nullptr, STA, nullptr};
        pg8::gemm_phase<pg8::EpiRes<0>, pg8::StaticOrder, true, true>(lds, g, S, E);
    }
    GSYNC();
    {
        PHASE_ARGS
        pg8::Gemm g{PBF, (const bf16*)(ws + W_P0), T, D, 256}; pg8::StaticOrder S; S.init(T, D, G, bid);
        pg8::EpiB<3, 16> E{PP, nullptr, nullptr, nullptr, nullptr, nullptr, D};
        pg8::gemm_phase<pg8::EpiB<3, 16>, pg8::StaticOrder, true, true>(lds, g, S, E);
    }
    GSYNC();
    {
        PHASE_ARGS
        pg8::Gemm g{B1, (const bf16*)(ws + W_G0), T, D, D}; pg8::StaticOrder S; S.init(T, D, G, bid);
        pg8::EpiRes<1> E{ka->out, ka->out, B2, STA, STB, PP};
        pg8::gemm_phase<pg8::EpiRes<1>, pg8::StaticOrder, true, true>(lds, g, S, E);
    }
    GSYNC();

#pragma unroll 1
    for (int pass = 0; pass < 2; ++pass) {
        PHASE_ARGS
        LAS float* UT = (LAS float*)(lds + wave * 12800);
        LAS bf16* HS = (LAS bf16*)(lds + wave * 12800 + 8192);
        const float* gm = ka->in[23]; const float* dsk = ka->in[31];
        for (int u = gw; u < 8192; u += NGW) {
            const int ck = u >> 6, g = u & 63, t0 = ck * 128;
#pragma unroll
            for (int q = 0; q < 2; ++q) {
                const int tk = lane + 64 * q, t = t0 + tk;
                const f32x4* sp = (const f32x4*)(STB + (size_t)t * 32); const f32x4 s0 = sp[0], s1 = sp[1], s2 = sp[2], s3 = sp[3];
                const float ssq = ((s0[0] + s0[1]) + (s0[2] + s0[3])) + ((s1[0] + s1[1]) + (s1[2] + s1[3])) + ((s2[0] + s2[1]) + (s2[2] + s2[3])) + ((s3[0] + s3[1]) + (s3[2] + s3[3]));
                const float rs = rsqrtf(ssq * (1.f / 1024.f) + 1e-6f);
                float f0[8], f1[8]; unpack8(*(const u32x4*)(B2 + (size_t)t * D + 16 * g), f0); unpack8(*(const u32x4*)(B2 + (size_t)t * D + 16 * g + 8), f1);
                const f32x4 g0 = *(const f32x4*)(gm + 16 * g), g1 = *(const f32x4*)(gm + 16 * g + 4), g2 = *(const f32x4*)(gm + 16 * g + 8), g3 = *(const f32x4*)(gm + 16 * g + 12);
                LAS f32x4* ud = (LAS f32x4*)(UT + tk * 16);
                ud[0] = (f32x4){f0[0] * rs * g0[0], f0[1] * rs * g0[1], f0[2] * rs * g0[2], f0[3] * rs * g0[3]};
                ud[1] = (f32x4){f0[4] * rs * g1[0], f0[5] * rs * g1[1], f0[6] * rs * g1[2], f0[7] * rs * g1[3]};
                ud[2] = (f32x4){f1[0] * rs * g2[0], f1[1] * rs * g2[1], f1[2] * rs * g2[2], f1[3] * rs * g2[3]};
                ud[3] = (f32x4){f1[4] * rs * g3[0], f1[5] * rs * g3[1], f1[6] * rs * g3[2], f1[7] * rs * g3[3]};
            }
            f32x2 bb[16];
#pragma unroll
            for (int c = 0; c < 16; ++c) bb[c] = BB[((size_t)g * 64 + lane) * 16 + c];
            const f32x2 lam = LB[g * 64 + lane];
            f32x2 hst = (f32x2){0.f, 0.f};
            if (pass == 0) {
#pragma unroll 4
                for (int tk = 0; tk < 128; ++tk) {
                    const LAS f32x4* up = (const LAS f32x4*)(UT + tk * 16); f32x2 bu = (f32x2){0.f, 0.f};
#pragma unroll
                    for (int c4 = 0; c4 < 4; ++c4) { const f32x4 uu = up[c4];
#pragma unroll
                        for (int e = 0; e < 4; ++e) bu += bb[4 * c4 + e] * uu[e]; }
                    const float nr = lam[0] * hst[0] - lam[1] * hst[1] + bu[0], ni = lam[0] * hst[1] + lam[1] * hst[0] + bu[1];
                    hst = (f32x2){nr, ni};
                }
                EST[((size_t)ck * 64 + g) * 64 + lane] = hst;
            } else {
                const f32x2 lL = LBL[g * 64 + lane];
                for (int c2 = 0; c2 < ck; c2 += 16) {
                    f32x2 eb[16];
#pragma unroll
                    for (int i = 0; i < 16; ++i) eb[i] = (c2 + i < ck) ? EST[((size_t)(c2 + i) * 64 + g) * 64 + lane] : (f32x2){0.f, 0.f};
#pragma unroll
                    for (int i = 0; i < 16; ++i) if (c2 + i < ck) { const float nr = lL[0] * hst[0] - lL[1] * hst[1] + eb[i][0], ni = lL[0] * hst[1] + lL[1] * hst[0] + eb[i][1]; hst = (f32x2){nr, ni}; }
                }
                bf16x8 cf[4];
                {
                    const int ch = lane & 15, qd = lane >> 4;
#pragma unroll
                    for (int ks = 0; ks < 4; ++ks) {
                        const float* src = (ks < 2 ? ka->in[29] : ka->in[30]) + ((size_t)g * 16 + ch) * 64 + (ks & 1) * 32 + qd * 8;
                        const f32x4 x0 = *(const f32x4*)src, x1 = *(const f32x4*)(src + 4); const float sg = ks < 2 ? 1.f : -1.f;
                        u32x4 w; w.x = pk2(sg * x0[0], sg * x0[1]); w.y = pk2(sg * x0[2], sg * x0[3]); w.z = pk2(sg * x1[0], sg * x1[1]); w.w = pk2(sg * x1[2], sg * x1[3]);
                        cf[ks] = __builtin_bit_cast(bf16x8, w);
                    }
                }
                const float dk = dsk[16 * g + (lane & 15)];
                for (int tg = 0; tg < 8; ++tg) {
#pragma unroll 4
                    for (int tl = 0; tl < 16; ++tl) {
                        const int tk = tg * 16 + tl;
                        const LAS f32x4* up = (const LAS f32x4*)(UT + tk * 16); f32x2 bu = (f32x2){0.f, 0.f};
#pragma unroll
                        for (int c4 = 0; c4 < 4; ++c4) { const f32x4 uu = up[c4];
#pragma unroll
                            for (int e = 0; e < 4; ++e) bu += bb[4 * c4 + e] * uu[e]; }
                        const float nr = lam[0] * hst[0] - lam[1] * hst[1] + bu[0], ni = lam[0] * hst[1] + lam[1] * hst[0] + bu[1];
                        hst = (f32x2){nr, ni};
                        const unsigned hw = pk2(nr, ni);
                        HS[tl * 136 + lane] = (bf16)(hw & 0xffffu); HS[tl * 136 + 64 + lane] = (bf16)(hw >> 16);
                    }
                    f32x4 acc = (f32x4){0.f, 0.f, 0.f, 0.f};
#pragma unroll
                    for (int ks = 0; ks < 4; ++ks) { const bf16x8 af = *(const LAS bf16x8*)(HS + (lane & 15) * 136 + ks * 32 + (lane >> 4) * 8);
                        acc = __builtin_amdgcn_mfma_f32_16x16x32_bf16(af, cf[ks], acc, 0, 0, 0); }
#pragma unroll
                    for (int j = 0; j < 4; ++j) { const int tk = tg * 16 + (lane >> 4) * 4 + j; const float uv = UT[tk * 16 + (lane & 15)];
                        const float y = gelu_tanh(acc[j] + dk * uv);
                        YG[(size_t)(t0 + tk) * D + 16 * g + (lane & 15)] = (bf16)(pk2(y, 0.f) & 0xffffu); }
                }
            }
        }
        GSYNC();
    }

    {
        PHASE_ARGS
        pg8::Gemm g{YG, (const bf16*)(ws + W_GLU), T, 2048, D}; pg8::StaticOrder S; S.init(T, 2048, G, bid);
        pg8::EpiRes<2> E{ka->out, ka->out, B1, nullptr, STA, nullptr};
        pg8::gemm_phase<pg8::EpiRes<2>, pg8::StaticOrder, true, true>(lds, g, S, E);
    }
    GSYNC();
    {
        PHASE_ARGS
        pg8::Gemm g{B1, (const bf16*)(ws + W_UP1), T, FF, D}; pg8::StaticOrder S; S.init(T, FF, G, bid);
        pg8::EpiB<2, 32> E{HID, nullptr, nullptr, STA, nullptr, nullptr, FF};
        pg8::gemm_phase<pg8::EpiB<2, 32>, pg8::StaticOrder, true, true>(lds, g, S, E);
    }
    GSYNC();
    {
        PHASE_ARGS
        pg8::Gemm g{HID, (const bf16*)(ws + W_DN1), T, D, FF}; pg8::StaticOrder S; S.init(T, D, G, bid);
        pg8::EpiRes<0> E{ka->out, ka->out, B1, nullptr, STB, nullptr};
        pg8::gemm_phase<pg8::EpiRes<0>, pg8::StaticOrder, true, true>(lds, g, S, E);
    }
    GSYNC();
    {
        PHASE_ARGS
        pg8::Gemm g{PBF + (size_t)T * 256, (const bf16*)(ws + W_P1), T, D, 256}; pg8::StaticOrder S; S.init(T, D, G, bid);
        pg8::EpiB<3, 16> E{PP, nullptr, nullptr, nullptr, nullptr, nullptr, D};
        pg8::gemm_phase<pg8::EpiB<3, 16>, pg8::StaticOrder, true, true>(lds, g, S, E);
    }
    GSYNC();
    {
        PHASE_ARGS
        pg8::Gemm g{B1, (const bf16*)(ws + W_G1), T, D, D}; pg8::StaticOrder S; S.init(T, D, G, bid);
        pg8::EpiRes<1> E{ka->out, ka->out, nullptr, STB, STA, PP};
        pg8::gemm_phase<pg8::EpiRes<1>, pg8::StaticOrder, true, true>(lds, g, S, E);
    }
    GSYNC();
    {
        PHASE_ARGS
        const float* gf = ka->in[40];
        for (int m = gw; m < T; m += NGW) {
            const f32x4* sp = (const f32x4*)(STA + (size_t)m * 32); const f32x4 s0 = sp[0], s1 = sp[1], s2 = sp[2], s3 = sp[3];
            const float ssq = ((s0[0] + s0[1]) + (s0[2] + s0[3])) + ((s1[0] + s1[1]) + (s1[2] + s1[3])) + ((s2[0] + s2[1]) + (s2[2] + s2[3])) + ((s3[0] + s3[1]) + (s3[2] + s3[3]));
            const float rs = rsqrtf(ssq * (1.f / 1024.f) + 1e-6f);
            f32x4* xr = (f32x4*)(ka->out + (size_t)m * D) + lane;
#pragma unroll
            for (int j = 0; j < 4; ++j) { const f32x4 v = xr[64 * j]; const f32x4 gg = *((const f32x4*)gf + lane + 64 * j); xr[64 * j] = v * rs * gg; }
        }
    }
#undef GSYNC
}

extern "C" void kernel_launch(void* const* d_in, const int* in_sizes, int n_in, void* d_out, int out_size, void* d_ws, size_t ws_size, hipStream_t stream) {
    static int grid = 0;
    if (grid == 0) {
        if (n_in != 41 || out_size != T * D || ws_size < WS_END) { fprintf(stderr, "kernel_launch: unexpected shapes (n_in %d, out %d, ws %zu)\n", n_in, out_size, ws_size); grid = -1; return; }
        int dev = 0, cus = 0, per_cu = 0;
        hipGetDevice(&dev); hipDeviceGetAttribute(&cus, hipDeviceAttributeMultiprocessorCount, dev);
        if (hipFuncSetAttribute((const void*)mega_fwd, hipFuncAttributeMaxDynamicSharedMemorySize, LDS_BYTES) != hipSuccess) { fprintf(stderr, "kernel_launch: hipFuncSetAttribute failed\n"); grid = -1; return; }
        if (hipOccupancyMaxActiveBlocksPerMultiprocessor(&per_cu, (const void*)mega_fwd, NWAVES * 64, LDS_BYTES) != hipSuccess || per_cu < 1) { fprintf(stderr, "kernel_launch: occupancy query says %d\n", per_cu); per_cu = 1; }
        (void)hipGetLastError();
        grid = cus;
    }
    if (grid < 0) return;
    if (hipMemsetAsync((char*)d_ws + WS_BAR, 0, 16384, stream) != hipSuccess) { fprintf(stderr, "kernel_launch: memset failed\n"); return; }
    Args a{};
    for (int i = 0; i < 41; ++i) a.in[i] = (const float*)d_in[i];
    a.out = (float*)d_out; a.ws = (unsigned char*)d_ws;
    void* params[] = {&a};
    hipError_t e = hipLaunchCooperativeKernel((const void*)mega_fwd, dim3(grid), dim3(NWAVES * 64), params, LDS_BYTES, stream);
    if (e != hipSuccess) fprintf(stderr, "kernel_launch: cooperative launch failed: %s (grid %d)\n", hipGetErrorString(e), grid);
}
```

```cpp
#include <hip/hip_runtime.h>
#include <hip/hip_cooperative_groups.h>
#include <cstdio>
#include <cstdint>
namespace pg8 {
#define PG8_LAS __attribute__((address_space(3)))
typedef unsigned short bf16_t;
typedef short bf16x8 __attribute__((ext_vector_type(8)));
typedef float f32x4 __attribute__((ext_vector_type(4)));
typedef unsigned u32x4 __attribute__((ext_vector_type(4)));
constexpr int BM = 256, BK = 64, HALF = 128, HTB = HALF * BK * 2  , STAGE_BYTES = 8 * HTB, NXCD = 8, WGM = 8;

__host__ __device__ __forceinline__ int lds_byte(int r, int c) { const int st = (r >> 4) * 2 + (c >> 5), rr = r & 15, cc = c & 31, ob = rr * 64 + cc * 2; return st * 1024 + (ob ^ (((ob >> 9) & 1) << 5)); }
__host__ __device__ __forceinline__ void stage_rc(int b, int& R, int& C) { const int st = b / 1024, sb = b % 1024, swz = sb ^ (((sb >> 9) & 1) << 5); R = (st >> 1) * 16 + swz / 64; C = (st & 1) * 32 + (swz % 64) / 2; }
__host__ __device__ __forceinline__ int perm32(int rho) { const int n = rho >> 4, i = rho & 15; return 8 * (i >> 2) + 4 * n + (i & 3); }

struct Unit { int pm, pn; };
struct Gemm { const bf16_t* A; const bf16_t* Bt; int M, N, K; };

struct StaticOrder {
    int nM, nN, nwg, G, c;
    __host__ __device__ void init(int M, int N, int G_, int c_) { nM = M / BM; nN = N / BM; nwg = nM * nN; G = G_; c = c_; }
    __host__ __device__ bool next(int i, Unit& u) const {
        const long L = (long)i * G + c; if (L >= nwg) return false;
        int wgid = (int)L; { const int q = nwg / NXCD, r = nwg % NXCD, xcd = wgid % NXCD, off = wgid / NXCD; wgid = (xcd < r ? xcd * (q + 1) : r * (q + 1) + (xcd - r) * q) + off; }
        const int nig = WGM * nN, gid = wgid / nig, fm = gid * WGM, gsz = (nM - fm) < WGM ? (nM - fm) : WGM;
        u.pm = fm + ((wgid % nig) % gsz); u.pn = (wgid % nig) / gsz; return true;
    }
    __device__ __forceinline__ void a_ready(const Unit&) const {}
    __device__ __forceinline__ void done(const Unit&) const {}
};

typedef float f32x2n __attribute__((ext_vector_type(2))); typedef __bf16 hbf2n __attribute__((ext_vector_type(2)));
__device__ __forceinline__ unsigned cvt_pk_bf16(float lo, float hi) { const f32x2n v = {lo, hi}; const hbf2n b = __builtin_convertvector(v, hbf2n); return __builtin_bit_cast(unsigned, b); }
typedef float f32x2 __attribute__((ext_vector_type(2)));

constexpr int TT = 16384;
typedef unsigned u32x2 __attribute__((ext_vector_type(2)));
__device__ __forceinline__ float fsigmoid(float x) { return __builtin_amdgcn_rcpf(1.0f + __expf(-x)); }
template <int NSL> __device__ __forceinline__ float row_rstd(const float* st, int r, int fq) {
    const f32x4 v = *(const f32x4*)(st + (size_t)r * 32 + 4 * fq);
    float s = (v[0] + v[1]) + (v[2] + v[3]);
    if (NSL == 32) { const f32x4 w = *(const f32x4*)(st + (size_t)r * 32 + 16 + 4 * fq); s += (w[0] + w[1]) + (w[2] + w[3]); }
    s += __shfl_xor(s, 16); s += __shfl_xor(s, 32);
    return rsqrtf(s * (1.0f / 1024.0f) + 1e-6f);
}
template <int MODE, int NSL> struct EpiB {
    static constexpr bool PERM = true, AFTER_DRAIN = false;
    bf16_t* o0; bf16_t* o1; bf16_t* o2; const float* st; const float* c0; const float* c1; int ldc;
    __device__ __forceinline__ void operator()(const f32x4 (&acc)[2][2][4][2], const Unit& u, int wr, int wc, int fr, int fq) const {
        const int row0 = u.pm * BM + wr * 64 + fr; const int pn = u.pn;
        bf16_t* base; int ld, colt; int kind = 0;
        if (MODE == 0) {
            if (pn < 6) { base = o0 + (size_t)(pn >> 1) * TT * 512; ld = 512; colt = (pn & 1) * 256; }
            else if (pn == 6) { base = o1; ld = 256; colt = 0; }
            else { base = o2; ld = 1536; colt = (pn - 7) * 256; }
        } else if (MODE == 1) {
            kind = pn >> 1; base = o0 + (size_t)kind * TT * 512; if (kind == 2) base = o2; ld = 512; colt = (pn & 1) * 256;
        } else { base = o0; ld = ldc; colt = pn * 256; }
        const int col0 = colt + wc * 32 + 8 * fq;
        const float* cbias = c0; if (kind == 1) cbias = c1; cbias += col0;
        f32x4 bv00 = (f32x4){0.f, 0.f, 0.f, 0.f}, bv01 = bv00, bv10 = bv00, bv11 = bv00;
        if (MODE == 1) { if (kind < 2) { bv00 = *(const f32x4*)(cbias); bv01 = *(const f32x4*)(cbias + 4); bv10 = *(const f32x4*)(cbias + HALF); bv11 = *(const f32x4*)(cbias + HALF + 4); } }
#pragma unroll
        for (int ai = 0; ai < 2; ++ai)
#pragma unroll
            for (int m = 0; m < 4; ++m) {
                const int r = row0 + ai * HALF + m * 16;
                float rs = 1.f;
                if (MODE == 0 || MODE == 2) rs = row_rstd<NSL>(st, r, fq);
                bf16_t* rowp = base + (size_t)r * ld + col0;
#pragma unroll
                for (int bj = 0; bj < 2; ++bj) {
                    f32x4 v0 = acc[ai][bj][m][0], v1 = acc[ai][bj][m][1];
                    if (MODE == 0) { v0 = v0 * rs; v1 = v1 * rs; }
                    if (MODE == 2) {
#pragma unroll
                        for (int e = 0; e < 4; ++e) { float a = fmaxf(v0[e], 0.f) * rs, b = fmaxf(v1[e], 0.f) * rs; v0[e] = a * a; v1[e] = b * b; }
                    }
                    if (MODE == 1) {
                        if (kind < 2) {
                            const float sc = kind == 0 ? (0.6065306597f * 1.4426950409f) : 1.0f;
                            v0 = v0 + (bj == 0 ? bv00 : bv10); v1 = v1 + (bj == 0 ? bv01 : bv11);
#pragma unroll
                            for (int e = 0; e < 4; ++e) { v0[e] = sc * fsigmoid(v0[e]); v1[e] = sc * fsigmoid(v1[e]); }
                        }
                    }
                    u32x4 w; w.x = cvt_pk_bf16(v0[0], v0[1]); w.y = cvt_pk_bf16(v0[2], v0[3]); w.z = cvt_pk_bf16(v1[0], v1[1]); w.w = cvt_pk_bf16(v1[2], v1[3]);
                    if (MODE == 1 && kind < 2) { const int cc_ = col0 + bj * HALF; *(u32x4*)(base + ((size_t)(cc_ >> 6) * TT + r) * 64 + (cc_ & 63)) = w; }
                    else *(u32x4*)(rowp + bj * HALF) = w;
                }
                if (m & 1) asm volatile("" ::: "memory");
            }
    }
};
template <int MODE> struct EpiRes {
    static constexpr bool PERM = false, AFTER_DRAIN = false;
    const float* base; float* out; bf16_t* hb; const float* st_in; float* st_out; const bf16_t* pp;
    __device__ __forceinline__ void operator()(const f32x4 (&acc)[2][2][4][2], const Unit& u, int wr, int wc, int fr, int fq) const {
        const int row0 = u.pm * BM + wr * 64 + fr;
#pragma unroll
        for (int ai = 0; ai < 2; ++ai)
#pragma unroll
            for (int m = 0; m < 4; ++m) {
                const int r = row0 + ai * HALF + m * 16;
                float rs = 1.f;
                if (MODE == 1) rs = row_rstd<16>(st_in, r, fq);
                float ss = 0.f;
#pragma unroll
                for (int bj = 0; bj < (MODE == 2 ? 1 : 2); ++bj)
#pragma unroll
                    for (int n = 0; n < 2; ++n) {
                        const int c = (MODE == 2 ? u.pn * 128 : u.pn * BM + bj * HALF) + wc * 32 + n * 16 + 4 * fq;
                        const size_t off = (size_t)r * 1024 + c;
                        const f32x4 b = *(const f32x4*)(base + off);
                        f32x4 v = acc[ai][bj][m][n];
                        if (MODE == 1) {
                            const u32x2 pw = *(const u32x2*)(pp + off);
                            const float p0 = __uint_as_float(pw.x << 16), p1 = __uint_as_float(pw.x & 0xffff0000u), p2 = __uint_as_float(pw.y << 16), p3 = __uint_as_float(pw.y & 0xffff0000u);
                            v[0] = p0 * fsigmoid(v[0] * rs); v[1] = p1 * fsigmoid(v[1] * rs); v[2] = p2 * fsigmoid(v[2] * rs); v[3] = p3 * fsigmoid(v[3] * rs);
                        }
                        if (MODE == 2) {
                            const f32x4 g = acc[ai][1][m][n];
#pragma unroll
                            for (int e = 0; e < 4; ++e) v[e] = v[e] * fsigmoid(g[e]);
                        }
                        const f32x4 o = b + v;
                        *(f32x4*)(out + off) = o;
                        if (hb) { u32x2 w; w.x = cvt_pk_bf16(o[0], o[1]); w.y = cvt_pk_bf16(o[2], o[3]); *(u32x2*)(hb + off) = w; }
                        ss += (o[0] * o[0] + o[1] * o[1]) + (o[2] * o[2] + o[3] * o[3]);
                    }
                ss += __shfl_xor(ss, 16); ss += __shfl_xor(ss, 32);
                if (fq == 0) st_out[(size_t)r * 32 + u.pn * 4 + wc] = ss;
                asm volatile("" ::: "memory");
            }
    }
};

template <class Epi, class Sched, bool ALIGN_EPI = false, bool SP2 = false>
__device__ __forceinline__ void gemm_phase(PG8_LAS unsigned char* lds, const Gemm g, const Sched& S, const Epi& E) {
    int tid_l = threadIdx.x; asm volatile("" : "+v"(tid_l)); const int tid = tid_l, wid = __builtin_amdgcn_readfirstlane(tid >> 6), lane = tid & 63, wr = wid >> 2, wc = wid & 3, fr = lane & 15, fq = lane >> 4;
    int K = g.K; asm volatile("" : "+s"(K)); const int nt = K / BK;
    unsigned voffA[2], voffB[2];
#pragma unroll
    for (int i = 0; i < 2; ++i) { int R, C; stage_rc(tid * 16 + i * 8192, R, C); const int Rb = Epi::PERM ? ((R & ~31) + perm32(R & 31)) : R;
        voffA[i] = (unsigned)(R * K + C) * 2u; voffB[i] = (unsigned)(Rb * K + C) * 2u; }
    const size_t kstep = (size_t)(BK * 2);
    const size_t hstep = (size_t)HALF * K * 2;
    const size_t tstep = 2 * hstep;
    const unsigned ldsw = (unsigned)wid * 1024u;
    const int aoff = lds_byte(wr * 64 + fr, fq * 8), boff = lds_byte(wc * 32 + fr, fq * 8);
#define PG8_SA(b, h) (((b) * 2 + (h)) * HTB)
#define PG8_SB(b, h) ((4 + (b) * 2 + (h)) * HTB)
#define PG8_STAGE(bufoff, gbase, voff) do { _Pragma("unroll") for (int _i = 0; _i < 2; ++_i) \
        __builtin_amdgcn_global_load_lds((const unsigned*)((const char*)(gbase) + (voff)[_i]), (PG8_LAS unsigned*)(lds + (bufoff) + ldsw + _i * 8192), 16, 0, 0); } while (0)
#define PG8_LDA(dst, b, h) do { _Pragma("unroll") for (int m = 0; m < 4; ++m) _Pragma("unroll") for (int k = 0; k < 2; ++k) dst[m][k] = *(const PG8_LAS bf16x8*)(lds + PG8_SA(b, h) + aoff + m * 2048 + k * 1024); } while (0)
#define PG8_LDB(dst, b, h) do { _Pragma("unroll") for (int n = 0; n < 2; ++n) _Pragma("unroll") for (int k = 0; k < 2; ++k) dst[n][k] = *(const PG8_LAS bf16x8*)(lds + PG8_SB(b, h) + boff + n * 2048 + k * 1024); } while (0)
#define PG8_MMA(ai, bj, At, Bt) do { __builtin_amdgcn_s_setprio(1); _Pragma("unroll") for (int m = 0; m < 4; ++m) _Pragma("unroll") for (int n = 0; n < 2; ++n) _Pragma("unroll") for (int k = 0; k < 2; ++k) \
        acc[ai][bj][m][n] = __builtin_amdgcn_mfma_f32_16x16x32_bf16(Bt[n][k], At[m][k], acc[ai][bj][m][n], 0, 0, 0); __builtin_amdgcn_s_setprio(0); } while (0)
#define PG8_WAIT_V(n) asm volatile("s_waitcnt vmcnt(" #n ")" ::: "memory")
#define PG8_WAIT_L(n) asm volatile("s_waitcnt lgkmcnt(" #n ")" ::: "memory")
#define PG8_BAR __builtin_amdgcn_s_barrier()
#define PG8_SCHED __builtin_amdgcn_sched_barrier(0)
    Unit cur, nxt; int ui = 0;
    if (!S.next(0, cur)) return;
    f32x4 acc[2][2][4][2];
#pragma unroll
    for (int a = 0; a < 2; ++a)
#pragma unroll
        for (int b = 0; b < 2; ++b)
#pragma unroll
            for (int m = 0; m < 4; ++m)
#pragma unroll
                for (int n = 0; n < 2; ++n) acc[a][b][m][n] = (f32x4){0.f, 0.f, 0.f, 0.f};
    bf16x8 At[4][2], B0[2][2], B1[2][2];
    const char* cA = (const char*)g.A + (size_t)cur.pm * tstep; const char* cB = (const char*)g.Bt + (size_t)cur.pn * tstep;
    S.a_ready(cur);
    if constexpr (SP2) {
        PG8_STAGE(PG8_SB(0, 0), cB, voffB); PG8_STAGE(PG8_SB(0, 1), cB + hstep, voffB); PG8_STAGE(PG8_SA(0, 0), cA, voffA); PG8_STAGE(PG8_SA(0, 1), cA + hstep, voffA);
        if (wr == 1) PG8_BAR;
        PG8_WAIT_V(2); PG8_BAR;
        PG8_STAGE(PG8_SB(1, 0), cB + kstep, voffB); PG8_STAGE(PG8_SA(1, 0), cA + kstep, voffA); PG8_STAGE(PG8_SB(1, 1), cB + hstep + kstep, voffB);
        PG8_WAIT_V(6); PG8_BAR;
    } else {
        PG8_STAGE(PG8_SB(0, 0), cB, voffB); PG8_STAGE(PG8_SA(0, 0), cA, voffA); PG8_STAGE(PG8_SB(0, 1), cB + hstep, voffB); PG8_STAGE(PG8_SA(0, 1), cA + hstep, voffA);
        if (wr == 1) PG8_BAR;
        PG8_WAIT_V(4); PG8_BAR;
        PG8_STAGE(PG8_SB(1, 0), cB + kstep, voffB); PG8_STAGE(PG8_SA(1, 0), cA + kstep, voffA); PG8_STAGE(PG8_SB(1, 1), cB + hstep + kstep, voffB);
        PG8_WAIT_V(6); PG8_BAR;
    }
    for (;;) {
        const bool has_next = S.next(ui + 1, nxt);
        const char* nA = has_next ? (const char*)g.A + (size_t)nxt.pm * tstep : cA; const char* nB = has_next ? (const char*)g.Bt + (size_t)nxt.pn * tstep : cB;
        for (int t = 0; t < nt; t += 2) {
            const bool last = (t == nt - 2);
            const char* a1 = cA + (size_t)(t + 1) * kstep;
            const char* a2 = last ? nA : cA + (size_t)(t + 2) * kstep; const char* b2 = last ? nB : cB + (size_t)(t + 2) * kstep;
            const char* a3 = a2 + kstep; const char* b3 = b2 + kstep;
            if (last && has_next) S.a_ready(nxt);
            if constexpr (SP2) {
            PG8_LDB(B0, 0, 0); PG8_LDB(B1, 0, 1); PG8_SCHED; PG8_LDA(At, 0, 0); PG8_STAGE(PG8_SA(1, 1), a1 + hstep, voffA);
            PG8_WAIT_V(8); PG8_WAIT_L(0); PG8_BAR; PG8_MMA(0, 0, At, B0); PG8_MMA(0, 1, At, B1); PG8_BAR; PG8_SCHED;
            PG8_LDA(At, 0, 1); PG8_STAGE(PG8_SB(0, 0), b2, voffB); PG8_STAGE(PG8_SB(0, 1), b2 + hstep, voffB); PG8_STAGE(PG8_SA(0, 0), a2, voffA);
            PG8_WAIT_V(8); PG8_WAIT_L(0); PG8_BAR; PG8_MMA(1, 0, At, B0); PG8_MMA(1, 1, At, B1); PG8_BAR; PG8_SCHED;
            PG8_LDB(B0, 1, 0); PG8_LDB(B1, 1, 1); PG8_SCHED; PG8_LDA(At, 1, 0); PG8_STAGE(PG8_SA(0, 1), a2 + hstep, voffA);
            PG8_WAIT_V(8); PG8_WAIT_L(0); PG8_BAR; PG8_MMA(0, 0, At, B0); PG8_MMA(0, 1, At, B1); PG8_BAR; PG8_SCHED;
            PG8_LDA(At, 1, 1); PG8_STAGE(PG8_SB(1, 0), b3, voffB); PG8_STAGE(PG8_SB(1, 1), b3 + hstep, voffB); PG8_STAGE(PG8_SA(1, 0), a3, voffA);
            PG8_WAIT_V(8); PG8_WAIT_L(0); PG8_BAR; PG8_MMA(1, 0, At, B0); PG8_MMA(1, 1, At, B1); PG8_BAR; PG8_SCHED;
            } else {
            PG8_LDB(B0, 0, 0); PG8_SCHED; PG8_LDA(At, 0, 0); PG8_STAGE(PG8_SA(1, 1), a1 + hstep, voffA);
            PG8_WAIT_L(8); PG8_BAR; PG8_WAIT_L(0); PG8_MMA(0, 0, At, B0); PG8_BAR; PG8_SCHED;
            PG8_LDB(B1, 0, 1); PG8_STAGE(PG8_SB(0, 0), b2, voffB);
            PG8_BAR; PG8_WAIT_L(0); PG8_MMA(0, 1, At, B1); PG8_BAR;
            PG8_LDA(At, 0, 1); PG8_STAGE(PG8_SA(0, 0), a2, voffA);
            PG8_BAR; PG8_WAIT_L(0); PG8_MMA(1, 0, At, B0); PG8_BAR; PG8_SCHED;
            PG8_STAGE(PG8_SB(0, 1), b2 + hstep, voffB);
            PG8_WAIT_V(6); PG8_BAR; PG8_MMA(1, 1, At, B1); PG8_BAR;
            PG8_LDB(B0, 1, 0); PG8_SCHED; PG8_LDA(At, 1, 0); PG8_STAGE(PG8_SA(0, 1), a2 + hstep, voffA);
            PG8_WAIT_L(8); PG8_BAR; PG8_WAIT_L(0); PG8_MMA(0, 0, At, B0); PG8_BAR; PG8_SCHED;
            PG8_LDB(B1, 1, 1); PG8_STAGE(PG8_SB(1, 0), b3, voffB);
            PG8_BAR; PG8_WAIT_L(0); PG8_MMA(0, 1, At, B1); PG8_BAR;
            PG8_LDA(At, 1, 1); PG8_STAGE(PG8_SA(1, 0), a3, voffA);
            PG8_BAR; PG8_WAIT_L(0); PG8_MMA(1, 0, At, B0); PG8_BAR; PG8_SCHED;
            PG8_STAGE(PG8_SB(1, 1), b3 + hstep, voffB);
            PG8_WAIT_V(6); PG8_BAR; PG8_MMA(1, 1, At, B1); PG8_BAR;
            }
        }
        if constexpr (ALIGN_EPI) { if (wr == 0) PG8_BAR; }
        if constexpr (!Epi::AFTER_DRAIN) { E(acc, cur, wr, wc, fr, fq); S.done(cur); }
        if (!has_next) break;
#pragma unroll
        for (int a = 0; a < 2; ++a)
#pragma unroll
            for (int b = 0; b < 2; ++b)
#pragma unroll
                for (int m = 0; m < 4; ++m)
#pragma unroll
                    for (int n = 0; n < 2; ++n) acc[a][b][m][n] = (f32x4){0.f, 0.f, 0.f, 0.f};
        cur = nxt; cA = nA; cB = nB; ++ui;
        if constexpr (ALIGN_EPI) { if (wr == 1) PG8_BAR; }
    }
    PG8_WAIT_V(0);
    if constexpr (!ALIGN_EPI) { if (wr == 0) PG8_BAR; }
    PG8_BAR;
    if constexpr (Epi::AFTER_DRAIN) { E.fused(acc, cur, wr, wc, fr, fq, lds, wid, lane); S.done(cur); }
#undef PG8_SA
#undef PG8_SB
#undef PG8_STAGE
#undef PG8_LDA
#undef PG8_LDB
#undef PG8_MMA
#undef PG8_WAIT_V
#undef PG8_WAIT_L
#undef PG8_BAR
#undef PG8_SCHED
}
}

namespace cg = cooperative_groups;
#define LAS __attribute__((address_space(3)))
typedef unsigned short bf16;
typedef float f32x4 __attribute__((ext_vector_type(4)));
typedef float f32x2 __attribute__((ext_vector_type(2)));
typedef unsigned u32x4 __attribute__((ext_vector_type(4)));
typedef unsigned u32x2 __attribute__((ext_vector_type(2)));
typedef short bf16x8 __attribute__((ext_vector_type(8)));
typedef short bf16x4 __attribute__((ext_vector_type(4)));

constexpr int T = 16384, D = 1024, FF = 4096, DIN = 3328, NWAVES = 8;
constexpr int LDS_BYTES = 147456;
constexpr size_t KiB = 1024, MiB = 1024 * 1024;
constexpr size_t WS_BON = 0;
constexpr size_t WS_EST = 1 * MiB;
constexpr size_t WS_S5P = 5 * MiB;
constexpr size_t WS_STA = 8 * MiB, WS_STB = 10 * MiB;
constexpr size_t W_IN = 12 * MiB, W_LORA = W_IN + 6656 * KiB, W_OUT = W_LORA + 768 * KiB, W_UP0 = W_OUT + 2 * MiB, W_DN0 = W_UP0 + 8 * MiB, W_G0 = W_DN0 + 8 * MiB,
                 W_P0 = W_G0 + 2 * MiB, W_GLU = W_P0 + 512 * KiB, W_UP1 = W_GLU + 4 * MiB, W_DN1 = W_UP1 + 8 * MiB, W_G1 = W_DN1 + 8 * MiB, W_P1 = W_G1 + 2 * MiB;
static_assert(W_P1 + 512 * KiB <= 64 * MiB, "weights");
constexpr size_t WS_PBF = 64 * MiB;
constexpr size_t WS_B1 = 80 * MiB, WS_B2 = 112 * MiB;
constexpr size_t WS_R = 144 * MiB, WS_E = 192 * MiB, WS_A = 208 * MiB, WS_KP = 224 * MiB;
constexpr size_t WS_HID = 112 * MiB;
constexpr size_t WS_PP = 144 * MiB, WS_YG = 144 * MiB;
constexpr size_t WS_ESEG = 1 * MiB, WS_MSEG = 240 * MiB;
constexpr size_t WS_END = 244 * MiB;
constexpr size_t DO_ZB = 0, DO_X = 48 * MiB, DO_AP = 56 * MiB, DO_KK = 48 * MiB, DO_G = 0, DO_RS = 16 * MiB, DO_VS = 32 * MiB;
constexpr size_t WS_Y = 144 * MiB;

__device__ __forceinline__ size_t hm8(int t, int lane) { return ((size_t)(lane >> 3) * T + t) * 64 + (lane & 7) * 8; }
__device__ __forceinline__ float bflo(unsigned w) { return __uint_as_float(w << 16); }
__device__ __forceinline__ float bfhi(unsigned w) { return __uint_as_float(w & 0xffff0000u); }
__device__ __forceinline__ unsigned pk2(float lo, float hi) { return pg8::cvt_pk_bf16(lo, hi); }
__device__ __forceinline__ void unpack8(const u32x4 w, float (&f)[8]) { f[0] = bflo(w.x); f[1] = bfhi(w.x); f[2] = bflo(w.y); f[3] = bfhi(w.y); f[4] = bflo(w.z); f[5] = bfhi(w.z); f[6] = bflo(w.w); f[7] = bfhi(w.w); }
__device__ __forceinline__ u32x4 pack8(const float (&f)[8]) { u32x4 w; w.x = pk2(f[0], f[1]); w.y = pk2(f[2], f[3]); w.z = pk2(f[4], f[5]); w.w = pk2(f[6], f[7]); return w; }
__device__ __forceinline__ float wave_sum(float v) {
#pragma unroll
    for (int o = 1; o < 64; o <<= 1) v += __shfl_xor(v, o);
    return v;
}
__device__ __forceinline__ float sum8(float v) { v += __shfl_xor(v, 1); v += __shfl_xor(v, 2); v += __shfl_xor(v, 4); return v; }
template <int CTRL, int RM> __device__ __forceinline__ float dpp0(float x) {
    return __builtin_bit_cast(float, __builtin_amdgcn_update_dpp(0, __builtin_bit_cast(int, x), CTRL, RM, 0xf, false));
}
__device__ __forceinline__ float wave_sum_dpp(float x) {
    x += dpp0<0xB1, 0xf>(x);
    x += dpp0<0x4E, 0xf>(x);
    x += dpp0<0x141, 0xf>(x);
    x += dpp0<0x140, 0xf>(x);
    x += dpp0<0x142, 0xa>(x);
    x += dpp0<0x143, 0xc>(x);
    return __builtin_bit_cast(float, __builtin_amdgcn_readlane(__builtin_bit_cast(int, x), 63));
}
__device__ __forceinline__ float gelu_tanh(float x) {
    const float u = 0.7978845608f * (x + 0.044715f * x * x * x);
    const float e = __expf(2.0f * u);
    const float th = 1.0f - 2.0f * __builtin_amdgcn_rcpf(e + 1.0f);
    return 0.5f * x * (1.0f + th);
}

__device__ __forceinline__ void tr_item(const float* W, int K, int N, bf16* WT, int mode, const float* gain, LAS float* scr, int item, int lane) {
    const int nblk = N / 32, kb = item / nblk, nb = item % nblk, k0 = 64 * kb, n0 = 32 * nb;
#pragma unroll 8
    for (int i = 0; i < 32; ++i) { const int kk = 2 * i + (lane >> 5); float v = W[(size_t)(k0 + kk) * N + n0 + (lane & 31)]; if (gain) v *= gain[k0 + kk]; scr[kk * 33 + (lane & 31)] = v; }
    asm volatile("s_waitcnt lgkmcnt(0)" ::: "memory");
    const int c = lane & 7;
#pragma unroll
    for (int j = 0; j < 4; ++j) { const int n = (lane >> 3) + 8 * j; const LAS float* s = scr + (8 * c) * 33 + n;
        u32x4 o; o.x = pk2(s[0 * 33], s[1 * 33]); o.y = pk2(s[2 * 33], s[3 * 33]); o.z = pk2(s[4 * 33], s[5 * 33]); o.w = pk2(s[6 * 33], s[7 * 33]);
        const int ng = n0 + n; const int row = mode == 0 ? ng : (256 * (ng >> 7) + (ng & 127) + (mode == 2 ? 128 : 0));
        *(u32x4*)(WT + (size_t)row * K + k0 + 8 * c) = o; }
    asm volatile("s_waitcnt lgkmcnt(0)" ::: "memory");
}

#define RLX_AGENT __ATOMIC_RELAXED, __HIP_MEMORY_SCOPE_AGENT
#define XB_TMO      128
#define XB_XCNT(j)  (256  + 64 * (j))
#define XB_XSUB(j)  (1280 + 64 * (j))
#define XB_XGEN(j)  (2304 + 64 * (j))
#define XB_TOP      3328
#define XB_TOPGEN   3392
#define XCD_BAR_WORDS 3456
#define XB_SPIN_CAP (1u << 18)

__device__ __forceinline__ unsigned xb_ld(unsigned* p)              { return __hip_atomic_load(p, __ATOMIC_RELAXED, __HIP_MEMORY_SCOPE_AGENT); }
__device__ __forceinline__ unsigned xb_add(unsigned* p, unsigned v) { return __hip_atomic_fetch_add(p, v, __ATOMIC_RELAXED, __HIP_MEMORY_SCOPE_AGENT); }
__device__ __forceinline__ unsigned xb_xcc_id() { return (unsigned)__builtin_amdgcn_s_getreg((3 << 11) | 20) & 0xFu; }
#define XB_SPIN(cond, bar) do { unsigned _sp = 0; while (cond) { __builtin_amdgcn_s_sleep(1); \
    if ((++_sp & 255u) == 0u) { if (xb_ld(&(bar)[XB_TMO])) break; if (_sp > XB_SPIN_CAP) { atomicAdd(&(bar)[XB_TMO], 1u); break; } } } } while (0)

struct XcdBarrier {
    unsigned* bar; unsigned x;
    volatile LAS unsigned* st;
};

__device__ __forceinline__ XcdBarrier xcd_barrier_post(unsigned* bar, volatile LAS unsigned* st) {
    XcdBarrier b; b.bar = bar; b.x = xb_xcc_id(); b.st = st;
    if (threadIdx.x == 0) (void)xb_add(&bar[XB_XCNT(b.x)], 1u);
    return b;
}
__device__ __forceinline__ void xcd_barrier_complete(unsigned* bar, unsigned x, unsigned& nloc, unsigned& nx) {
    const unsigned G = gridDim.x * gridDim.y * gridDim.z;
    unsigned sum, cnt, mine, sp = 0u;
    for (;;) {
        sum = 0u; cnt = 0u; mine = 0u;
#pragma unroll
        for (unsigned j = 0; j < 16; ++j) { const unsigned c = xb_ld(&bar[XB_XCNT(j)]); sum += c; cnt += (c > 0u) ? 1u : 0u; mine = (j == x) ? c : mine; }
        if (sum == G) break;
        __builtin_amdgcn_s_sleep(1);
        if ((++sp & 255u) == 0u) { if (xb_ld(&bar[XB_TMO])) break; if (sp > XB_SPIN_CAP) { atomicAdd(&bar[XB_TMO], 1u); break; } }
    }
    nloc = mine > 0u ? mine : 1u; nx = cnt > 0u ? cnt : 1u;
}

__device__ __forceinline__ void xcd_barrier(const XcdBarrier& b) {
    asm volatile("s_waitcnt vmcnt(0)" ::: "memory");
    __syncthreads();
    if (threadIdx.x == 0) {
        unsigned* bar = b.bar;
        __builtin_amdgcn_s_waitcnt(0);
        unsigned nloc = b.st[0], nx = b.st[1];
        if (nloc == 0u) { xcd_barrier_complete(bar, b.x, nloc, nx); b.st[0] = nloc; b.st[1] = nx; }
        const unsigned old = xb_add(&bar[XB_XSUB(b.x)], 1u);
        const unsigned gen = old / nloc;
        if (old + 1u == (gen + 1u) * nloc) {
            __builtin_amdgcn_fence(__ATOMIC_RELEASE, "agent");
            asm volatile("s_waitcnt vmcnt(0)" ::: "memory");
            const unsigned og = xb_add(&bar[XB_TOP], 1u);
            const unsigned tg = og / nx;
            if (og + 1u == (tg + 1u) * nx) xb_add(&bar[XB_TOPGEN], 1u);
            else XB_SPIN(xb_ld(&bar[XB_TOPGEN]) == tg, bar);
            __builtin_amdgcn_fence(__ATOMIC_ACQUIRE, "agent");
            xb_add(&bar[XB_XGEN(b.x)], 1u);
            asm volatile("s_waitcnt vmcnt(0)" ::: "memory");
        } else {
            XB_SPIN(xb_ld(&bar[XB_XGEN(b.x)]) == gen, bar);
            __builtin_amdgcn_fence(__ATOMIC_ACQUIRE, "agent");
            asm volatile("s_waitcnt vmcnt(0)" ::: "memory");
        }
    }
    __syncthreads();
}

constexpr size_t WS_BAR = 6 * MiB;
struct Args { const float* in[41]; float* out; unsigned char* ws; };
typedef const __attribute__((address_space(4))) Args* KArgs;
__device__ __forceinline__ KArgs kargs() { KArgs p = (KArgs)__builtin_amdgcn_kernarg_segment_ptr(); asm volatile("" : "+s"(p)); return p; }


#define STA ((float*)(ws + WS_STA))
#define STB ((float*)(ws + WS_STB))
#define B1 ((bf16*)(ws + WS_B1))
#define B2 ((bf16*)(ws + WS_B2))
#define Rb ((bf16*)(ws + WS_R))
#define Kb (Rb + (size_t)T * 512)
#define Vb (Rb + (size_t)T * 1024)
#define Eb ((bf16*)(ws + WS_E))
#define Ab ((bf16*)(ws + WS_A))
#define KPb ((bf16*)(ws + WS_KP))
#define ZB ((bf16*)(dob + DO_ZB))
#define Xb ((bf16*)(dob + DO_X))
#define APb ((bf16*)(dob + DO_AP))
#define KKb ((bf16*)(dob + DO_KK))
#define Gb ((bf16*)(dob + DO_G))
#define RSb ((bf16*)(dob + DO_RS))
#define VSb ((bf16*)(dob + DO_VS))
#define BON ((float*)(ws + WS_BON))
#define HID ((bf16*)(ws + WS_HID))
#define PP ((bf16*)(ws + WS_PP))
#define YG ((bf16*)(ws + WS_YG))
#define PBF ((bf16*)(ws + WS_PBF))
#define EST ((f32x2*)(ws + WS_EST))
#define LB ((f32x2*)(ws + WS_S5P))
#define LBL (LB + 4096)
#define BB (LB + 8192)
#define PHASE_ARGS KArgs ka = kargs(); unsigned char* const ws = ka->ws; unsigned char* const dob = (unsigned char*)ka->out; (void)dob; int tid_p = threadIdx.x; asm volatile("" : "+v"(tid_p)); const int tid = tid_p, lane = tid & 63, wave = __builtin_amdgcn_readfirstlane(tid >> 6), gw = bid * NWAVES + wave, NGW = G * NWAVES; (void)gw; (void)NGW; (void)lane;

template <int pass> __device__ __forceinline__ void rwkv_seg_pass(LAS unsigned char* lds, unsigned char* const ws, unsigned char* const dob, const int bid, const int G, const int tid) {
    const int lane = tid & 63, wave = __builtin_amdgcn_readfirstlane(tid >> 6);
        constexpr int NCL = 32, NS = 10, SLOT = 12288;
        float* ESEG = (float*)(ws + WS_ESEG); float* MSEG = (float*)(ws + WS_MSEG);
        for (int job = bid; job < 256; job += G) {
            const int h = job & 7, sg = job >> 3, c0 = sg * NCL;
            __syncthreads();
            if (wave >= 4) {
                const int lw = wave - 4;
                const unsigned char* srcb[3]; unsigned ldso[3];
#pragma unroll
                for (int i = 0; i < 3; ++i) { const int p = (lw * 3 + i) * 64 + lane; const int blk = p >> 7, seg = (p >> 3) & 15, part = (p & 7) ^ ((seg >> 1) & 7);
                    const bf16* base = blk == 0 ? Ab : (blk == 1 ? RSb : (blk == 2 ? KKb : (blk == 3 ? KPb : (blk == 4 ? Eb : VSb))));
                    srcb[i] = (const unsigned char*)(base + ((size_t)h * T + seg) * 64) + part * 16; ldso[i] = (unsigned)((lw * 3 + i) * 1024); }
#define RW_ISSUE(cc_) do { const int cq = c0 + ((cc_) < NCL ? (cc_) : NCL - 1); const unsigned so = (unsigned)(((cc_) % NS) * SLOT); _Pragma("unroll") for (int i = 0; i < 3; ++i) \
        __builtin_amdgcn_global_load_lds((const unsigned*)(srcb[i] + (size_t)cq * 2048), (LAS unsigned*)(lds + so + ldso[i]), 16, 0, 0); } while (0)
                for (int c = 0; c < NS - 1; ++c) RW_ISSUE(c);
                asm volatile("s_waitcnt vmcnt(21)" ::: "memory");
                __builtin_amdgcn_s_barrier();
                for (int c = 0; c < NCL; ++c) {
                    RW_ISSUE(c + NS - 1);
                    asm volatile("s_waitcnt vmcnt(21)" ::: "memory");
                    __builtin_amdgcn_s_barrier();
                }
                asm volatile("s_waitcnt vmcnt(0)" ::: "memory");
#undef RW_ISSUE
            } else {
                const int fr = lane & 15, q = lane >> 4;
                f32x4 ST[4], SI[4];
#pragma unroll
                for (int m = 0; m < 4; ++m) { ST[m] = (f32x4){0.f, 0.f, 0.f, 0.f}; const int d_ = 16 * wave + fr - 16 * m - 4 * q;
                    SI[m] = (f32x4){d_ == 0 ? 1.f : 0.f, d_ == 1 ? 1.f : 0.f, d_ == 2 ? 1.f : 0.f, d_ == 3 ? 1.f : 0.f}; }
                if (pass == 1) {
                    const float* Mh = MSEG + (size_t)h * 32 * 4096; const float* Eh = ESEG + (size_t)h * 32 * 4096;
                    for (int s = 0; s < sg; ++s) {
                        const float* Ms = Mh + (size_t)s * 4096; const float* Es = Eh + (size_t)s * 4096;
                        bf16x4 shi[4], slo[4];
#pragma unroll
                        for (int k = 0; k < 4; ++k) { const f32x4 x = ST[k]; u32x2 hw; hw.x = pk2(x[0], x[1]); hw.y = pk2(x[2], x[3]);
                            const f32x4 xh = (f32x4){bflo(hw.x), bfhi(hw.x), bflo(hw.y), bfhi(hw.y)}; const f32x4 xl = x - xh; u32x2 lw2; lw2.x = pk2(xl[0], xl[1]); lw2.y = pk2(xl[2], xl[3]);
                            shi[k] = __builtin_bit_cast(bf16x4, hw); slo[k] = __builtin_bit_cast(bf16x4, lw2); }
                        f32x4 nw[4];
#pragma unroll
                        for (int m = 0; m < 4; ++m) { const float* ep_ = Es + (size_t)(16 * m + 4 * q) * 64 + 16 * wave + fr; nw[m] = (f32x4){ep_[0], ep_[64], ep_[128], ep_[192]}; }
#pragma unroll
                        for (int m = 0; m < 4; ++m) {
#pragma unroll
                            for (int k = 0; k < 4; ++k) {
                                const f32x4 x = *(const f32x4*)(Ms + (size_t)(16 * m + fr) * 64 + 16 * k + 4 * q);
                                u32x2 hw; hw.x = pk2(x[0], x[1]); hw.y = pk2(x[2], x[3]);
                                const f32x4 xh = (f32x4){bflo(hw.x), bfhi(hw.x), bflo(hw.y), bfhi(hw.y)}; const f32x4 xl = x - xh; u32x2 lw2; lw2.x = pk2(xl[0], xl[1]); lw2.y = pk2(xl[2], xl[3]);
                                const bf16x4 ahi = __builtin_bit_cast(bf16x4, hw), alo = __builtin_bit_cast(bf16x4, lw2);
                                nw[m] = __builtin_amdgcn_mfma_f32_16x16x16bf16_1k(ahi, shi[k], nw[m], 0, 0, 0);
                                nw[m] = __builtin_amdgcn_mfma_f32_16x16x16bf16_1k(ahi, slo[k], nw[m], 0, 0, 0);
                                nw[m] = __builtin_amdgcn_mfma_f32_16x16x16bf16_1k(alo, shi[k], nw[m], 0, 0, 0);
                            }
                            asm volatile("" ::: "memory");
                        }
#pragma unroll
                        for (int m = 0; m < 4; ++m) ST[m] = nw[m];
                    }
                }
                bf16x4 cw[4], cr[4], cb[4], ck[4], cp, cmb, cmk, cv; f32x4 cg[4];
#define RW_SW(seg_, pc_) ((((pc_) ^ (((seg_) >> 1) & 7))) * 16)
#define RW_READ(cc_) do { const LAS unsigned char* sl = lds + ((cc_) % NS) * SLOT; \
        _Pragma("unroll") for (int m = 0; m < 4; ++m) { const int sg_ = 4 * m + (fr >> 2), gs_ = 12 + ((16 * m + 4 * q) >> 5); \
            cw[m] = *(const LAS bf16x4*)(sl + 0 * 2048 + fr * 128 + RW_SW(fr, 2 * m + (q >> 1)) + (q & 1) * 8); \
            cr[m] = *(const LAS bf16x4*)(sl + 1 * 2048 + fr * 128 + RW_SW(fr, 2 * m + (q >> 1)) + (q & 1) * 8); \
            cb[m] = *(const LAS bf16x4*)(sl + 2 * 2048 + sg_ * 128 + RW_SW(sg_, (fr & 3) * 2 + (q >> 1)) + (q & 1) * 8); \
            ck[m] = *(const LAS bf16x4*)(sl + 3 * 2048 + sg_ * 128 + RW_SW(sg_, (fr & 3) * 2 + (q >> 1)) + (q & 1) * 8); \
            cg[m] = *(const LAS f32x4*)(sl + 4 * 2048 + gs_ * 128 + RW_SW(gs_, ((16 * m + 4 * q) & 31) >> 2)); } \
        { const int s0_ = fr >> 2, s1_ = 4 + (fr >> 2), s2_ = 8 + (fr >> 2), pc_ = (fr & 3) * 2 + (q >> 1); \
        cp  = *(const LAS bf16x4*)(sl + 4 * 2048 + s0_ * 128 + RW_SW(s0_, pc_) + (q & 1) * 8); \
        cmb = *(const LAS bf16x4*)(sl + 4 * 2048 + s1_ * 128 + RW_SW(s1_, pc_) + (q & 1) * 8); \
        cmk = *(const LAS bf16x4*)(sl + 4 * 2048 + s2_ * 128 + RW_SW(s2_, pc_) + (q & 1) * 8); } \
        _Pragma("unroll") for (int jj = 0; jj < 4; ++jj) cv[jj] = *(const LAS short*)(sl + 5 * 2048 + (4 * q + jj) * 128 + RW_SW(4 * q + jj, 2 * wave + (fr >> 3)) + (fr & 7) * 2); } while (0)
                __builtin_amdgcn_s_barrier();
                RW_READ(0);
                float* yout = (float*)(ws + WS_Y) + ((size_t)h * T + (size_t)c0 * 16) * 64 + 16 * wave + fr;
                for (int c = 0; c < NCL; ++c) {
                    const bf16x4 w0 = cw[0], w1 = cw[1], w2 = cw[2], w3 = cw[3], r0 = cr[0], r1 = cr[1], r2 = cr[2], r3 = cr[3];
                    const bf16x4 b0 = cb[0], b1 = cb[1], b2 = cb[2], b3 = cb[3], k0 = ck[0], k1 = ck[1], k2 = ck[2], k3 = ck[3];
                    const bf16x4 pp_ = cp, mb_ = cmb, mk_ = cmk, vv_ = cv; const f32x4 g0 = cg[0], g1 = cg[1], g2 = cg[2], g3 = cg[3];
                    if (c + 1 < NCL) RW_READ(c + 1);
                    bf16x4 sb[4];
#pragma unroll
                    for (int m = 0; m < 4; ++m) { u32x2 t2; t2.x = pk2(ST[m][0], ST[m][1]); t2.y = pk2(ST[m][2], ST[m][3]); sb[m] = __builtin_bit_cast(bf16x4, t2); }
                    const f32x4 z4 = (f32x4){0.f, 0.f, 0.f, 0.f};
                    f32x4 ua = __builtin_amdgcn_mfma_f32_16x16x16bf16_1k(pp_, vv_, z4, 0, 0, 0);
                    f32x4 ub = __builtin_amdgcn_mfma_f32_16x16x16bf16_1k(w0, sb[0], z4, 0, 0, 0);
                    ua = __builtin_amdgcn_mfma_f32_16x16x16bf16_1k(w1, sb[1], ua, 0, 0, 0);
                    ub = __builtin_amdgcn_mfma_f32_16x16x16bf16_1k(w2, sb[2], ub, 0, 0, 0);
                    ua = __builtin_amdgcn_mfma_f32_16x16x16bf16_1k(w3, sb[3], ua, 0, 0, 0);
                    if (pass == 0) {
                        bf16x4 si[4];
#pragma unroll
                        for (int m = 0; m < 4; ++m) { u32x2 t2; t2.x = pk2(SI[m][0], SI[m][1]); t2.y = pk2(SI[m][2], SI[m][3]); si[m] = __builtin_bit_cast(bf16x4, t2); }
                        f32x4 va = __builtin_amdgcn_mfma_f32_16x16x16bf16_1k(w0, si[0], z4, 0, 0, 0);
                        f32x4 vb = __builtin_amdgcn_mfma_f32_16x16x16bf16_1k(w1, si[1], z4, 0, 0, 0);
                        va = __builtin_amdgcn_mfma_f32_16x16x16bf16_1k(w2, si[2], va, 0, 0, 0);
                        vb = __builtin_amdgcn_mfma_f32_16x16x16bf16_1k(w3, si[3], vb, 0, 0, 0);
                        const f32x4 vt = va + vb; u32x2 v2; v2.x = pk2(vt[0], vt[1]); v2.y = pk2(vt[2], vt[3]); const bf16x4 vbf = __builtin_bit_cast(bf16x4, v2);
                        SI[0] = __builtin_amdgcn_mfma_f32_16x16x16bf16_1k(b0, vbf, SI[0] * g0, 0, 0, 0);
                        SI[1] = __builtin_amdgcn_mfma_f32_16x16x16bf16_1k(b1, vbf, SI[1] * g1, 0, 0, 0);
                        SI[2] = __builtin_amdgcn_mfma_f32_16x16x16bf16_1k(b2, vbf, SI[2] * g2, 0, 0, 0);
                        SI[3] = __builtin_amdgcn_mfma_f32_16x16x16bf16_1k(b3, vbf, SI[3] * g3, 0, 0, 0);
                    }
                    f32x4 ya = z4, yb = z4;
                    if (pass == 1) {
                        ya = __builtin_amdgcn_mfma_f32_16x16x16bf16_1k(mk_, vv_, z4, 0, 0, 0);
                        yb = __builtin_amdgcn_mfma_f32_16x16x16bf16_1k(r0, sb[0], z4, 0, 0, 0);
                        ya = __builtin_amdgcn_mfma_f32_16x16x16bf16_1k(r1, sb[1], ya, 0, 0, 0);
                        yb = __builtin_amdgcn_mfma_f32_16x16x16bf16_1k(r2, sb[2], yb, 0, 0, 0);
                        ya = __builtin_amdgcn_mfma_f32_16x16x16bf16_1k(r3, sb[3], ya, 0, 0, 0);
                    }
                    ST[0] = __builtin_amdgcn_mfma_f32_16x16x16bf16_1k(k0, vv_, ST[0] * g0, 0, 0, 0);
                    ST[1] = __builtin_amdgcn_mfma_f32_16x16x16bf16_1k(k1, vv_, ST[1] * g1, 0, 0, 0);
                    ST[2] = __builtin_amdgcn_mfma_f32_16x16x16bf16_1k(k2, vv_, ST[2] * g2, 0, 0, 0);
                    ST[3] = __builtin_amdgcn_mfma_f32_16x16x16bf16_1k(k3, vv_, ST[3] * g3, 0, 0, 0);
                    const f32x4 ut = ua + ub;
                    u32x2 u2; u2.x = pk2(ut[0], ut[1]); u2.y = pk2(ut[2], ut[3]); const bf16x4 ubf = __builtin_bit_cast(bf16x4, u2);
                    ST[0] = __builtin_amdgcn_mfma_f32_16x16x16bf16_1k(b0, ubf, ST[0], 0, 0, 0);
                    ST[1] = __builtin_amdgcn_mfma_f32_16x16x16bf16_1k(b1, ubf, ST[1], 0, 0, 0);
                    ST[2] = __builtin_amdgcn_mfma_f32_16x16x16bf16_1k(b2, ubf, ST[2], 0, 0, 0);
                    ST[3] = __builtin_amdgcn_mfma_f32_16x16x16bf16_1k(b3, ubf, ST[3], 0, 0, 0);
                    if (pass == 1) {
                        ya = __builtin_amdgcn_mfma_f32_16x16x16bf16_1k(mb_, ubf, ya, 0, 0, 0);
                        const f32x4 yt = ya + yb;
#pragma unroll
                        for (int jj = 0; jj < 4; ++jj) yout[(size_t)(c * 16 + 4 * q + jj) * 64] = yt[jj];
                    }
                    __builtin_amdgcn_s_barrier();
                }
#undef RW_READ
#undef RW_SW
                if (pass == 0) {
                    float* Es = ESEG + ((size_t)h * 32 + sg) * 4096; float* Ms = MSEG + ((size_t)h * 32 + sg) * 4096;
#pragma unroll
                    for (int m = 0; m < 4; ++m)
#pragma unroll
                        for (int v = 0; v < 4; ++v) { const size_t o = (size_t)(16 * m + 4 * q + v) * 64 + 16 * wave + fr; Es[o] = ST[m][v]; Ms[o] = SI[m][v]; }
                }
            }
        }
}

__global__ void __launch_bounds__(NWAVES * 64, 2) mega_fwd(Args a) {
    extern __shared__ __attribute__((aligned(16))) unsigned char lds_raw[];
    LAS unsigned char* lds = (LAS unsigned char*)lds_raw;
    cg::grid_group grid = cg::this_grid();
    const int G = gridDim.x, bid = blockIdx.x;
    volatile LAS unsigned* xst = (volatile LAS unsigned*)(lds + LDS_BYTES - 16);
    if (threadIdx.x < 2) xst[threadIdx.x] = 0u;
    __syncthreads();
    XcdBarrier xbar = xcd_barrier_post((unsigned*)(((KArgs)__builtin_amdgcn_kernarg_segment_ptr())->ws + WS_BAR), xst);
#define GSYNC() xcd_barrier(xbar)
#define GSYNC_CG() do { asm volatile("s_waitcnt vmcnt(0)" ::: "memory"); __syncthreads(); if (threadIdx.x == 0) __builtin_amdgcn_fence(__ATOMIC_RELEASE, "agent"); grid.sync(); __builtin_amdgcn_fence(__ATOMIC_ACQUIRE, "agent"); asm volatile("s_waitcnt vmcnt(0)" ::: "memory"); } while (0)

    {
        PHASE_ARGS
        LAS float* scr = (LAS float*)(lds + wave * 16384);
        constexpr int I_IN = 16 * (DIN / 32), I_SQ = 16 * 32, I_UP = 16 * 128, I_DN = 64 * 32, I_PR = 4 * 32;
        constexpr int NITEMS = I_IN + I_SQ + I_UP + I_DN + I_SQ + I_PR + 2 * I_SQ + I_UP + I_DN + I_SQ + I_PR;
        for (int it = gw; it < NITEMS; it += NGW) {
            int r = it;
            if (r < I_IN) { tr_item(ka->in[3], D, DIN, (bf16*)(ws + W_IN), 0, ka->in[2], scr, r, lane); continue; } r -= I_IN;
            if (r < I_SQ) { tr_item(ka->in[16], D, D, (bf16*)(ws + W_OUT), 0, nullptr, scr, r, lane); continue; } r -= I_SQ;
            if (r < I_UP) { tr_item(ka->in[18], D, FF, (bf16*)(ws + W_UP0), 0, ka->in[17], scr, r, lane); continue; } r -= I_UP;
            if (r < I_DN) { tr_item(ka->in[19], FF, D, (bf16*)(ws + W_DN0), 0, nullptr, scr, r, lane); continue; } r -= I_DN;
            if (r < I_SQ) { tr_item(ka->in[21], D, D, (bf16*)(ws + W_G0), 0, ka->in[20], scr, r, lane); continue; } r -= I_SQ;
            if (r < I_PR) { tr_item(ka->in[22], 256, D, (bf16*)(ws + W_P0), 0, nullptr, scr, r, lane); continue; } r -= I_PR;
            if (r < I_SQ) { tr_item(ka->in[32], D, D, (bf16*)(ws + W_GLU), 1, nullptr, scr, r, lane); continue; } r -= I_SQ;
            if (r < I_SQ) { tr_item(ka->in[33], D, D, (bf16*)(ws + W_GLU), 2, nullptr, scr, r, lane); continue; } r -= I_SQ;
            if (r < I_UP) { tr_item(ka->in[35], D, FF, (bf16*)(ws + W_UP1), 0, ka->in[34], scr, r, lane); continue; } r -= I_UP;
            if (r < I_DN) { tr_item(ka->in[36], FF, D, (bf16*)(ws + W_DN1), 0, nullptr, scr, r, lane); continue; } r -= I_DN;
            if (r < I_SQ) { tr_item(ka->in[38], D, D, (bf16*)(ws + W_G1), 0, ka->in[37], scr, r, lane); continue; } r -= I_SQ;
            tr_item(ka->in[39], 256, D, (bf16*)(ws + W_P1), 0, nullptr, scr, r, lane);
        }
        {
            bf16* WL = (bf16*)(ws + W_LORA); const float* wl = ka->in[6]; const float* al = ka->in[8]; const float* gl = ka->in[9];
            for (int i = bid * 512 + tid; i < 1536 * 256; i += G * 512) {
                const int n = i >> 8, k = i & 255; float v = 0.f;
                if (n < 512) { if (k < 64) v = wl[k * 512 + n]; }
                else if (n < 1024) { if (k >= 64 && k < 128) v = al[(k - 64) * 512 + (n - 512)]; }
                else { if (k >= 128) v = gl[(k - 128) * 512 + (n - 1024)]; }
                WL[i] = (bf16)(pk2(v, 0.f) & 0xffffu);
            }
        }
        for (int m = gw; m < T; m += NGW) {
            const f32x4* xr = (const f32x4*)(ka->in[0] + (size_t)m * D) + lane; f32x4 v[4]; float s = 0.f;
#pragma unroll
            for (int j = 0; j < 4; ++j) { v[j] = xr[64 * j]; s += (v[j][0] * v[j][0] + v[j][1] * v[j][1]) + (v[j][2] * v[j][2] + v[j][3] * v[j][3]); }
            s = wave_sum(s);
            u32x2* o8 = (u32x2*)(B1 + (size_t)m * D) + lane;
#pragma unroll
            for (int j = 0; j < 4; ++j) { u32x2 w; w.x = pk2(v[j][0], v[j][1]); w.y = pk2(v[j][2], v[j][3]); o8[64 * j] = w; }
            if (lane < 16) STA[(size_t)m * 32 + lane] = lane == 0 ? s : 0.f;
        }
        {
            const f32x4* ps = (const f32x4*)ka->in[1]; u32x2* pd = (u32x2*)PBF;
            for (int i = bid * 512 + tid; i < 2 * T * 256 / 4; i += G * 512) { const f32x4 v = ps[i]; u32x2 w; w.x = pk2(v[0], v[1]); w.y = pk2(v[2], v[3]); pd[i] = w; }
        }
        for (int i = bid * 512 + tid; i < 4096; i += G * 512) {
            const int g = i >> 6;
            const float step = expf(ka->in[26][g]); const float lre = fminf(ka->in[24][i], -1e-4f), lim = ka->in[25][i];
            const float x = lre * step, ang = lim * step; float sn, cs; sincosf(ang, &sn, &cs);
            const float er = expf(x); const float lbr = er * cs, lbi = er * sn;
            const float sh = sinf(0.5f * ang); const float nr = expm1f(x) * cs - 2.f * sh * sh, ni = lbi;
            const float d = lre * lre + lim * lim; const float qr = (nr * lre + ni * lim) / d, qi = (ni * lre - nr * lim) / d;
            LB[i] = (f32x2){lbr, lbi};
            float pr = lbr, pi = lbi;
#pragma unroll
            for (int q = 0; q < 7; ++q) { const float tr = pr * pr - pi * pi, ti = 2.f * pr * pi; pr = tr; pi = ti; }
            LBL[i] = (f32x2){pr, pi};
            for (int c = 0; c < 16; ++c) { const float br = ka->in[27][(size_t)i * 16 + c], bi = ka->in[28][(size_t)i * 16 + c]; BB[(size_t)i * 16 + c] = (f32x2){qr * br - qi * bi, qr * bi + qi * br}; }
        }
    }
    GSYNC_CG();

    {
        PHASE_ARGS
        pg8::Gemm g{B1, (const bf16*)(ws + W_IN), T, DIN, D}; pg8::StaticOrder S; S.init(T, DIN, G, bid);
        pg8::EpiB<0, 16> E{Rb, Xb, ZB, STA, nullptr, nullptr, 0};
        pg8::gemm_phase<pg8::EpiB<0, 16>, pg8::StaticOrder, true, true>(lds, g, S, E);
    }
    GSYNC();

    {
        PHASE_ARGS
        const float* mu = ka->in[4]; const float* cw = ka->in[15];
        for (int t = gw; t < T; t += NGW) {
            {
                const u32x2 x0 = *((const u32x2*)(Xb + (size_t)t * 256) + lane);
                u32x2 x1 = (u32x2){0u, 0u}; if (t > 0) x1 = *((const u32x2*)(Xb + (size_t)(t - 1) * 256) + lane);
                const f32x4 m4 = *((const f32x4*)(mu + 1536) + lane);
                float c[4] = {bflo(x0.x), bfhi(x0.x), bflo(x0.y), bfhi(x0.y)}, p[4] = {bflo(x1.x), bfhi(x1.x), bflo(x1.y), bfhi(x1.y)}, o[4];
#pragma unroll
                for (int e = 0; e < 4; ++e) { const float xs = c[e] + m4[e] * (p[e] - c[e]);
                    o[e] = lane < 16 ? tanhf(xs) : (lane < 32 ? xs : pg8::fsigmoid(xs)); }
                u32x2 w; w.x = pk2(o[0], o[1]); w.y = pk2(o[2], o[3]); *((u32x2*)(APb + (size_t)t * 256) + lane) = w;
            }
            {
                const bf16* z0 = ZB + (size_t)t * 1536; float bg[8], c0[8], x0[8], c1[8], x1[8], c2[8], x2[8];
                unpack8(*((const u32x4*)z0 + lane), bg); unpack8(*((const u32x4*)(z0 + 512) + lane), c0); unpack8(*((const u32x4*)(z0 + 1024) + lane), x0);
                const u32x4 zz = (u32x4){0u, 0u, 0u, 0u};
                unpack8(t > 0 ? *((const u32x4*)(z0 - 1536 + 512) + lane) : zz, c1); unpack8(t > 0 ? *((const u32x4*)(z0 - 1536 + 1024) + lane) : zz, x1);
                unpack8(t > 1 ? *((const u32x4*)(z0 - 3072 + 512) + lane) : zz, c2); unpack8(t > 1 ? *((const u32x4*)(z0 - 3072 + 1024) + lane) : zz, x2);
                float o[8];
#pragma unroll
                for (int e = 0; e < 8; ++e) { const int ch = 8 * lane + e; o[e] = bg[e] * (cw[ch] * (c0[e] * x0[e]) + cw[512 + ch] * (c1[e] * x1[e]) + cw[1024 + ch] * (c2[e] * x2[e])); }
                *((u32x4*)(B2 + (size_t)t * D + 512) + lane) = pack8(o);
            }
        }
    }
    GSYNC();

    {
        PHASE_ARGS
        pg8::Gemm g{APb, (const bf16*)(ws + W_LORA), T, 1536, 256}; pg8::StaticOrder S; S.init(T, 1536, G, bid);
        pg8::EpiB<1, 16> E{Eb, Ab, Gb, nullptr, ka->in[5], ka->in[7], 0};
        pg8::gemm_phase<pg8::EpiB<1, 16>, pg8::StaticOrder, true, true>(lds, g, S, E);
    }
    GSYNC();

    {
        PHASE_ARGS
        const float* mu = ka->in[4]; const float* k_k = ka->in[10]; const float* k_a = ka->in[11]; const float* r_k = ka->in[12];
        float mr[8], mk[8], mv[8], kk_[8], ka_[8], rk_[8];
#pragma unroll
        for (int e = 0; e < 8; ++e) { const int ch = 8 * lane + e; mr[e] = mu[ch]; mk[e] = mu[512 + ch]; mv[e] = mu[1024 + ch]; kk_[e] = k_k[ch]; ka_[e] = k_a[ch]; rk_[e] = r_k[ch]; }
        for (int t = gw; t < T; t += NGW) {
            float k0[8], k1[8], r0[8], r1[8], v0[8], v1[8], av[8];
            const u32x4 zz = (u32x4){0u, 0u, 0u, 0u};
            unpack8(*((const u32x4*)(Kb + (size_t)t * 512) + lane), k0); unpack8(t > 0 ? *((const u32x4*)(Kb + (size_t)(t - 1) * 512) + lane) : zz, k1);
            unpack8(*((const u32x4*)(Rb + (size_t)t * 512) + lane), r0); unpack8(t > 0 ? *((const u32x4*)(Rb + (size_t)(t - 1) * 512) + lane) : zz, r1);
            unpack8(*((const u32x4*)(Vb + (size_t)t * 512) + lane), v0); unpack8(t > 0 ? *((const u32x4*)(Vb + (size_t)(t - 1) * 512) + lane) : zz, v1);
            unpack8(*(const u32x4*)(Ab + hm8(t, lane)), av);
            float kp[8], kn[8], rs[8], vs[8]; float ss = 0.f, bs = 0.f;
#pragma unroll
            for (int e = 0; e < 8; ++e) {
                const float ks = k0[e] + mk[e] * (k1[e] - k0[e]); rs[e] = r0[e] + mr[e] * (r1[e] - r0[e]); vs[e] = v0[e] + mv[e] * (v1[e] - v0[e]);
                kn[e] = ks * kk_[e]; ss += kn[e] * kn[e];
                kp[e] = ks * (1.f + (av[e] - 1.f) * ka_[e]); bs += rs[e] * kp[e] * rk_[e];
            }
            ss = sum8(ss); bs = sum8(bs);
            const float inv = 1.f / fmaxf(sqrtf(ss), 1e-12f);
#pragma unroll
            for (int e = 0; e < 8; ++e) kn[e] *= inv;
            *(u32x4*)(KPb + hm8(t, lane)) = pack8(kp);
            *(u32x4*)(KKb + hm8(t, lane)) = pack8(kn);
            *(u32x4*)(RSb + hm8(t, lane)) = pack8(rs);
            *(u32x4*)(VSb + hm8(t, lane)) = pack8(vs);
            if ((lane & 7) == 0) BON[(size_t)t * 8 + (lane >> 3)] = bs;
        }
    }
    GSYNC();

    {
        PHASE_ARGS
        constexpr int TS = 68;
        LAS bf16* TA = (LAS bf16*)(lds + wave * 12288);
        LAS bf16* TBh = TA + 16 * TS; LAS bf16* TKh = TBh + 16 * TS; LAS bf16* TR = TKh + 16 * TS;
        LAS float* MAB = (LAS float*)(lds + wave * 12288 + 8704);
        LAS float* MAK = MAB + 256; LAS float* TM = MAK + 256;
        for (int u = gw; u < 8192; u += NGW) {
            const int c = u >> 3, h = u & 7; const size_t bo = ((size_t)h * T + c * 16) * 64;
            float at[16], bh[16], kh[16], rt[16];
            {
                unsigned short e_[16], k_[16], a_[16], p_[16], r_[16];
#pragma unroll
                for (int t = 0; t < 16; ++t) { const size_t o = bo + (size_t)t * 64 + lane; e_[t] = Eb[o]; k_[t] = KKb[o]; a_[t] = Ab[o]; p_[t] = KPb[o]; r_[t] = RSb[o]; }
                float g = 1.f;
#pragma unroll
                for (int t = 0; t < 16; ++t) {
                    const float w = __builtin_amdgcn_exp2f(-bflo(e_[t])); const float gp = g; g *= w; const float gi = 1.0f / g;
                    const float kkv = bflo(k_[t]);
                    at[t] = -kkv * gp; bh[t] = kkv * bflo(a_[t]) * gi; kh[t] = bflo(p_[t]) * gi; rt[t] = bflo(r_[t]) * g;
                    TA[t * TS + lane] = (bf16)(pk2(at[t], 0.f) & 0xffffu); TBh[t * TS + lane] = (bf16)(pk2(bh[t], 0.f) & 0xffffu);
                    TKh[t * TS + lane] = (bf16)(pk2(kh[t], 0.f) & 0xffffu); TR[t * TS + lane] = (bf16)(pk2(rt[t], 0.f) & 0xffffu);
                }
                bf16* bbp = KKb + bo + (size_t)(lane >> 2) * 64 + (lane & 3) * 16; bf16* kbp = KPb + bo + (size_t)(lane >> 2) * 64 + (lane & 3) * 16;
                float tb[8], tk[8];
#pragma unroll
                for (int hh = 0; hh < 2; ++hh) {
#pragma unroll
                    for (int e = 0; e < 8; ++e) { tb[e] = bh[hh * 8 + e] * g; tk[e] = kh[hh * 8 + e] * g; }
                    *(u32x4*)(bbp + hh * 8) = pack8(tb); *(u32x4*)(kbp + hh * 8) = pack8(tk);
                }
                ((float*)(Eb + bo + (size_t)(12 + (lane >> 5)) * 64))[lane & 31] = g;
#pragma unroll
                for (int t = 0; t < 16; ++t) RSb[bo + (size_t)t * 64 + lane] = (bf16)(pk2(rt[t], 0.f) & 0xffffu);
            }
            const int fr = lane & 15, q = lane >> 4;
            f32x4 mab = (f32x4){0.f, 0.f, 0.f, 0.f}, mak = mab, mbr = mab, mkr = mab;
#pragma unroll
            for (int m = 0; m < 4; ++m) {
                const bf16x4 fb = *(const LAS bf16x4*)(TBh + fr * TS + 16 * m + 4 * q), fk = *(const LAS bf16x4*)(TKh + fr * TS + 16 * m + 4 * q);
                const bf16x4 fa = *(const LAS bf16x4*)(TA + fr * TS + 16 * m + 4 * q), frr = *(const LAS bf16x4*)(TR + fr * TS + 16 * m + 4 * q);
                mab = __builtin_amdgcn_mfma_f32_16x16x16bf16_1k(fb, fa, mab, 0, 0, 0); mak = __builtin_amdgcn_mfma_f32_16x16x16bf16_1k(fk, fa, mak, 0, 0, 0);
                mbr = __builtin_amdgcn_mfma_f32_16x16x16bf16_1k(fb, frr, mbr, 0, 0, 0); mkr = __builtin_amdgcn_mfma_f32_16x16x16bf16_1k(fk, frr, mkr, 0, 0, 0);
            }
#pragma unroll
            for (int jj = 0; jj < 4; ++jj) { const int s = 4 * q + jj;
                MAB[s * 16 + fr] = s < fr ? mab[jj] : 0.f; MAK[s * 16 + fr] = s < fr ? mak[jj] : 0.f;
                mbr[jj] = s <= fr ? mbr[jj] : 0.f; mkr[jj] = s <= fr ? mkr[jj] : 0.f; }
            {
                u32x2 w1, w2; w1.x = pk2(mbr[0], mbr[1]); w1.y = pk2(mbr[2], mbr[3]); w2.x = pk2(mkr[0], mkr[1]); w2.y = pk2(mkr[2], mkr[3]);
                *(u32x2*)(Eb + bo + (size_t)(4 + (fr >> 2)) * 64 + (fr & 3) * 16 + 4 * q) = w1;
                *(u32x2*)(Eb + bo + (size_t)(8 + (fr >> 2)) * 64 + (fr & 3) * 16 + 4 * q) = w2;
            }
            float tm[16];
#pragma unroll
            for (int t = 0; t < 16; ++t) { float acc = (t == fr) ? 1.f : 0.f;
#pragma unroll
                for (int s = 0; s < t; ++s) acc += tm[s] * MAB[s * 16 + t];
                tm[t] = acc; }
            if (q == 0) {
#pragma unroll
                for (int t = 0; t < 16; ++t) TM[fr * 16 + t] = tm[t];
            }
#pragma unroll
            for (int t = 0; t < 16; ++t) { float acc = 0.f;
#pragma unroll
                for (int s = 0; s <= t; ++s) acc += TM[s * 16 + t] * at[s];
                Ab[bo + (size_t)t * 64 + lane] = (bf16)(pk2(acc, 0.f) & 0xffffu); }
            {
                float p4[4] = {0.f, 0.f, 0.f, 0.f};
#pragma unroll
                for (int s2 = 0; s2 < 16; ++s2) { const float mk_ = MAK[fr * 16 + s2];
#pragma unroll
                    for (int e = 0; e < 4; ++e) p4[e] += mk_ * TM[s2 * 16 + 4 * q + e]; }
#pragma unroll
                for (int e = 0; e < 4; ++e) { const int t = 4 * q + e; Eb[bo + (size_t)(t >> 2) * 64 + (t & 3) * 16 + fr] = (bf16)(pk2(p4[e], 0.f) & 0xffffu); }
            }
        }
    }
    GSYNC();

    { PHASE_ARGS rwkv_seg_pass<0>(lds, ws, dob, bid, G, tid); }
    GSYNC();
    { PHASE_ARGS rwkv_seg_pass<1>(lds, ws, dob, bid, G, tid); }
    GSYNC();

    {
        PHASE_ARGS
        const float* lnw = ka->in[13]; const float* lnb = ka->in[14];
        float lw[8], lb[8];
#pragma unroll
        for (int e = 0; e < 8; ++e) { const int ch = 8 * lane + e; lw[e] = lnw[ch]; lb[e] = lnb[ch]; }
        const float* YRp = (const float*)(ws + WS_Y);
        for (int t = gw; t < T; t += NGW) {
            const f32x4 ya = *(const f32x4*)(YRp + hm8(t, lane)), yb = *(const f32x4*)(YRp + hm8(t, lane) + 4);
            float y[8] = {ya[0], ya[1], ya[2], ya[3], yb[0], yb[1], yb[2], yb[3]};
            float vs[8], gv[8];
            unpack8(*(const u32x4*)(VSb + hm8(t, lane)), vs);
            unpack8(*((const u32x4*)(Gb + (size_t)t * 512) + lane), gv);
            float s = 0.f;
#pragma unroll
            for (int e = 0; e < 8; ++e) s += y[e];
            const float mean = sum8(s) * (1.f / 64.f); float qv = 0.f;
#pragma unroll
            for (int e = 0; e < 8; ++e) { y[e] -= mean; qv += y[e] * y[e]; }
            const float rstd = rsqrtf(sum8(qv) * (1.f / 64.f) + 64e-5f);
            const float bon = BON[(size_t)t * 8 + (lane >> 3)];
            float o[8];
#pragma unroll
            for (int e = 0; e < 8; ++e) o[e] = (y[e] * rstd * lw[e] + lb[e] + bon * vs[e]) * gv[e];
            *((u32x4*)(B2 + (size_t)t * D) + lane) = pack8(o);
        }
    }
    GSYNC();

    {
        PHASE_ARGS
        pg8::Gemm g{B2, (const bf16*)(ws + W_OUT), T, D, D}; pg8::StaticOrder S; S.init(T, D, G, bid);
        pg8::EpiRes<0> E{ka->in[0], ka->out, B1, nullptr, STB, nullptr};
        pg8::gemm_phase<pg8::EpiRes<0>, pg8::StaticOrder, true, true>(lds, g, S, E);
    }
    GSYNC();
    {
        PHASE_ARGS
        pg8::Gemm g{B1, (const bf16*)(ws + W_UP0), T, FF, D}; pg8::StaticOrder S; S.init(T, FF, G, bid);
        pg8::EpiB<2, 16> E{HID, nullptr, nullptr, STB, nullptr, nullptr, FF};
        pg8::gemm_phase<pg8::EpiB<2, 16>, pg8::StaticOrder, true, true>(lds, g, S, E);
    }
    GSYNC();
    {
        PHASE_ARGS
        pg8::Gemm g{HID, (const bf16*)(ws + W_DN0), T, D, FF}; pg8::StaticOrder S; S.init(T, D, G, bid);
        pg8::EpiRes<0> E{ka->out, ka->out, B1, nullptr, STA, nullptr};
        pg8::gemm_phase<pg8::EpiRes<0>, pg8::StaticOrder, true, true>(lds, g, S, E);
    }
    GSYNC();
    {
        PHASE_ARGS
        pg8::Gemm g{PBF, (const bf16*)(ws + W_P0), T, D, 256}; pg8::StaticOrder S; S.init(T, D, G, bid);
        pg8::EpiB<3, 16> E{PP, nullptr, nullptr, nullptr, nullptr, nullptr, D};
        pg8::gemm_phase<pg8::EpiB<3, 16>, pg8::StaticOrder, true, true>(lds, g, S, E);
    }
    GSYNC();
    {
        PHASE_ARGS
        pg8::Gemm g{B1, (const bf16*)(ws + W_G0), T, D, D}; pg8::StaticOrder S; S.init(T, D, G, bid);
        pg8::EpiRes<1> E{ka->out, ka->out, B2, STA, STB, PP};
        pg8::gemm_phase<pg8::EpiRes<1>, pg8::StaticOrder, true, true>(lds, g, S, E);
    }
    GSYNC();

#pragma unroll 1
    for (int pass = 0; pass < 2; ++pass) {
        PHASE_ARGS
        LAS bf16* UTb = (LAS bf16*)(lds + wave * 16896);
        LAS bf16* HS = (LAS bf16*)(lds + wave * 16896 + 4096);
        LAS float* BUL = (LAS float*)(lds + wave * 16896 + 8448);
        const float* gm = ka->in[23]; const float* dsk = ka->in[31];
        const int fr = lane & 15, q = lane >> 4;
        for (int u = gw; u < 8192; u += NGW) {
            const int ck = u >> 6, g = u & 63, t0 = ck * 128;
#pragma unroll
            for (int qq = 0; qq < 2; ++qq) {
                const int tk = lane + 64 * qq, t = t0 + tk;
                const f32x4* sp = (const f32x4*)(STB + (size_t)t * 32); const f32x4 s0 = sp[0], s1 = sp[1], s2 = sp[2], s3 = sp[3];
                const float ssq = ((s0[0] + s0[1]) + (s0[2] + s0[3])) + ((s1[0] + s1[1]) + (s1[2] + s1[3])) + ((s2[0] + s2[1]) + (s2[2] + s2[3])) + ((s3[0] + s3[1]) + (s3[2] + s3[3]));
                const float rs = rsqrtf(ssq * (1.f / 1024.f) + 1e-6f);
                float f0[8], f1[8]; unpack8(*(const u32x4*)(B2 + (size_t)t * D + 16 * g), f0); unpack8(*(const u32x4*)(B2 + (size_t)t * D + 16 * g + 8), f1);
                const f32x4 g0 = *(const f32x4*)(gm + 16 * g), g1 = *(const f32x4*)(gm + 16 * g + 4), g2 = *(const f32x4*)(gm + 16 * g + 8), g3 = *(const f32x4*)(gm + 16 * g + 12);
                float o0[8] = {f0[0] * rs * g0[0], f0[1] * rs * g0[1], f0[2] * rs * g0[2], f0[3] * rs * g0[3], f0[4] * rs * g1[0], f0[5] * rs * g1[1], f0[6] * rs * g1[2], f0[7] * rs * g1[3]};
                float o1[8] = {f1[0] * rs * g2[0], f1[1] * rs * g2[1], f1[2] * rs * g2[2], f1[3] * rs * g2[3], f1[4] * rs * g3[0], f1[5] * rs * g3[1], f1[6] * rs * g3[2], f1[7] * rs * g3[3]};
                LAS u32x4* ud = (LAS u32x4*)(UTb + tk * 16); ud[0] = pack8(o0); ud[1] = pack8(o1);
            }
            bf16x4 bre[4], bim[4];
#pragma unroll
            for (int i = 0; i < 4; ++i) {
                const float* bp = (const float*)(BB + ((size_t)g * 64 + 16 * i + fr) * 16 + 4 * q);
                const f32x4 x0 = *(const f32x4*)bp, x1 = *(const f32x4*)(bp + 4);
                u32x2 wr_, wi_; wr_.x = pk2(x0[0], x0[2]); wr_.y = pk2(x1[0], x1[2]); wi_.x = pk2(x0[1], x0[3]); wi_.y = pk2(x1[1], x1[3]);
                bre[i] = __builtin_bit_cast(bf16x4, wr_); bim[i] = __builtin_bit_cast(bf16x4, wi_);
            }
            const f32x2 lam = LB[g * 64 + lane];
            f32x2 hst = (f32x2){0.f, 0.f};
            bf16x8 cf[4]; float dk = 0.f;
            if (pass == 1) {
                const f32x2 lL = LBL[g * 64 + lane];
                for (int c2 = 0; c2 < ck; c2 += 16) {
                    f32x2 eb[16];
#pragma unroll
                    for (int i = 0; i < 16; ++i) eb[i] = (c2 + i < ck) ? EST[((size_t)(c2 + i) * 64 + g) * 64 + lane] : (f32x2){0.f, 0.f};
#pragma unroll
                    for (int i = 0; i < 16; ++i) if (c2 + i < ck) { const float nr = lL[0] * hst[0] - lL[1] * hst[1] + eb[i][0], ni = lL[0] * hst[1] + lL[1] * hst[0] + eb[i][1]; hst = (f32x2){nr, ni}; }
                }
#pragma unroll
                for (int ks = 0; ks < 4; ++ks) {
                    const float* src = (ks < 2 ? ka->in[29] : ka->in[30]) + ((size_t)g * 16 + fr) * 64 + (ks & 1) * 32 + q * 8;
                    const f32x4 x0 = *(const f32x4*)src, x1 = *(const f32x4*)(src + 4); const float sg = ks < 2 ? 1.f : -1.f;
                    u32x4 w; w.x = pk2(sg * x0[0], sg * x0[1]); w.y = pk2(sg * x0[2], sg * x0[3]); w.z = pk2(sg * x1[0], sg * x1[1]); w.w = pk2(sg * x1[2], sg * x1[3]);
                    cf[ks] = __builtin_bit_cast(bf16x8, w);
                }
                dk = dsk[16 * g + fr];
            }
            for (int tg = 0; tg < 8; ++tg) {
                const bf16x4 af = *(const LAS bf16x4*)(UTb + (16 * tg + fr) * 16 + 4 * q);
                const f32x4 z4 = (f32x4){0.f, 0.f, 0.f, 0.f};
#pragma unroll
                for (int i = 0; i < 4; ++i) {
                    const f32x4 dr = __builtin_amdgcn_mfma_f32_16x16x16bf16_1k(af, bre[i], z4, 0, 0, 0), di = __builtin_amdgcn_mfma_f32_16x16x16bf16_1k(af, bim[i], z4, 0, 0, 0);
#pragma unroll
                    for (int v = 0; v < 4; ++v) { BUL[(4 * q + v) * 132 + 16 * i + fr] = dr[v]; BUL[(4 * q + v) * 132 + 64 + 16 * i + fr] = di[v]; }
                }
#pragma unroll
                for (int tl = 0; tl < 16; ++tl) {
                    const float br = BUL[tl * 132 + lane], bi = BUL[tl * 132 + 64 + lane];
                    const float nr = lam[0] * hst[0] - lam[1] * hst[1] + br, ni = lam[0] * hst[1] + lam[1] * hst[0] + bi;
                    hst = (f32x2){nr, ni};
                    if (pass == 1) { const unsigned hw = pk2(nr, ni); HS[tl * 136 + lane] = (bf16)(hw & 0xffffu); HS[tl * 136 + 64 + lane] = (bf16)(hw >> 16); }
                }
                if (pass == 1) {
                    f32x4 acc = z4;
#pragma unroll
                    for (int ks = 0; ks < 4; ++ks) { const bf16x8 hf = *(const LAS bf16x8*)(HS + fr * 136 + ks * 32 + q * 8);
                        acc = __builtin_amdgcn_mfma_f32_16x16x32_bf16(hf, cf[ks], acc, 0, 0, 0); }
#pragma unroll
                    for (int j = 0; j < 4; ++j) { const int tk = tg * 16 + q * 4 + j; const float uv = bflo((unsigned)UTb[tk * 16 + fr]);
                        const float y = gelu_tanh(acc[j] + dk * uv);
                        YG[(size_t)(t0 + tk) * D + 16 * g + fr] = (bf16)(pk2(y, 0.f) & 0xffffu); }
                }
            }
            if (pass == 0) EST[((size_t)ck * 64 + g) * 64 + lane] = hst;
        }
        GSYNC();
    }

    {
        PHASE_ARGS
        pg8::Gemm g{YG, (const bf16*)(ws + W_GLU), T, 2048, D}; pg8::StaticOrder S; S.init(T, 2048, G, bid);
        pg8::EpiRes<2> E{ka->out, ka->out, B1, nullptr, STA, nullptr};
        pg8::gemm_phase<pg8::EpiRes<2>, pg8::StaticOrder, true, true>(lds, g, S, E);
    }
    GSYNC();
    {
        PHASE_ARGS
        pg8::Gemm g{B1, (const bf16*)(ws + W_UP1), T, FF, D}; pg8::StaticOrder S; S.init(T, FF, G, bid);
        pg8::EpiB<2, 32> E{HID, nullptr, nullptr, STA, nullptr, nullptr, FF};
        pg8::gemm_phase<pg8::EpiB<2, 32>, pg8::StaticOrder, true, true>(lds, g, S, E);
    }
    GSYNC();
    {
        PHASE_ARGS
        pg8::Gemm g{HID, (const bf16*)(ws + W_DN1), T, D, FF}; pg8::StaticOrder S; S.init(T, D, G, bid);
        pg8::EpiRes<0> E{ka->out, ka->out, B1, nullptr, STB, nullptr};
        pg8::gemm_phase<pg8::EpiRes<0>, pg8::StaticOrder, true, true>(lds, g, S, E);
    }
    GSYNC();
    {
        PHASE_ARGS
        pg8::Gemm g{PBF + (size_t)T * 256, (const bf16*)(ws + W_P1), T, D, 256}; pg8::StaticOrder S; S.init(T, D, G, bid);
        pg8::EpiB<3, 16> E{PP, nullptr, nullptr, nullptr, nullptr, nullptr, D};
        pg8::gemm_phase<pg8::EpiB<3, 16>, pg8::StaticOrder, true, true>(lds, g, S, E);
    }
    GSYNC();
    {
        PHASE_ARGS
        pg8::Gemm g{B1, (const bf16*)(ws + W_G1), T, D, D}; pg8::StaticOrder S; S.init(T, D, G, bid);
        pg8::EpiRes<1> E{ka->out, ka->out, nullptr, STB, STA, PP};
        pg8::gemm_phase<pg8::EpiRes<1>, pg8::StaticOrder, true, true>(lds, g, S, E);
    }
    GSYNC();
    {
        PHASE_ARGS
        const float* gf = ka->in[40];
        for (int m = gw; m < T; m += NGW) {
            const f32x4* sp = (const f32x4*)(STA + (size_t)m * 32); const f32x4 s0 = sp[0], s1 = sp[1], s2 = sp[2], s3 = sp[3];
            const float ssq = ((s0[0] + s0[1]) + (s0[2] + s0[3])) + ((s1[0] + s1[1]) + (s1[2] + s1[3])) + ((s2[0] + s2[1]) + (s2[2] + s2[3])) + ((s3[0] + s3[1]) + (s3[2] + s3[3]));
            const float rs = rsqrtf(ssq * (1.f / 1024.f) + 1e-6f);
            f32x4* xr = (f32x4*)(ka->out + (size_t)m * D) + lane;
#pragma unroll
            for (int j = 0; j < 4; ++j) { const f32x4 v = xr[64 * j]; const f32x4 gg = *((const f32x4*)gf + lane + 64 * j); xr[64 * j] = v * rs * gg; }
        }
    }
#undef GSYNC
}

extern "C" void kernel_launch(void* const* d_in, const int* in_sizes, int n_in, void* d_out, int out_size, void* d_ws, size_t ws_size, hipStream_t stream) {
    static int grid = 0;
    if (grid == 0) {
        if (n_in != 41 || out_size != T * D || ws_size < WS_END) { fprintf(stderr, "kernel_launch: unexpected shapes (n_in %d, out %d, ws %zu)\n", n_in, out_size, ws_size); grid = -1; return; }
        int dev = 0, cus = 0, per_cu = 0;
        hipGetDevice(&dev); hipDeviceGetAttribute(&cus, hipDeviceAttributeMultiprocessorCount, dev);
        if (hipFuncSetAttribute((const void*)mega_fwd, hipFuncAttributeMaxDynamicSharedMemorySize, LDS_BYTES) != hipSuccess) { fprintf(stderr, "kernel_launch: hipFuncSetAttribute failed\n"); grid = -1; return; }
        if (hipOccupancyMaxActiveBlocksPerMultiprocessor(&per_cu, (const void*)mega_fwd, NWAVES * 64, LDS_BYTES) != hipSuccess || per_cu < 1) { fprintf(stderr, "kernel_launch: occupancy query says %d\n", per_cu); per_cu = 1; }
        (void)hipGetLastError();
        grid = cus;
    }
    if (grid < 0) return;
    if (hipMemsetAsync((char*)d_ws + WS_BAR, 0, 16384, stream) != hipSuccess) { fprintf(stderr, "kernel_launch: memset failed\n"); return; }
    Args a{};
    for (int i = 0; i < 41; ++i) a.in[i] = (const float*)d_in[i];
    a.out = (float*)d_out; a.ws = (unsigned char*)d_ws;
    void* params[] = {&a};
    hipError_t e = hipLaunchCooperativeKernel((const void*)mega_fwd, dim3(grid), dim3(NWAVES * 64), params, LDS_BYTES, stream);
    if (e != hipSuccess) fprintf(stderr, "kernel_launch: cooperative launch failed: %s (grid %d)\n", hipGetErrorString(e), grid);
}
```

```cpp
#include <hip/hip_runtime.h>
#include <hip/hip_cooperative_groups.h>
#include <cstdio>
#include <cstdint>
namespace pg8 {
#define PG8_LAS __attribute__((address_space(3)))
typedef unsigned short bf16_t;
typedef short bf16x8 __attribute__((ext_vector_type(8)));
typedef float f32x4 __attribute__((ext_vector_type(4)));
typedef unsigned u32x4 __attribute__((ext_vector_type(4)));
constexpr int BM = 256, BK = 64, HALF = 128, HTB = HALF * BK * 2  , STAGE_BYTES = 8 * HTB, NXCD = 8, WGM = 8;

__host__ __device__ __forceinline__ int lds_byte(int r, int c) { const int st = (r >> 4) * 2 + (c >> 5), rr = r & 15, cc = c & 31, ob = rr * 64 + cc * 2; return st * 1024 + (ob ^ (((ob >> 9) & 1) << 5)); }
__host__ __device__ __forceinline__ void stage_rc(int b, int& R, int& C) { const int st = b / 1024, sb = b % 1024, swz = sb ^ (((sb >> 9) & 1) << 5); R = (st >> 1) * 16 + swz / 64; C = (st & 1) * 32 + (swz % 64) / 2; }
__host__ __device__ __forceinline__ int perm32(int rho) { const int n = rho >> 4, i = rho & 15; return 8 * (i >> 2) + 4 * n + (i & 3); }

struct Unit { int pm, pn; };
struct Gemm { const bf16_t* A; const bf16_t* Bt; int M, N, K; };

struct StaticOrder {
    int nM, nN, nwg, G, c;
    __host__ __device__ void init(int M, int N, int G_, int c_) { nM = M / BM; nN = N / BM; nwg = nM * nN; G = G_; c = c_; }
    __host__ __device__ bool next(int i, Unit& u) const {
        const long L = (long)i * G + c; if (L >= nwg) return false;
        int wgid = (int)L; { const int q = nwg / NXCD, r = nwg % NXCD, xcd = wgid % NXCD, off = wgid / NXCD; wgid = (xcd < r ? xcd * (q + 1) : r * (q + 1) + (xcd - r) * q) + off; }
        const int nig = WGM * nN, gid = wgid / nig, fm = gid * WGM, gsz = (nM - fm) < WGM ? (nM - fm) : WGM;
        u.pm = fm + ((wgid % nig) % gsz); u.pn = (wgid % nig) / gsz; return true;
    }
    __device__ __forceinline__ void a_ready(const Unit&) const {}
    __device__ __forceinline__ void done(const Unit&) const {}
};

typedef float f32x2n __attribute__((ext_vector_type(2))); typedef __bf16 hbf2n __attribute__((ext_vector_type(2)));
__device__ __forceinline__ unsigned cvt_pk_bf16(float lo, float hi) { const f32x2n v = {lo, hi}; const hbf2n b = __builtin_convertvector(v, hbf2n); return __builtin_bit_cast(unsigned, b); }
typedef float f32x2 __attribute__((ext_vector_type(2)));

constexpr int TT = 16384;
typedef unsigned u32x2 __attribute__((ext_vector_type(2)));
__device__ __forceinline__ float fsigmoid(float x) { return __builtin_amdgcn_rcpf(1.0f + __expf(-x)); }
template <int NSL> __device__ __forceinline__ float row_rstd(const float* st, int r, int fq) {
    const f32x4 v = *(const f32x4*)(st + (size_t)r * 32 + 4 * fq);
    float s = (v[0] + v[1]) + (v[2] + v[3]);
    if (NSL == 32) { const f32x4 w = *(const f32x4*)(st + (size_t)r * 32 + 16 + 4 * fq); s += (w[0] + w[1]) + (w[2] + w[3]); }
    s += __shfl_xor(s, 16); s += __shfl_xor(s, 32);
    return rsqrtf(s * (1.0f / 1024.0f) + 1e-6f);
}
template <int MODE, int NSL> struct EpiB {
    static constexpr bool PERM = true, AFTER_DRAIN = false;
    bf16_t* o0; bf16_t* o1; bf16_t* o2; const float* st; const float* c0; const float* c1; int ldc;
    __device__ __forceinline__ void operator()(const f32x4 (&acc)[2][2][4][2], const Unit& u, int wr, int wc, int fr, int fq) const {
        const int row0 = u.pm * BM + wr * 64 + fr; const int pn = u.pn;
        bf16_t* base; int ld, colt; int kind = 0;
        if (MODE == 0) {
            if (pn < 6) { base = o0 + (size_t)(pn >> 1) * TT * 512; ld = 512; colt = (pn & 1) * 256; }
            else if (pn == 6) { base = o1; ld = 256; colt = 0; }
            else { base = o2; ld = 1536; colt = (pn - 7) * 256; }
        } else if (MODE == 1) {
            kind = pn >> 1; base = o0 + (size_t)kind * TT * 512; if (kind == 2) base = o2; ld = 512; colt = (pn & 1) * 256;
        } else { base = o0; ld = ldc; colt = pn * 256; }
        const int col0 = colt + wc * 32 + 8 * fq;
        const float* cbias = c0; if (kind == 1) cbias = c1; cbias += col0;
        f32x4 bv00 = (f32x4){0.f, 0.f, 0.f, 0.f}, bv01 = bv00, bv10 = bv00, bv11 = bv00;
        if (MODE == 1) { if (kind < 2) { bv00 = *(const f32x4*)(cbias); bv01 = *(const f32x4*)(cbias + 4); bv10 = *(const f32x4*)(cbias + HALF); bv11 = *(const f32x4*)(cbias + HALF + 4); } }
#pragma unroll
        for (int ai = 0; ai < 2; ++ai)
#pragma unroll
            for (int m = 0; m < 4; ++m) {
                const int r = row0 + ai * HALF + m * 16;
                float rs = 1.f;
                if (MODE == 0 || MODE == 2) rs = row_rstd<NSL>(st, r, fq);
                bf16_t* rowp = base + (size_t)r * ld + col0;
#pragma unroll
                for (int bj = 0; bj < 2; ++bj) {
                    f32x4 v0 = acc[ai][bj][m][0], v1 = acc[ai][bj][m][1];
                    if (MODE == 0) { v0 = v0 * rs; v1 = v1 * rs; }
                    if (MODE == 2) {
#pragma unroll
                        for (int e = 0; e < 4; ++e) { float a = fmaxf(v0[e], 0.f) * rs, b = fmaxf(v1[e], 0.f) * rs; v0[e] = a * a; v1[e] = b * b; }
                    }
                    if (MODE == 1) {
                        if (kind < 2) {
                            const float sc = kind == 0 ? (0.6065306597f * 1.4426950409f) : 1.0f;
                            v0 = v0 + (bj == 0 ? bv00 : bv10); v1 = v1 + (bj == 0 ? bv01 : bv11);
#pragma unroll
                            for (int e = 0; e < 4; ++e) { v0[e] = sc * fsigmoid(v0[e]); v1[e] = sc * fsigmoid(v1[e]); }
                        }
                    }
                    u32x4 w; w.x = cvt_pk_bf16(v0[0], v0[1]); w.y = cvt_pk_bf16(v0[2], v0[3]); w.z = cvt_pk_bf16(v1[0], v1[1]); w.w = cvt_pk_bf16(v1[2], v1[3]);
                    if (MODE == 1 && kind < 2) { const int cc_ = col0 + bj * HALF; *(u32x4*)(base + ((size_t)(cc_ >> 6) * TT + r) * 64 + (cc_ & 63)) = w; }
                    else *(u32x4*)(rowp + bj * HALF) = w;
                }
                if (m & 1) asm volatile("" ::: "memory");
            }
    }
};
template <int MODE> struct EpiRes {
    static constexpr bool PERM = false, AFTER_DRAIN = false;
    const float* base; float* out; bf16_t* hb; const float* st_in; float* st_out; const bf16_t* pp;
    __device__ __forceinline__ void operator()(const f32x4 (&acc)[2][2][4][2], const Unit& u, int wr, int wc, int fr, int fq) const {
        constexpr int NB = MODE == 2 ? 1 : 2;
        const int row0 = u.pm * BM + wr * 64 + fr;
        const int cb0 = (MODE == 2 ? u.pn * 128 : u.pn * BM) + wc * 32 + 4 * fq;
        f32x4 bq[2][2][2]; u32x2 pq[2][2][2];
#define ER_LOAD(it_) do { const int r_ = row0 + ((it_) >> 2) * HALF + ((it_) & 3) * 16; _Pragma("unroll") for (int bj = 0; bj < NB; ++bj) _Pragma("unroll") for (int n = 0; n < 2; ++n) { \
            const size_t off_ = (size_t)r_ * 1024 + cb0 + bj * HALF + n * 16; bq[(it_) & 1][bj][n] = *(const f32x4*)(base + off_); if (MODE == 1) pq[(it_) & 1][bj][n] = *(const u32x2*)(pp + off_); } } while (0)
        ER_LOAD(0);
#pragma unroll
        for (int it = 0; it < 8; ++it) {
            const int ai = it >> 2, m = it & 3;
            const int r = row0 + ai * HALF + m * 16;
            if (it + 1 < 8) ER_LOAD(it + 1);
            const float rs = MODE == 1 ? row_rstd<16>(st_in, r, fq) : 1.f;
            float ss = 0.f;
#pragma unroll
            for (int bj = 0; bj < NB; ++bj)
#pragma unroll
                for (int n = 0; n < 2; ++n) {
                    const size_t off = (size_t)r * 1024 + cb0 + bj * HALF + n * 16;
                    const f32x4 b = bq[it & 1][bj][n];
                    f32x4 v = acc[ai][bj][m][n];
                    if (MODE == 1) {
                        const u32x2 pw = pq[it & 1][bj][n];
                        const float p0 = __uint_as_float(pw.x << 16), p1 = __uint_as_float(pw.x & 0xffff0000u), p2 = __uint_as_float(pw.y << 16), p3 = __uint_as_float(pw.y & 0xffff0000u);
                        v[0] = p0 * fsigmoid(v[0] * rs); v[1] = p1 * fsigmoid(v[1] * rs); v[2] = p2 * fsigmoid(v[2] * rs); v[3] = p3 * fsigmoid(v[3] * rs);
                    }
                    if (MODE == 2) {
                        const f32x4 g = acc[ai][1][m][n];
#pragma unroll
                        for (int e = 0; e < 4; ++e) v[e] = v[e] * fsigmoid(g[e]);
                    }
                    const f32x4 o = b + v;
                    *(f32x4*)(out + off) = o;
                    if (hb) { u32x2 w; w.x = cvt_pk_bf16(o[0], o[1]); w.y = cvt_pk_bf16(o[2], o[3]); *(u32x2*)(hb + off) = w; }
                    ss += (o[0] * o[0] + o[1] * o[1]) + (o[2] * o[2] + o[3] * o[3]);
                }
            ss += __shfl_xor(ss, 16); ss += __shfl_xor(ss, 32);
            if (fq == 0) st_out[(size_t)r * 32 + u.pn * 4 + wc] = ss;
            asm volatile("" ::: "memory");
        }
#undef ER_LOAD
    }
};

template <class Epi, class Sched, bool ALIGN_EPI = false, bool SP2 = false>
__device__ __forceinline__ void gemm_phase(PG8_LAS unsigned char* lds, const Gemm g, const Sched& S, const Epi& E) {
    int tid_l = threadIdx.x; asm volatile("" : "+v"(tid_l)); const int tid = tid_l, wid = __builtin_amdgcn_readfirstlane(tid >> 6), lane = tid & 63, wr = wid >> 2, wc = wid & 3, fr = lane & 15, fq = lane >> 4;
    int K = g.K; asm volatile("" : "+s"(K)); const int nt = K / BK;
    unsigned voffA[2], voffB[2];
#pragma unroll
    for (int i = 0; i < 2; ++i) { int R, C; stage_rc(tid * 16 + i * 8192, R, C); const int Rb = Epi::PERM ? ((R & ~31) + perm32(R & 31)) : R;
        voffA[i] = (unsigned)(R * K + C) * 2u; voffB[i] = (unsigned)(Rb * K + C) * 2u; }
    const size_t kstep = (size_t)(BK * 2);
    const size_t hstep = (size_t)HALF * K * 2;
    const size_t tstep = 2 * hstep;
    const unsigned ldsw = (unsigned)wid * 1024u;
    const int aoff = lds_byte(wr * 64 + fr, fq * 8), boff = lds_byte(wc * 32 + fr, fq * 8);
#define PG8_SA(b, h) (((b) * 2 + (h)) * HTB)
#define PG8_SB(b, h) ((4 + (b) * 2 + (h)) * HTB)
#define PG8_STAGE(bufoff, gbase, voff) do { _Pragma("unroll") for (int _i = 0; _i < 2; ++_i) \
        __builtin_amdgcn_global_load_lds((const unsigned*)((const char*)(gbase) + (voff)[_i]), (PG8_LAS unsigned*)(lds + (bufoff) + ldsw + _i * 8192), 16, 0, 0); } while (0)
#define PG8_LDA(dst, b, h) do { _Pragma("unroll") for (int m = 0; m < 4; ++m) _Pragma("unroll") for (int k = 0; k < 2; ++k) dst[m][k] = *(const PG8_LAS bf16x8*)(lds + PG8_SA(b, h) + aoff + m * 2048 + k * 1024); } while (0)
#define PG8_LDB(dst, b, h) do { _Pragma("unroll") for (int n = 0; n < 2; ++n) _Pragma("unroll") for (int k = 0; k < 2; ++k) dst[n][k] = *(const PG8_LAS bf16x8*)(lds + PG8_SB(b, h) + boff + n * 2048 + k * 1024); } while (0)
#define PG8_MMA(ai, bj, At, Bt) do { __builtin_amdgcn_s_setprio(1); _Pragma("unroll") for (int m = 0; m < 4; ++m) _Pragma("unroll") for (int n = 0; n < 2; ++n) _Pragma("unroll") for (int k = 0; k < 2; ++k) \
        acc[ai][bj][m][n] = __builtin_amdgcn_mfma_f32_16x16x32_bf16(Bt[n][k], At[m][k], acc[ai][bj][m][n], 0, 0, 0); __builtin_amdgcn_s_setprio(0); } while (0)
#define PG8_WAIT_V(n) asm volatile("s_waitcnt vmcnt(" #n ")" ::: "memory")
#define PG8_WAIT_L(n) asm volatile("s_waitcnt lgkmcnt(" #n ")" ::: "memory")
#define PG8_BAR __builtin_amdgcn_s_barrier()
#define PG8_SCHED __builtin_amdgcn_sched_barrier(0)
    Unit cur, nxt; int ui = 0;
    if (!S.next(0, cur)) return;
    f32x4 acc[2][2][4][2];
#pragma unroll
    for (int a = 0; a < 2; ++a)
#pragma unroll
        for (int b = 0; b < 2; ++b)
#pragma unroll
            for (int m = 0; m < 4; ++m)
#pragma unroll
                for (int n = 0; n < 2; ++n) acc[a][b][m][n] = (f32x4){0.f, 0.f, 0.f, 0.f};
    bf16x8 At[4][2], B0[2][2], B1[2][2];
    const char* cA = (const char*)g.A + (size_t)cur.pm * tstep; const char* cB = (const char*)g.Bt + (size_t)cur.pn * tstep;
    S.a_ready(cur);
    if constexpr (SP2) {
        PG8_STAGE(PG8_SB(0, 0), cB, voffB); PG8_STAGE(PG8_SB(0, 1), cB + hstep, voffB); PG8_STAGE(PG8_SA(0, 0), cA, voffA); PG8_STAGE(PG8_SA(0, 1), cA + hstep, voffA);
        if (wr == 1) PG8_BAR;
        PG8_WAIT_V(2); PG8_BAR;
        PG8_STAGE(PG8_SB(1, 0), cB + kstep, voffB); PG8_STAGE(PG8_SA(1, 0), cA + kstep, voffA); PG8_STAGE(PG8_SB(1, 1), cB + hstep + kstep, voffB);
        PG8_WAIT_V(6); PG8_BAR;
    } else {
        PG8_STAGE(PG8_SB(0, 0), cB, voffB); PG8_STAGE(PG8_SA(0, 0), cA, voffA); PG8_STAGE(PG8_SB(0, 1), cB + hstep, voffB); PG8_STAGE(PG8_SA(0, 1), cA + hstep, voffA);
        if (wr == 1) PG8_BAR;
        PG8_WAIT_V(4); PG8_BAR;
        PG8_STAGE(PG8_SB(1, 0), cB + kstep, voffB); PG8_STAGE(PG8_SA(1, 0), cA + kstep, voffA); PG8_STAGE(PG8_SB(1, 1), cB + hstep + kstep, voffB);
        PG8_WAIT_V(6); PG8_BAR;
    }
    for (;;) {
        const bool has_next = S.next(ui + 1, nxt);
        const char* nA = has_next ? (const char*)g.A + (size_t)nxt.pm * tstep : cA; const char* nB = has_next ? (const char*)g.Bt + (size_t)nxt.pn * tstep : cB;
        for (int t = 0; t < nt; t += 2) {
            const bool last = (t == nt - 2);
            const char* a1 = cA + (size_t)(t + 1) * kstep;
            const char* a2 = last ? nA : cA + (size_t)(t + 2) * kstep; const char* b2 = last ? nB : cB + (size_t)(t + 2) * kstep;
            const char* a3 = a2 + kstep; const char* b3 = b2 + kstep;
            if (last && has_next) S.a_ready(nxt);
            if constexpr (SP2) {
            PG8_LDB(B0, 0, 0); PG8_LDB(B1, 0, 1); PG8_SCHED; PG8_LDA(At, 0, 0); PG8_STAGE(PG8_SA(1, 1), a1 + hstep, voffA);
            PG8_WAIT_V(8); PG8_WAIT_L(0); PG8_BAR; PG8_MMA(0, 0, At, B0); PG8_MMA(0, 1, At, B1); PG8_BAR; PG8_SCHED;
            PG8_LDA(At, 0, 1); PG8_STAGE(PG8_SB(0, 0), b2, voffB); PG8_STAGE(PG8_SB(0, 1), b2 + hstep, voffB); PG8_STAGE(PG8_SA(0, 0), a2, voffA);
            PG8_WAIT_V(8); PG8_WAIT_L(0); PG8_BAR; PG8_MMA(1, 0, At, B0); PG8_MMA(1, 1, At, B1); PG8_BAR; PG8_SCHED;
            PG8_LDB(B0, 1, 0); PG8_LDB(B1, 1, 1); PG8_SCHED; PG8_LDA(At, 1, 0); PG8_STAGE(PG8_SA(0, 1), a2 + hstep, voffA);
            PG8_WAIT_V(8); PG8_WAIT_L(0); PG8_BAR; PG8_MMA(0, 0, At, B0); PG8_MMA(0, 1, At, B1); PG8_BAR; PG8_SCHED;
            PG8_LDA(At, 1, 1); PG8_STAGE(PG8_SB(1, 0), b3, voffB); PG8_STAGE(PG8_SB(1, 1), b3 + hstep, voffB); PG8_STAGE(PG8_SA(1, 0), a3, voffA);
            PG8_WAIT_V(8); PG8_WAIT_L(0); PG8_BAR; PG8_MMA(1, 0, At, B0); PG8_MMA(1, 1, At, B1); PG8_BAR; PG8_SCHED;
            } else {
            PG8_LDB(B0, 0, 0); PG8_SCHED; PG8_LDA(At, 0, 0); PG8_STAGE(PG8_SA(1, 1), a1 + hstep, voffA);
            PG8_WAIT_L(8); PG8_BAR; PG8_WAIT_L(0); PG8_MMA(0, 0, At, B0); PG8_BAR; PG8_SCHED;
            PG8_LDB(B1, 0, 1); PG8_STAGE(PG8_SB(0, 0), b2, voffB);
            PG8_BAR; PG8_WAIT_L(0); PG8_MMA(0, 1, At, B1); PG8_BAR;
            PG8_LDA(At, 0, 1); PG8_STAGE(PG8_SA(0, 0), a2, voffA);
            PG8_BAR; PG8_WAIT_L(0); PG8_MMA(1, 0, At, B0); PG8_BAR; PG8_SCHED;
            PG8_STAGE(PG8_SB(0, 1), b2 + hstep, voffB);
            PG8_WAIT_V(6); PG8_BAR; PG8_MMA(1, 1, At, B1); PG8_BAR;
            PG8_LDB(B0, 1, 0); PG8_SCHED; PG8_LDA(At, 1, 0); PG8_STAGE(PG8_SA(0, 1), a2 + hstep, voffA);
            PG8_WAIT_L(8); PG8_BAR; PG8_WAIT_L(0); PG8_MMA(0, 0, At, B0); PG8_BAR; PG8_SCHED;
            PG8_LDB(B1, 1, 1); PG8_STAGE(PG8_SB(1, 0), b3, voffB);
            PG8_BAR; PG8_WAIT_L(0); PG8_MMA(0, 1, At, B1); PG8_BAR;
            PG8_LDA(At, 1, 1); PG8_STAGE(PG8_SA(1, 0), a3, voffA);
            PG8_BAR; PG8_WAIT_L(0); PG8_MMA(1, 0, At, B0); PG8_BAR; PG8_SCHED;
            PG8_STAGE(PG8_SB(1, 1), b3 + hstep, voffB);
            PG8_WAIT_V(6); PG8_BAR; PG8_MMA(1, 1, At, B1); PG8_BAR;
            }
        }
        if constexpr (ALIGN_EPI) { if (wr == 0) PG8_BAR; }
        if constexpr (!Epi::AFTER_DRAIN) { E(acc, cur, wr, wc, fr, fq); S.done(cur); }
        if (!has_next) break;
#pragma unroll
        for (int a = 0; a < 2; ++a)
#pragma unroll
            for (int b = 0; b < 2; ++b)
#pragma unroll
                for (int m = 0; m < 4; ++m)
#pragma unroll
                    for (int n = 0; n < 2; ++n) acc[a][b][m][n] = (f32x4){0.f, 0.f, 0.f, 0.f};
        cur = nxt; cA = nA; cB = nB; ++ui;
        if constexpr (ALIGN_EPI) { if (wr == 1) PG8_BAR; }
    }
    PG8_WAIT_V(0);
    if constexpr (!ALIGN_EPI) { if (wr == 0) PG8_BAR; }
    PG8_BAR;
    if constexpr (Epi::AFTER_DRAIN) { E.fused(acc, cur, wr, wc, fr, fq, lds, wid, lane); S.done(cur); }
#undef PG8_SA
#undef PG8_SB
#undef PG8_STAGE
#undef PG8_LDA
#undef PG8_LDB
#undef PG8_MMA
#undef PG8_WAIT_V
#undef PG8_WAIT_L
#undef PG8_BAR
#undef PG8_SCHED
}
}

namespace cg = cooperative_groups;
#define LAS __attribute__((address_space(3)))
typedef unsigned short bf16;
typedef float f32x4 __attribute__((ext_vector_type(4)));
typedef float f32x2 __attribute__((ext_vector_type(2)));
typedef unsigned u32x4 __attribute__((ext_vector_type(4)));
typedef unsigned u32x2 __attribute__((ext_vector_type(2)));
typedef short bf16x8 __attribute__((ext_vector_type(8)));
typedef short bf16x4 __attribute__((ext_vector_type(4)));

constexpr int T = 16384, D = 1024, FF = 4096, DIN = 3328, NWAVES = 8;
constexpr int LDS_BYTES = 147456;
constexpr size_t KiB = 1024, MiB = 1024 * 1024;
constexpr size_t WS_BON = 0;
constexpr size_t WS_EST = 1 * MiB;
constexpr size_t WS_S5P = 5 * MiB;
constexpr size_t WS_STA = 8 * MiB, WS_STB = 10 * MiB;
constexpr size_t W_IN = 12 * MiB, W_LORA = W_IN + 6656 * KiB, W_OUT = W_LORA + 768 * KiB, W_UP0 = W_OUT + 2 * MiB, W_DN0 = W_UP0 + 8 * MiB, W_G0 = W_DN0 + 8 * MiB,
                 W_P0 = W_G0 + 2 * MiB, W_GLU = W_P0 + 512 * KiB, W_UP1 = W_GLU + 4 * MiB, W_DN1 = W_UP1 + 8 * MiB, W_G1 = W_DN1 + 8 * MiB, W_P1 = W_G1 + 2 * MiB;
static_assert(W_P1 + 512 * KiB <= 64 * MiB, "weights");
constexpr size_t WS_PBF = 64 * MiB;
constexpr size_t WS_B1 = 80 * MiB, WS_B2 = 112 * MiB;
constexpr size_t WS_R = 144 * MiB, WS_E = 192 * MiB, WS_A = 208 * MiB, WS_KP = 224 * MiB;
constexpr size_t WS_HID = 112 * MiB;
constexpr size_t WS_PP = 144 * MiB, WS_YG = 144 * MiB;
constexpr size_t WS_ESEG = 1 * MiB, WS_MSEG = 240 * MiB;
constexpr size_t WS_END = 244 * MiB;
constexpr size_t DO_ZB = 0, DO_X = 48 * MiB, DO_AP = 56 * MiB, DO_KK = 48 * MiB, DO_G = 0, DO_RS = 16 * MiB, DO_VS = 32 * MiB;
constexpr size_t WS_Y = 144 * MiB;

__device__ __forceinline__ size_t hm8(int t, int lane) { return ((size_t)(lane >> 3) * T + t) * 64 + (lane & 7) * 8; }
__device__ __forceinline__ float bflo(unsigned w) { return __uint_as_float(w << 16); }
__device__ __forceinline__ float bfhi(unsigned w) { return __uint_as_float(w & 0xffff0000u); }
__device__ __forceinline__ unsigned pk2(float lo, float hi) { return pg8::cvt_pk_bf16(lo, hi); }
__device__ __forceinline__ void unpack8(const u32x4 w, float (&f)[8]) { f[0] = bflo(w.x); f[1] = bfhi(w.x); f[2] = bflo(w.y); f[3] = bfhi(w.y); f[4] = bflo(w.z); f[5] = bfhi(w.z); f[6] = bflo(w.w); f[7] = bfhi(w.w); }
__device__ __forceinline__ u32x4 pack8(const float (&f)[8]) { u32x4 w; w.x = pk2(f[0], f[1]); w.y = pk2(f[2], f[3]); w.z = pk2(f[4], f[5]); w.w = pk2(f[6], f[7]); return w; }
__device__ __forceinline__ float wave_sum(float v) {
#pragma unroll
    for (int o = 1; o < 64; o <<= 1) v += __shfl_xor(v, o);
    return v;
}
__device__ __forceinline__ float sum8(float v) { v += __shfl_xor(v, 1); v += __shfl_xor(v, 2); v += __shfl_xor(v, 4); return v; }
template <int CTRL, int RM> __device__ __forceinline__ float dpp0(float x) {
    return __builtin_bit_cast(float, __builtin_amdgcn_update_dpp(0, __builtin_bit_cast(int, x), CTRL, RM, 0xf, false));
}
__device__ __forceinline__ float wave_sum_dpp(float x) {
    x += dpp0<0xB1, 0xf>(x);
    x += dpp0<0x4E, 0xf>(x);
    x += dpp0<0x141, 0xf>(x);
    x += dpp0<0x140, 0xf>(x);
    x += dpp0<0x142, 0xa>(x);
    x += dpp0<0x143, 0xc>(x);
    return __builtin_bit_cast(float, __builtin_amdgcn_readlane(__builtin_bit_cast(int, x), 63));
}
__device__ __forceinline__ float gelu_tanh(float x) {
    const float u = 0.7978845608f * (x + 0.044715f * x * x * x);
    const float e = __expf(2.0f * u);
    const float th = 1.0f - 2.0f * __builtin_amdgcn_rcpf(e + 1.0f);
    return 0.5f * x * (1.0f + th);
}

__device__ __forceinline__ void tr_item(const float* W, int K, int N, bf16* WT, int mode, const float* gain, LAS float* scr, int item, int lane) {
    const int nblk = N / 32, kb = item / nblk, nb = item % nblk, k0 = 64 * kb, n0 = 32 * nb;
#pragma unroll 8
    for (int i = 0; i < 32; ++i) { const int kk = 2 * i + (lane >> 5); float v = W[(size_t)(k0 + kk) * N + n0 + (lane & 31)]; if (gain) v *= gain[k0 + kk]; scr[kk * 33 + (lane & 31)] = v; }
    asm volatile("s_waitcnt lgkmcnt(0)" ::: "memory");
    const int c = lane & 7;
#pragma unroll
    for (int j = 0; j < 4; ++j) { const int n = (lane >> 3) + 8 * j; const LAS float* s = scr + (8 * c) * 33 + n;
        u32x4 o; o.x = pk2(s[0 * 33], s[1 * 33]); o.y = pk2(s[2 * 33], s[3 * 33]); o.z = pk2(s[4 * 33], s[5 * 33]); o.w = pk2(s[6 * 33], s[7 * 33]);
        const int ng = n0 + n; const int row = mode == 0 ? ng : (256 * (ng >> 7) + (ng & 127) + (mode == 2 ? 128 : 0));
        *(u32x4*)(WT + (size_t)row * K + k0 + 8 * c) = o; }
    asm volatile("s_waitcnt lgkmcnt(0)" ::: "memory");
}

#define RLX_AGENT __ATOMIC_RELAXED, __HIP_MEMORY_SCOPE_AGENT
#define XB_TMO      128
#define XB_XCNT(j)  (256  + 64 * (j))
#define XB_XSUB(j)  (1280 + 64 * (j))
#define XB_XGEN(j)  (2304 + 64 * (j))
#define XB_TOP      3328
#define XB_TOPGEN   3392
#define XCD_BAR_WORDS 3456
#define XB_SPIN_CAP (1u << 18)

__device__ __forceinline__ unsigned xb_ld(unsigned* p)              { return __hip_atomic_load(p, __ATOMIC_RELAXED, __HIP_MEMORY_SCOPE_AGENT); }
__device__ __forceinline__ unsigned xb_add(unsigned* p, unsigned v) { return __hip_atomic_fetch_add(p, v, __ATOMIC_RELAXED, __HIP_MEMORY_SCOPE_AGENT); }
__device__ __forceinline__ unsigned xb_xcc_id() { return (unsigned)__builtin_amdgcn_s_getreg((3 << 11) | 20) & 0xFu; }
#define XB_SPIN(cond, bar) do { unsigned _sp = 0; while (cond) { __builtin_amdgcn_s_sleep(1); \
    if ((++_sp & 255u) == 0u) { if (xb_ld(&(bar)[XB_TMO])) break; if (_sp > XB_SPIN_CAP) { atomicAdd(&(bar)[XB_TMO], 1u); break; } } } } while (0)

struct XcdBarrier {
    unsigned* bar; unsigned x;
    volatile LAS unsigned* st;
};

__device__ __forceinline__ XcdBarrier xcd_barrier_post(unsigned* bar, volatile LAS unsigned* st) {
    XcdBarrier b; b.bar = bar; b.x = xb_xcc_id(); b.st = st;
    if (threadIdx.x == 0) (void)xb_add(&bar[XB_XCNT(b.x)], 1u);
    return b;
}
__device__ __forceinline__ void xcd_barrier_complete(unsigned* bar, unsigned x, unsigned& nloc, unsigned& nx) {
    const unsigned G = gridDim.x * gridDim.y * gridDim.z;
    unsigned sum, cnt, mine, sp = 0u;
    for (;;) {
        sum = 0u; cnt = 0u; mine = 0u;
#pragma unroll
        for (unsigned j = 0; j < 16; ++j) { const unsigned c = xb_ld(&bar[XB_XCNT(j)]); sum += c; cnt += (c > 0u) ? 1u : 0u; mine = (j == x) ? c : mine; }
        if (sum == G) break;
        __builtin_amdgcn_s_sleep(1);
        if ((++sp & 255u) == 0u) { if (xb_ld(&bar[XB_TMO])) break; if (sp > XB_SPIN_CAP) { atomicAdd(&bar[XB_TMO], 1u); break; } }
    }
    nloc = mine > 0u ? mine : 1u; nx = cnt > 0u ? cnt : 1u;
}

__device__ __forceinline__ void xcd_barrier(const XcdBarrier& b) {
    asm volatile("s_waitcnt vmcnt(0)" ::: "memory");
    __syncthreads();
    if (threadIdx.x == 0) {
        unsigned* bar = b.bar;
        __builtin_amdgcn_s_waitcnt(0);
        unsigned nloc = b.st[0], nx = b.st[1];
        if (nloc == 0u) { xcd_barrier_complete(bar, b.x, nloc, nx); b.st[0] = nloc; b.st[1] = nx; }
        const unsigned old = xb_add(&bar[XB_XSUB(b.x)], 1u);
        const unsigned gen = old / nloc;
        if (old + 1u == (gen + 1u) * nloc) {
            __builtin_amdgcn_fence(__ATOMIC_RELEASE, "agent");
            asm volatile("s_waitcnt vmcnt(0)" ::: "memory");
            const unsigned og = xb_add(&bar[XB_TOP], 1u);
            const unsigned tg = og / nx;
            if (og + 1u == (tg + 1u) * nx) xb_add(&bar[XB_TOPGEN], 1u);
            else XB_SPIN(xb_ld(&bar[XB_TOPGEN]) == tg, bar);
            __builtin_amdgcn_fence(__ATOMIC_ACQUIRE, "agent");
            xb_add(&bar[XB_XGEN(b.x)], 1u);
            asm volatile("s_waitcnt vmcnt(0)" ::: "memory");
        } else {
            XB_SPIN(xb_ld(&bar[XB_XGEN(b.x)]) == gen, bar);
            __builtin_amdgcn_fence(__ATOMIC_ACQUIRE, "agent");
            asm volatile("s_waitcnt vmcnt(0)" ::: "memory");
        }
    }
    __syncthreads();
}

constexpr size_t WS_BAR = 6 * MiB;
struct Args { const float* in[41]; float* out; unsigned char* ws; };
typedef const __attribute__((address_space(4))) Args* KArgs;
__device__ __forceinline__ KArgs kargs() { KArgs p = (KArgs)__builtin_amdgcn_kernarg_segment_ptr(); asm volatile("" : "+s"(p)); return p; }


#define STA ((float*)(ws + WS_STA))
#define STB ((float*)(ws + WS_STB))
#define B1 ((bf16*)(ws + WS_B1))
#define B2 ((bf16*)(ws + WS_B2))
#define Rb ((bf16*)(ws + WS_R))
#define Kb (Rb + (size_t)T * 512)
#define Vb (Rb + (size_t)T * 1024)
#define Eb ((bf16*)(ws + WS_E))
#define Ab ((bf16*)(ws + WS_A))
#define KPb ((bf16*)(ws + WS_KP))
#define ZB ((bf16*)(dob + DO_ZB))
#define Xb ((bf16*)(dob + DO_X))
#define APb ((bf16*)(dob + DO_AP))
#define KKb ((bf16*)(dob + DO_KK))
#define Gb ((bf16*)(dob + DO_G))
#define RSb ((bf16*)(dob + DO_RS))
#define VSb ((bf16*)(dob + DO_VS))
#define BON ((float*)(ws + WS_BON))
#define HID ((bf16*)(ws + WS_HID))
#define PP ((bf16*)(ws + WS_PP))
#define YG ((bf16*)(ws + WS_YG))
#define PBF ((bf16*)(ws + WS_PBF))
#define EST ((f32x2*)(ws + WS_EST))
#define LB ((f32x2*)(ws + WS_S5P))
#define LBL (LB + 4096)
#define BB (LB + 8192)
#define PHASE_ARGS KArgs ka = kargs(); unsigned char* const ws = ka->ws; unsigned char* const dob = (unsigned char*)ka->out; (void)dob; int tid_p = threadIdx.x; asm volatile("" : "+v"(tid_p)); const int tid = tid_p, lane = tid & 63, wave = __builtin_amdgcn_readfirstlane(tid >> 6), gw = bid * NWAVES + wave, NGW = G * NWAVES; (void)gw; (void)NGW; (void)lane;

template <int pass> __device__ __forceinline__ void rwkv_seg_pass(LAS unsigned char* lds, unsigned char* const ws, unsigned char* const dob, const int bid, const int G, const int tid) {
    const int lane = tid & 63, wave = __builtin_amdgcn_readfirstlane(tid >> 6);
        constexpr int NCL = 32, NS = 10, SLOT = 12288;
        float* ESEG = (float*)(ws + WS_ESEG); float* MSEG = (float*)(ws + WS_MSEG);
        for (int job = bid; job < 256; job += G) {
            const int h = job & 7, sg = job >> 3, c0 = sg * NCL;
            __syncthreads();
            if (wave >= 4) {
                const int lw = wave - 4;
                const unsigned char* srcb[3]; unsigned ldso[3];
#pragma unroll
                for (int i = 0; i < 3; ++i) { const int p = (lw * 3 + i) * 64 + lane; const int blk = p >> 7, seg = (p >> 3) & 15, part = (p & 7) ^ ((seg >> 1) & 7);
                    const bf16* base = blk == 0 ? Ab : (blk == 1 ? RSb : (blk == 2 ? KKb : (blk == 3 ? KPb : (blk == 4 ? Eb : VSb))));
                    srcb[i] = (const unsigned char*)(base + ((size_t)h * T + seg) * 64) + part * 16; ldso[i] = (unsigned)((lw * 3 + i) * 1024); }
#define RW_ISSUE(cc_) do { const int cq = c0 + ((cc_) < NCL ? (cc_) : NCL - 1); const unsigned so = (unsigned)(((cc_) % NS) * SLOT); _Pragma("unroll") for (int i = 0; i < 3; ++i) \
        __builtin_amdgcn_global_load_lds((const unsigned*)(srcb[i] + (size_t)cq * 2048), (LAS unsigned*)(lds + so + ldso[i]), 16, 0, 0); } while (0)
                for (int c = 0; c < NS - 1; ++c) RW_ISSUE(c);
                asm volatile("s_waitcnt vmcnt(21)" ::: "memory");
                __builtin_amdgcn_s_barrier();
                for (int c = 0; c < NCL; ++c) {
                    RW_ISSUE(c + NS - 1);
                    asm volatile("s_waitcnt vmcnt(21)" ::: "memory");
                    __builtin_amdgcn_s_barrier();
                }
                asm volatile("s_waitcnt vmcnt(0)" ::: "memory");
#undef RW_ISSUE
            } else {
                const int fr = lane & 15, q = lane >> 4;
                f32x4 ST[4], SI[4];
#pragma unroll
                for (int m = 0; m < 4; ++m) { ST[m] = (f32x4){0.f, 0.f, 0.f, 0.f}; const int d_ = 16 * wave + fr - 16 * m - 4 * q;
                    SI[m] = (f32x4){d_ == 0 ? 1.f : 0.f, d_ == 1 ? 1.f : 0.f, d_ == 2 ? 1.f : 0.f, d_ == 3 ? 1.f : 0.f}; }
                if (pass == 1) {
                    const float* Mh = MSEG + (size_t)h * 32 * 4096; const float* Eh = ESEG + (size_t)h * 32 * 4096;
                    for (int s = 0; s < sg; ++s) {
                        const float* Ms = Mh + (size_t)s * 4096; const float* Es = Eh + (size_t)s * 4096;
                        bf16x4 shi[4], slo[4];
#pragma unroll
                        for (int k = 0; k < 4; ++k) { const f32x4 x = ST[k]; u32x2 hw; hw.x = pk2(x[0], x[1]); hw.y = pk2(x[2], x[3]);
                            const f32x4 xh = (f32x4){bflo(hw.x), bfhi(hw.x), bflo(hw.y), bfhi(hw.y)}; const f32x4 xl = x - xh; u32x2 lw2; lw2.x = pk2(xl[0], xl[1]); lw2.y = pk2(xl[2], xl[3]);
                            shi[k] = __builtin_bit_cast(bf16x4, hw); slo[k] = __builtin_bit_cast(bf16x4, lw2); }
                        f32x4 nw[4];
#pragma unroll
                        for (int m = 0; m < 4; ++m) { const float* ep_ = Es + (size_t)(16 * m + 4 * q) * 64 + 16 * wave + fr; nw[m] = (f32x4){ep_[0], ep_[64], ep_[128], ep_[192]}; }
#pragma unroll
                        for (int m = 0; m < 4; ++m) {
#pragma unroll
                            for (int k = 0; k < 4; ++k) {
                                const f32x4 x = *(const f32x4*)(Ms + (size_t)(16 * m + fr) * 64 + 16 * k + 4 * q);
                                u32x2 hw; hw.x = pk2(x[0], x[1]); hw.y = pk2(x[2], x[3]);
                                const f32x4 xh = (f32x4){bflo(hw.x), bfhi(hw.x), bflo(hw.y), bfhi(hw.y)}; const f32x4 xl = x - xh; u32x2 lw2; lw2.x = pk2(xl[0], xl[1]); lw2.y = pk2(xl[2], xl[3]);
                                const bf16x4 ahi = __builtin_bit_cast(bf16x4, hw), alo = __builtin_bit_cast(bf16x4, lw2);
                                nw[m] = __builtin_amdgcn_mfma_f32_16x16x16bf16_1k(ahi, shi[k], nw[m], 0, 0, 0);
                                nw[m] = __builtin_amdgcn_mfma_f32_16x16x16bf16_1k(ahi, slo[k], nw[m], 0, 0, 0);
                                nw[m] = __builtin_amdgcn_mfma_f32_16x16x16bf16_1k(alo, shi[k], nw[m], 0, 0, 0);
                            }
                            asm volatile("" ::: "memory");
                        }
#pragma unroll
                        for (int m = 0; m < 4; ++m) ST[m] = nw[m];
                    }
                }
                bf16x4 cw[4], cr[4], cb[4], ck[4], cp, cmb, cmk, cv; f32x4 cg[4];
#define RW_SW(seg_, pc_) ((((pc_) ^ (((seg_) >> 1) & 7))) * 16)
#define RW_READ(cc_) do { const LAS unsigned char* sl = lds + ((cc_) % NS) * SLOT; \
        _Pragma("unroll") for (int m = 0; m < 4; ++m) { const int sg_ = 4 * m + (fr >> 2), gs_ = 12 + ((16 * m + 4 * q) >> 5); \
            cw[m] = *(const LAS bf16x4*)(sl + 0 * 2048 + fr * 128 + RW_SW(fr, 2 * m + (q >> 1)) + (q & 1) * 8); \
            cr[m] = *(const LAS bf16x4*)(sl + 1 * 2048 + fr * 128 + RW_SW(fr, 2 * m + (q >> 1)) + (q & 1) * 8); \
            cb[m] = *(const LAS bf16x4*)(sl + 2 * 2048 + sg_ * 128 + RW_SW(sg_, (fr & 3) * 2 + (q >> 1)) + (q & 1) * 8); \
            ck[m] = *(const LAS bf16x4*)(sl + 3 * 2048 + sg_ * 128 + RW_SW(sg_, (fr & 3) * 2 + (q >> 1)) + (q & 1) * 8); \
            cg[m] = *(const LAS f32x4*)(sl + 4 * 2048 + gs_ * 128 + RW_SW(gs_, ((16 * m + 4 * q) & 31) >> 2)); } \
        { const int s0_ = fr >> 2, s1_ = 4 + (fr >> 2), s2_ = 8 + (fr >> 2), pc_ = (fr & 3) * 2 + (q >> 1); \
        cp  = *(const LAS bf16x4*)(sl + 4 * 2048 + s0_ * 128 + RW_SW(s0_, pc_) + (q & 1) * 8); \
        cmb = *(const LAS bf16x4*)(sl + 4 * 2048 + s1_ * 128 + RW_SW(s1_, pc_) + (q & 1) * 8); \
        cmk = *(const LAS bf16x4*)(sl + 4 * 2048 + s2_ * 128 + RW_SW(s2_, pc_) + (q & 1) * 8); } \
        _Pragma("unroll") for (int jj = 0; jj < 4; ++jj) cv[jj] = *(const LAS short*)(sl + 5 * 2048 + (4 * q + jj) * 128 + RW_SW(4 * q + jj, 2 * wave + (fr >> 3)) + (fr & 7) * 2); } while (0)
                __builtin_amdgcn_s_barrier();
                RW_READ(0);
                float* yout = (float*)(ws + WS_Y) + ((size_t)h * T + (size_t)c0 * 16) * 64 + 16 * wave + fr;
                for (int c = 0; c < NCL; ++c) {
                    const bf16x4 w0 = cw[0], w1 = cw[1], w2 = cw[2], w3 = cw[3], r0 = cr[0], r1 = cr[1], r2 = cr[2], r3 = cr[3];
                    const bf16x4 b0 = cb[0], b1 = cb[1], b2 = cb[2], b3 = cb[3], k0 = ck[0], k1 = ck[1], k2 = ck[2], k3 = ck[3];
                    const bf16x4 pp_ = cp, mb_ = cmb, mk_ = cmk, vv_ = cv; const f32x4 g0 = cg[0], g1 = cg[1], g2 = cg[2], g3 = cg[3];
                    if (c + 1 < NCL) RW_READ(c + 1);
                    bf16x4 sb[4];
#pragma unroll
                    for (int m = 0; m < 4; ++m) { u32x2 t2; t2.x = pk2(ST[m][0], ST[m][1]); t2.y = pk2(ST[m][2], ST[m][3]); sb[m] = __builtin_bit_cast(bf16x4, t2); }
                    const f32x4 z4 = (f32x4){0.f, 0.f, 0.f, 0.f};
                    f32x4 ua = __builtin_amdgcn_mfma_f32_16x16x16bf16_1k(pp_, vv_, z4, 0, 0, 0);
                    f32x4 ub = __builtin_amdgcn_mfma_f32_16x16x16bf16_1k(w0, sb[0], z4, 0, 0, 0);
                    ua = __builtin_amdgcn_mfma_f32_16x16x16bf16_1k(w1, sb[1], ua, 0, 0, 0);
                    ub = __builtin_amdgcn_mfma_f32_16x16x16bf16_1k(w2, sb[2], ub, 0, 0, 0);
                    ua = __builtin_amdgcn_mfma_f32_16x16x16bf16_1k(w3, sb[3], ua, 0, 0, 0);
                    if (pass == 0) {
                        bf16x4 si[4];
#pragma unroll
                        for (int m = 0; m < 4; ++m) { u32x2 t2; t2.x = pk2(SI[m][0], SI[m][1]); t2.y = pk2(SI[m][2], SI[m][3]); si[m] = __builtin_bit_cast(bf16x4, t2); }
                        f32x4 va = __builtin_amdgcn_mfma_f32_16x16x16bf16_1k(w0, si[0], z4, 0, 0, 0);
                        f32x4 vb = __builtin_amdgcn_mfma_f32_16x16x16bf16_1k(w1, si[1], z4, 0, 0, 0);
                        va = __builtin_amdgcn_mfma_f32_16x16x16bf16_1k(w2, si[2], va, 0, 0, 0);
                        vb = __builtin_amdgcn_mfma_f32_16x16x16bf16_1k(w3, si[3], vb, 0, 0, 0);
                        const f32x4 vt = va + vb; u32x2 v2; v2.x = pk2(vt[0], vt[1]); v2.y = pk2(vt[2], vt[3]); const bf16x4 vbf = __builtin_bit_cast(bf16x4, v2);
                        SI[0] = __builtin_amdgcn_mfma_f32_16x16x16bf16_1k(b0, vbf, SI[0] * g0, 0, 0, 0);
                        SI[1] = __builtin_amdgcn_mfma_f32_16x16x16bf16_1k(b1, vbf, SI[1] * g1, 0, 0, 0);
                        SI[2] = __builtin_amdgcn_mfma_f32_16x16x16bf16_1k(b2, vbf, SI[2] * g2, 0, 0, 0);
                        SI[3] = __builtin_amdgcn_mfma_f32_16x16x16bf16_1k(b3, vbf, SI[3] * g3, 0, 0, 0);
                    }
                    f32x4 ya = z4, yb = z4;
                    if (pass == 1) {
                        ya = __builtin_amdgcn_mfma_f32_16x16x16bf16_1k(mk_, vv_, z4, 0, 0, 0);
                        yb = __builtin_amdgcn_mfma_f32_16x16x16bf16_1k(r0, sb[0], z4, 0, 0, 0);
                        ya = __builtin_amdgcn_mfma_f32_16x16x16bf16_1k(r1, sb[1], ya, 0, 0, 0);
                        yb = __builtin_amdgcn_mfma_f32_16x16x16bf16_1k(r2, sb[2], yb, 0, 0, 0);
                        ya = __builtin_amdgcn_mfma_f32_16x16x16bf16_1k(r3, sb[3], ya, 0, 0, 0);
                    }
                    ST[0] = __builtin_amdgcn_mfma_f32_16x16x16bf16_1k(k0, vv_, ST[0] * g0, 0, 0, 0);
                    ST[1] = __builtin_amdgcn_mfma_f32_16x16x16bf16_1k(k1, vv_, ST[1] * g1, 0, 0, 0);
                    ST[2] = __builtin_amdgcn_mfma_f32_16x16x16bf16_1k(k2, vv_, ST[2] * g2, 0, 0, 0);
                    ST[3] = __builtin_amdgcn_mfma_f32_16x16x16bf16_1k(k3, vv_, ST[3] * g3, 0, 0, 0);
                    const f32x4 ut = ua + ub;
                    u32x2 u2; u2.x = pk2(ut[0], ut[1]); u2.y = pk2(ut[2], ut[3]); const bf16x4 ubf = __builtin_bit_cast(bf16x4, u2);
                    ST[0] = __builtin_amdgcn_mfma_f32_16x16x16bf16_1k(b0, ubf, ST[0], 0, 0, 0);
                    ST[1] = __builtin_amdgcn_mfma_f32_16x16x16bf16_1k(b1, ubf, ST[1], 0, 0, 0);
                    ST[2] = __builtin_amdgcn_mfma_f32_16x16x16bf16_1k(b2, ubf, ST[2], 0, 0, 0);
                    ST[3] = __builtin_amdgcn_mfma_f32_16x16x16bf16_1k(b3, ubf, ST[3], 0, 0, 0);
                    if (pass == 1) {
                        ya = __builtin_amdgcn_mfma_f32_16x16x16bf16_1k(mb_, ubf, ya, 0, 0, 0);
                        const f32x4 yt = ya + yb;
#pragma unroll
                        for (int jj = 0; jj < 4; ++jj) yout[(size_t)(c * 16 + 4 * q + jj) * 64] = yt[jj];
                    }
                    __builtin_amdgcn_s_barrier();
                }
#undef RW_READ
#undef RW_SW
                if (pass == 0) {
                    float* Es = ESEG + ((size_t)h * 32 + sg) * 4096; float* Ms = MSEG + ((size_t)h * 32 + sg) * 4096;
#pragma unroll
                    for (int m = 0; m < 4; ++m)
#pragma unroll
                        for (int v = 0; v < 4; ++v) { const size_t o = (size_t)(16 * m + 4 * q + v) * 64 + 16 * wave + fr; Es[o] = ST[m][v]; Ms[o] = SI[m][v]; }
                }
            }
        }
}

__global__ void __launch_bounds__(NWAVES * 64, 2) mega_fwd(Args a) {
    extern __shared__ __attribute__((aligned(16))) unsigned char lds_raw[];
    LAS unsigned char* lds = (LAS unsigned char*)lds_raw;
    cg::grid_group grid = cg::this_grid();
    const int G = gridDim.x, bid = blockIdx.x;
    volatile LAS unsigned* xst = (volatile LAS unsigned*)(lds + LDS_BYTES - 16);
    if (threadIdx.x < 2) xst[threadIdx.x] = 0u;
    __syncthreads();
    XcdBarrier xbar = xcd_barrier_post((unsigned*)(((KArgs)__builtin_amdgcn_kernarg_segment_ptr())->ws + WS_BAR), xst);
#define GSYNC() xcd_barrier(xbar)
#define GSYNC_CG() do { asm volatile("s_waitcnt vmcnt(0)" ::: "memory"); __syncthreads(); if (threadIdx.x == 0) __builtin_amdgcn_fence(__ATOMIC_RELEASE, "agent"); grid.sync(); __builtin_amdgcn_fence(__ATOMIC_ACQUIRE, "agent"); asm volatile("s_waitcnt vmcnt(0)" ::: "memory"); } while (0)

    {
        PHASE_ARGS
        LAS float* scr = (LAS float*)(lds + wave * 16384);
        constexpr int I_IN = 16 * (DIN / 32), I_SQ = 16 * 32, I_UP = 16 * 128, I_DN = 64 * 32, I_PR = 4 * 32;
        constexpr int NITEMS = I_IN + I_SQ + I_UP + I_DN + I_SQ + I_PR + 2 * I_SQ + I_UP + I_DN + I_SQ + I_PR;
        for (int it = gw; it < NITEMS; it += NGW) {
            int r = it;
            if (r < I_IN) { tr_item(ka->in[3], D, DIN, (bf16*)(ws + W_IN), 0, ka->in[2], scr, r, lane); continue; } r -= I_IN;
            if (r < I_SQ) { tr_item(ka->in[16], D, D, (bf16*)(ws + W_OUT), 0, nullptr, scr, r, lane); continue; } r -= I_SQ;
            if (r < I_UP) { tr_item(ka->in[18], D, FF, (bf16*)(ws + W_UP0), 0, ka->in[17], scr, r, lane); continue; } r -= I_UP;
            if (r < I_DN) { tr_item(ka->in[19], FF, D, (bf16*)(ws + W_DN0), 0, nullptr, scr, r, lane); continue; } r -= I_DN;
            if (r < I_SQ) { tr_item(ka->in[21], D, D, (bf16*)(ws + W_G0), 0, ka->in[20], scr, r, lane); continue; } r -= I_SQ;
            if (r < I_PR) { tr_item(ka->in[22], 256, D, (bf16*)(ws + W_P0), 0, nullptr, scr, r, lane); continue; } r -= I_PR;
            if (r < I_SQ) { tr_item(ka->in[32], D, D, (bf16*)(ws + W_GLU), 1, nullptr, scr, r, lane); continue; } r -= I_SQ;
            if (r < I_SQ) { tr_item(ka->in[33], D, D, (bf16*)(ws + W_GLU), 2, nullptr, scr, r, lane); continue; } r -= I_SQ;
            if (r < I_UP) { tr_item(ka->in[35], D, FF, (bf16*)(ws + W_UP1), 0, ka->in[34], scr, r, lane); continue; } r -= I_UP;
            if (r < I_DN) { tr_item(ka->in[36], FF, D, (bf16*)(ws + W_DN1), 0, nullptr, scr, r, lane); continue; } r -= I_DN;
            if (r < I_SQ) { tr_item(ka->in[38], D, D, (bf16*)(ws + W_G1), 0, ka->in[37], scr, r, lane); continue; } r -= I_SQ;
            tr_item(ka->in[39], 256, D, (bf16*)(ws + W_P1), 0, nullptr, scr, r, lane);
        }
        {
            bf16* WL = (bf16*)(ws + W_LORA); const float* wl = ka->in[6]; const float* al = ka->in[8]; const float* gl = ka->in[9];
            for (int i = bid * 512 + tid; i < 1536 * 256; i += G * 512) {
                const int n = i >> 8, k = i & 255; float v = 0.f;
                if (n < 512) { if (k < 64) v = wl[k * 512 + n]; }
                else if (n < 1024) { if (k >= 64 && k < 128) v = al[(k - 64) * 512 + (n - 512)]; }
                else { if (k >= 128) v = gl[(k - 128) * 512 + (n - 1024)]; }
                WL[i] = (bf16)(pk2(v, 0.f) & 0xffffu);
            }
        }
        for (int m = gw; m < T; m += NGW) {
            const f32x4* xr = (const f32x4*)(ka->in[0] + (size_t)m * D) + lane; f32x4 v[4]; float s = 0.f;
#pragma unroll
            for (int j = 0; j < 4; ++j) { v[j] = xr[64 * j]; s += (v[j][0] * v[j][0] + v[j][1] * v[j][1]) + (v[j][2] * v[j][2] + v[j][3] * v[j][3]); }
            s = wave_sum(s);
            u32x2* o8 = (u32x2*)(B1 + (size_t)m * D) + lane;
#pragma unroll
            for (int j = 0; j < 4; ++j) { u32x2 w; w.x = pk2(v[j][0], v[j][1]); w.y = pk2(v[j][2], v[j][3]); o8[64 * j] = w; }
            if (lane < 16) STA[(size_t)m * 32 + lane] = lane == 0 ? s : 0.f;
        }
        {
            const f32x4* ps = (const f32x4*)ka->in[1]; u32x2* pd = (u32x2*)PBF;
            for (int i = bid * 512 + tid; i < 2 * T * 256 / 4; i += G * 512) { const f32x4 v = ps[i]; u32x2 w; w.x = pk2(v[0], v[1]); w.y = pk2(v[2], v[3]); pd[i] = w; }
        }
        for (int i = bid * 512 + tid; i < 4096; i += G * 512) {
            const int g = i >> 6;
            const float step = expf(ka->in[26][g]); const float lre = fminf(ka->in[24][i], -1e-4f), lim = ka->in[25][i];
            const float x = lre * step, ang = lim * step; float sn, cs; sincosf(ang, &sn, &cs);
            const float er = expf(x); const float lbr = er * cs, lbi = er * sn;
            const float sh = sinf(0.5f * ang); const float nr = expm1f(x) * cs - 2.f * sh * sh, ni = lbi;
            const float d = lre * lre + lim * lim; const float qr = (nr * lre + ni * lim) / d, qi = (ni * lre - nr * lim) / d;
            LB[i] = (f32x2){lbr, lbi};
            float pr = lbr, pi = lbi;
#pragma unroll
            for (int q = 0; q < 7; ++q) { const float tr = pr * pr - pi * pi, ti = 2.f * pr * pi; pr = tr; pi = ti; }
            LBL[i] = (f32x2){pr, pi};
            for (int c = 0; c < 16; ++c) { const float br = ka->in[27][(size_t)i * 16 + c], bi = ka->in[28][(size_t)i * 16 + c]; BB[(size_t)i * 16 + c] = (f32x2){qr * br - qi * bi, qr * bi + qi * br}; }
        }
    }
    GSYNC_CG();

    {
        PHASE_ARGS
        pg8::Gemm g{B1, (const bf16*)(ws + W_IN), T, DIN, D}; pg8::StaticOrder S; S.init(T, DIN, G, bid);
        pg8::EpiB<0, 16> E{Rb, Xb, ZB, STA, nullptr, nullptr, 0};
        pg8::gemm_phase<pg8::EpiB<0, 16>, pg8::StaticOrder, true, true>(lds, g, S, E);
    }
    GSYNC();

    {
        PHASE_ARGS
        const float* mu = ka->in[4]; const float* cw = ka->in[15];
        for (int t = gw; t < T; t += NGW) {
            {
                const u32x2 x0 = *((const u32x2*)(Xb + (size_t)t * 256) + lane);
                u32x2 x1 = (u32x2){0u, 0u}; if (t > 0) x1 = *((const u32x2*)(Xb + (size_t)(t - 1) * 256) + lane);
                const f32x4 m4 = *((const f32x4*)(mu + 1536) + lane);
                float c[4] = {bflo(x0.x), bfhi(x0.x), bflo(x0.y), bfhi(x0.y)}, p[4] = {bflo(x1.x), bfhi(x1.x), bflo(x1.y), bfhi(x1.y)}, o[4];
#pragma unroll
                for (int e = 0; e < 4; ++e) { const float xs = c[e] + m4[e] * (p[e] - c[e]);
                    o[e] = lane < 16 ? tanhf(xs) : (lane < 32 ? xs : pg8::fsigmoid(xs)); }
                u32x2 w; w.x = pk2(o[0], o[1]); w.y = pk2(o[2], o[3]); *((u32x2*)(APb + (size_t)t * 256) + lane) = w;
            }
            {
                const bf16* z0 = ZB + (size_t)t * 1536; float bg[8], c0[8], x0[8], c1[8], x1[8], c2[8], x2[8];
                unpack8(*((const u32x4*)z0 + lane), bg); unpack8(*((const u32x4*)(z0 + 512) + lane), c0); unpack8(*((const u32x4*)(z0 + 1024) + lane), x0);
                const u32x4 zz = (u32x4){0u, 0u, 0u, 0u};
                unpack8(t > 0 ? *((const u32x4*)(z0 - 1536 + 512) + lane) : zz, c1); unpack8(t > 0 ? *((const u32x4*)(z0 - 1536 + 1024) + lane) : zz, x1);
                unpack8(t > 1 ? *((const u32x4*)(z0 - 3072 + 512) + lane) : zz, c2); unpack8(t > 1 ? *((const u32x4*)(z0 - 3072 + 1024) + lane) : zz, x2);
                float o[8];
#pragma unroll
                for (int e = 0; e < 8; ++e) { const int ch = 8 * lane + e; o[e] = bg[e] * (cw[ch] * (c0[e] * x0[e]) + cw[512 + ch] * (c1[e] * x1[e]) + cw[1024 + ch] * (c2[e] * x2[e])); }
                *((u32x4*)(B2 + (size_t)t * D + 512) + lane) = pack8(o);
            }
        }
    }
    GSYNC();

    {
        PHASE_ARGS
        pg8::Gemm g{APb, (const bf16*)(ws + W_LORA), T, 1536, 256}; pg8::StaticOrder S; S.init(T, 1536, G, bid);
        pg8::EpiB<1, 16> E{Eb, Ab, Gb, nullptr, ka->in[5], ka->in[7], 0};
        pg8::gemm_phase<pg8::EpiB<1, 16>, pg8::StaticOrder, true, true>(lds, g, S, E);
    }
    GSYNC();

    {
        PHASE_ARGS
        const float* mu = ka->in[4]; const float* k_k = ka->in[10]; const float* k_a = ka->in[11]; const float* r_k = ka->in[12];
        float mr[8], mk[8], mv[8], kk_[8], ka_[8], rk_[8];
#pragma unroll
        for (int e = 0; e < 8; ++e) { const int ch = 8 * lane + e; mr[e] = mu[ch]; mk[e] = mu[512 + ch]; mv[e] = mu[1024 + ch]; kk_[e] = k_k[ch]; ka_[e] = k_a[ch]; rk_[e] = r_k[ch]; }
        for (int t = gw; t < T; t += NGW) {
            float k0[8], k1[8], r0[8], r1[8], v0[8], v1[8], av[8];
            const u32x4 zz = (u32x4){0u, 0u, 0u, 0u};
            unpack8(*((const u32x4*)(Kb + (size_t)t * 512) + lane), k0); unpack8(t > 0 ? *((const u32x4*)(Kb + (size_t)(t - 1) * 512) + lane) : zz, k1);
            unpack8(*((const u32x4*)(Rb + (size_t)t * 512) + lane), r0); unpack8(t > 0 ? *((const u32x4*)(Rb + (size_t)(t - 1) * 512) + lane) : zz, r1);
            unpack8(*((const u32x4*)(Vb + (size_t)t * 512) + lane), v0); unpack8(t > 0 ? *((const u32x4*)(Vb + (size_t)(t - 1) * 512) + lane) : zz, v1);
            unpack8(*(const u32x4*)(Ab + hm8(t, lane)), av);
            float kp[8], kn[8], rs[8], vs[8]; float ss = 0.f, bs = 0.f;
#pragma unroll
            for (int e = 0; e < 8; ++e) {
                const float ks = k0[e] + mk[e] * (k1[e] - k0[e]); rs[e] = r0[e] + mr[e] * (r1[e] - r0[e]); vs[e] = v0[e] + mv[e] * (v1[e] - v0[e]);
                kn[e] = ks * kk_[e]; ss += kn[e] * kn[e];
                kp[e] = ks * (1.f + (av[e] - 1.f) * ka_[e]); bs += rs[e] * kp[e] * rk_[e];
            }
            ss = sum8(ss); bs = sum8(bs);
            const float inv = 1.f / fmaxf(sqrtf(ss), 1e-12f);
#pragma unroll
            for (int e = 0; e < 8; ++e) kn[e] *= inv;
            *(u32x4*)(KPb + hm8(t, lane)) = pack8(kp);
            *(u32x4*)(KKb + hm8(t, lane)) = pack8(kn);
            *(u32x4*)(RSb + hm8(t, lane)) = pack8(rs);
            *(u32x4*)(VSb + hm8(t, lane)) = pack8(vs);
            if ((lane & 7) == 0) BON[(size_t)t * 8 + (lane >> 3)] = bs;
        }
    }
    GSYNC();

    {
        PHASE_ARGS
        constexpr int TS = 68;
        LAS bf16* TA = (LAS bf16*)(lds + wave * 12288);
        LAS bf16* TBh = TA + 16 * TS; LAS bf16* TKh = TBh + 16 * TS; LAS bf16* TR = TKh + 16 * TS;
        LAS float* MAB = (LAS float*)(lds + wave * 12288 + 8704);
        LAS float* MAK = MAB + 256; LAS float* TM = MAK + 256;
        for (int u = gw; u < 8192; u += NGW) {
            const int c = u >> 3, h = u & 7; const size_t bo = ((size_t)h * T + c * 16) * 64;
            float at[16], bh[16], kh[16], rt[16];
            {
                unsigned short e_[16], k_[16], a_[16], p_[16], r_[16];
#pragma unroll
                for (int t = 0; t < 16; ++t) { const size_t o = bo + (size_t)t * 64 + lane; e_[t] = Eb[o]; k_[t] = KKb[o]; a_[t] = Ab[o]; p_[t] = KPb[o]; r_[t] = RSb[o]; }
                float g = 1.f;
#pragma unroll
                for (int t = 0; t < 16; ++t) {
                    const float w = __builtin_amdgcn_exp2f(-bflo(e_[t])); const float gp = g; g *= w; const float gi = 1.0f / g;
                    const float kkv = bflo(k_[t]);
                    at[t] = -kkv * gp; bh[t] = kkv * bflo(a_[t]) * gi; kh[t] = bflo(p_[t]) * gi; rt[t] = bflo(r_[t]) * g;
                    TA[t * TS + lane] = (bf16)(pk2(at[t], 0.f) & 0xffffu); TBh[t * TS + lane] = (bf16)(pk2(bh[t], 0.f) & 0xffffu);
                    TKh[t * TS + lane] = (bf16)(pk2(kh[t], 0.f) & 0xffffu); TR[t * TS + lane] = (bf16)(pk2(rt[t], 0.f) & 0xffffu);
                }
                bf16* bbp = KKb + bo + (size_t)(lane >> 2) * 64 + (lane & 3) * 16; bf16* kbp = KPb + bo + (size_t)(lane >> 2) * 64 + (lane & 3) * 16;
                float tb[8], tk[8];
#pragma unroll
                for (int hh = 0; hh < 2; ++hh) {
#pragma unroll
                    for (int e = 0; e < 8; ++e) { tb[e] = bh[hh * 8 + e] * g; tk[e] = kh[hh * 8 + e] * g; }
                    *(u32x4*)(bbp + hh * 8) = pack8(tb); *(u32x4*)(kbp + hh * 8) = pack8(tk);
                }
                ((float*)(Eb + bo + (size_t)(12 + (lane >> 5)) * 64))[lane & 31] = g;
#pragma unroll
                for (int t = 0; t < 16; ++t) RSb[bo + (size_t)t * 64 + lane] = (bf16)(pk2(rt[t], 0.f) & 0xffffu);
            }
            const int fr = lane & 15, q = lane >> 4;
            f32x4 mab = (f32x4){0.f, 0.f, 0.f, 0.f}, mak = mab, mbr = mab, mkr = mab;
#pragma unroll
            for (int m = 0; m < 4; ++m) {
                const bf16x4 fb = *(const LAS bf16x4*)(TBh + fr * TS + 16 * m + 4 * q), fk = *(const LAS bf16x4*)(TKh + fr * TS + 16 * m + 4 * q);
                const bf16x4 fa = *(const LAS bf16x4*)(TA + fr * TS + 16 * m + 4 * q), frr = *(const LAS bf16x4*)(TR + fr * TS + 16 * m + 4 * q);
                mab = __builtin_amdgcn_mfma_f32_16x16x16bf16_1k(fb, fa, mab, 0, 0, 0); mak = __builtin_amdgcn_mfma_f32_16x16x16bf16_1k(fk, fa, mak, 0, 0, 0);
                mbr = __builtin_amdgcn_mfma_f32_16x16x16bf16_1k(fb, frr, mbr, 0, 0, 0); mkr = __builtin_amdgcn_mfma_f32_16x16x16bf16_1k(fk, frr, mkr, 0, 0, 0);
            }
#pragma unroll
            for (int jj = 0; jj < 4; ++jj) { const int s = 4 * q + jj;
                MAB[s * 16 + fr] = s < fr ? mab[jj] : 0.f; MAK[s * 16 + fr] = s < fr ? mak[jj] : 0.f;
                mbr[jj] = s <= fr ? mbr[jj] : 0.f; mkr[jj] = s <= fr ? mkr[jj] : 0.f; }
            {
                u32x2 w1, w2; w1.x = pk2(mbr[0], mbr[1]); w1.y = pk2(mbr[2], mbr[3]); w2.x = pk2(mkr[0], mkr[1]); w2.y = pk2(mkr[2], mkr[3]);
                *(u32x2*)(Eb + bo + (size_t)(4 + (fr >> 2)) * 64 + (fr & 3) * 16 + 4 * q) = w1;
                *(u32x2*)(Eb + bo + (size_t)(8 + (fr >> 2)) * 64 + (fr & 3) * 16 + 4 * q) = w2;
            }
            float tm[16];
#pragma unroll
            for (int t = 0; t < 16; ++t) { float acc = (t == fr) ? 1.f : 0.f;
#pragma unroll
                for (int s = 0; s < t; ++s) acc += tm[s] * MAB[s * 16 + t];
                tm[t] = acc; }
            if (q == 0) {
#pragma unroll
                for (int t = 0; t < 16; ++t) TM[fr * 16 + t] = tm[t];
            }
#pragma unroll
            for (int t = 0; t < 16; ++t) { float acc = 0.f;
#pragma unroll
                for (int s = 0; s <= t; ++s) acc += TM[s * 16 + t] * at[s];
                Ab[bo + (size_t)t * 64 + lane] = (bf16)(pk2(acc, 0.f) & 0xffffu); }
            {
                float p4[4] = {0.f, 0.f, 0.f, 0.f};
#pragma unroll
                for (int s2 = 0; s2 < 16; ++s2) { const float mk_ = MAK[fr * 16 + s2];
#pragma unroll
                    for (int e = 0; e < 4; ++e) p4[e] += mk_ * TM[s2 * 16 + 4 * q + e]; }
#pragma unroll
                for (int e = 0; e < 4; ++e) { const int t = 4 * q + e; Eb[bo + (size_t)(t >> 2) * 64 + (t & 3) * 16 + fr] = (bf16)(pk2(p4[e], 0.f) & 0xffffu); }
            }
        }
    }
    GSYNC();

    { PHASE_ARGS rwkv_seg_pass<0>(lds, ws, dob, bid, G, tid); }
    GSYNC();
    { PHASE_ARGS rwkv_seg_pass<1>(lds, ws, dob, bid, G, tid); }
    GSYNC();

    {
        PHASE_ARGS
        const float* lnw = ka->in[13]; const float* lnb = ka->in[14];
        float lw[8], lb[8];
#pragma unroll
        for (int e = 0; e < 8; ++e) { const int ch = 8 * lane + e; lw[e] = lnw[ch]; lb[e] = lnb[ch]; }
        const float* YRp = (const float*)(ws + WS_Y);
        for (int t = gw; t < T; t += NGW) {
            const f32x4 ya = *(const f32x4*)(YRp + hm8(t, lane)), yb = *(const f32x4*)(YRp + hm8(t, lane) + 4);
            float y[8] = {ya[0], ya[1], ya[2], ya[3], yb[0], yb[1], yb[2], yb[3]};
            float vs[8], gv[8];
            unpack8(*(const u32x4*)(VSb + hm8(t, lane)), vs);
            unpack8(*((const u32x4*)(Gb + (size_t)t * 512) + lane), gv);
            float s = 0.f;
#pragma unroll
            for (int e = 0; e < 8; ++e) s += y[e];
            const float mean = sum8(s) * (1.f / 64.f); float qv = 0.f;
#pragma unroll
            for (int e = 0; e < 8; ++e) { y[e] -= mean; qv += y[e] * y[e]; }
            const float rstd = rsqrtf(sum8(qv) * (1.f / 64.f) + 64e-5f);
            const float bon = BON[(size_t)t * 8 + (lane >> 3)];
            float o[8];
#pragma unroll
            for (int e = 0; e < 8; ++e) o[e] = (y[e] * rstd * lw[e] + lb[e] + bon * vs[e]) * gv[e];
            *((u32x4*)(B2 + (size_t)t * D) + lane) = pack8(o);
        }
    }
    GSYNC();

    {
        PHASE_ARGS
        pg8::Gemm g{B2, (const bf16*)(ws + W_OUT), T, D, D}; pg8::StaticOrder S; S.init(T, D, G, bid);
        pg8::EpiRes<0> E{ka->in[0], ka->out, B1, nullptr, STB, nullptr};
        pg8::gemm_phase<pg8::EpiRes<0>, pg8::StaticOrder, true, true>(lds, g, S, E);
    }
    GSYNC();
    {
        PHASE_ARGS
        pg8::Gemm g{B1, (const bf16*)(ws + W_UP0), T, FF, D}; pg8::StaticOrder S; S.init(T, FF, G, bid);
        pg8::EpiB<2, 16> E{HID, nullptr, nullptr, STB, nullptr, nullptr, FF};
        pg8::gemm_phase<pg8::EpiB<2, 16>, pg8::StaticOrder, true, true>(lds, g, S, E);
    }
    GSYNC();
    {
        PHASE_ARGS
        pg8::Gemm g{HID, (const bf16*)(ws + W_DN0), T, D, FF}; pg8::StaticOrder S; S.init(T, D, G, bid);
        pg8::EpiRes<0> E{ka->out, ka->out, B1, nullptr, STA, nullptr};
        pg8::gemm_phase<pg8::EpiRes<0>, pg8::StaticOrder, true, true>(lds, g, S, E);
    }
    GSYNC();
    {
        PHASE_ARGS
        pg8::Gemm g{PBF, (const bf16*)(ws + W_P0), T, D, 256}; pg8::StaticOrder S; S.init(T, D, G, bid);
        pg8::EpiB<3, 16> E{PP, nullptr, nullptr, nullptr, nullptr, nullptr, D};
        pg8::gemm_phase<pg8::EpiB<3, 16>, pg8::StaticOrder, true, true>(lds, g, S, E);
    }
    GSYNC();
    {
        PHASE_ARGS
        pg8::Gemm g{B1, (const bf16*)(ws + W_G0), T, D, D}; pg8::StaticOrder S; S.init(T, D, G, bid);
        pg8::EpiRes<1> E{ka->out, ka->out, B2, STA, STB, PP};
        pg8::gemm_phase<pg8::EpiRes<1>, pg8::StaticOrder, true, true>(lds, g, S, E);
    }
    GSYNC();

#pragma unroll 1
    for (int pass = 0; pass < 2; ++pass) {
        PHASE_ARGS
        LAS bf16* UTb = (LAS bf16*)(lds + wave * 16896);
        LAS bf16* HS = (LAS bf16*)(lds + wave * 16896 + 4096);
        LAS float* BUL = (LAS float*)(lds + wave * 16896 + 8448);
        const float* gm = ka->in[23]; const float* dsk = ka->in[31];
        const int fr = lane & 15, q = lane >> 4;
        for (int u = gw; u < 8192; u += NGW) {
            const int ck = u >> 6, g = u & 63, t0 = ck * 128;
#pragma unroll
            for (int qq = 0; qq < 2; ++qq) {
                const int tk = lane + 64 * qq, t = t0 + tk;
                const f32x4* sp = (const f32x4*)(STB + (size_t)t * 32); const f32x4 s0 = sp[0], s1 = sp[1], s2 = sp[2], s3 = sp[3];
                const float ssq = ((s0[0] + s0[1]) + (s0[2] + s0[3])) + ((s1[0] + s1[1]) + (s1[2] + s1[3])) + ((s2[0] + s2[1]) + (s2[2] + s2[3])) + ((s3[0] + s3[1]) + (s3[2] + s3[3]));
                const float rs = rsqrtf(ssq * (1.f / 1024.f) + 1e-6f);
                float f0[8], f1[8]; unpack8(*(const u32x4*)(B2 + (size_t)t * D + 16 * g), f0); unpack8(*(const u32x4*)(B2 + (size_t)t * D + 16 * g + 8), f1);
                const f32x4 g0 = *(const f32x4*)(gm + 16 * g), g1 = *(const f32x4*)(gm + 16 * g + 4), g2 = *(const f32x4*)(gm + 16 * g + 8), g3 = *(const f32x4*)(gm + 16 * g + 12);
                float o0[8] = {f0[0] * rs * g0[0], f0[1] * rs * g0[1], f0[2] * rs * g0[2], f0[3] * rs * g0[3], f0[4] * rs * g1[0], f0[5] * rs * g1[1], f0[6] * rs * g1[2], f0[7] * rs * g1[3]};
                float o1[8] = {f1[0] * rs * g2[0], f1[1] * rs * g2[1], f1[2] * rs * g2[2], f1[3] * rs * g2[3], f1[4] * rs * g3[0], f1[5] * rs * g3[1], f1[6] * rs * g3[2], f1[7] * rs * g3[3]};
                LAS u32x4* ud = (LAS u32x4*)(UTb + tk * 16); ud[0] = pack8(o0); ud[1] = pack8(o1);
            }
            bf16x4 bre[4], bim[4];
#pragma unroll
            for (int i = 0; i < 4; ++i) {
                const float* bp = (const float*)(BB + ((size_t)g * 64 + 16 * i + fr) * 16 + 4 * q);
                const f32x4 x0 = *(const f32x4*)bp, x1 = *(const f32x4*)(bp + 4);
                u32x2 wr_, wi_; wr_.x = pk2(x0[0], x0[2]); wr_.y = pk2(x1[0], x1[2]); wi_.x = pk2(x0[1], x0[3]); wi_.y = pk2(x1[1], x1[3]);
                bre[i] = __builtin_bit_cast(bf16x4, wr_); bim[i] = __builtin_bit_cast(bf16x4, wi_);
            }
            const f32x2 lam = LB[g * 64 + lane];
            f32x2 hst = (f32x2){0.f, 0.f};
            bf16x8 cf[4]; float dk = 0.f;
            if (pass == 1) {
                const f32x2 lL = LBL[g * 64 + lane];
                for (int c2 = 0; c2 < ck; c2 += 16) {
                    f32x2 eb[16];
#pragma unroll
                    for (int i = 0; i < 16; ++i) eb[i] = (c2 + i < ck) ? EST[((size_t)(c2 + i) * 64 + g) * 64 + lane] : (f32x2){0.f, 0.f};
#pragma unroll
                    for (int i = 0; i < 16; ++i) if (c2 + i < ck) { const float nr = lL[0] * hst[0] - lL[1] * hst[1] + eb[i][0], ni = lL[0] * hst[1] + lL[1] * hst[0] + eb[i][1]; hst = (f32x2){nr, ni}; }
                }
#pragma unroll
                for (int ks = 0; ks < 4; ++ks) {
                    const float* src = (ks < 2 ? ka->in[29] : ka->in[30]) + ((size_t)g * 16 + fr) * 64 + (ks & 1) * 32 + q * 8;
                    const f32x4 x0 = *(const f32x4*)src, x1 = *(const f32x4*)(src + 4); const float sg = ks < 2 ? 1.f : -1.f;
                    u32x4 w; w.x = pk2(sg * x0[0], sg * x0[1]); w.y = pk2(sg * x0[2], sg * x0[3]); w.z = pk2(sg * x1[0], sg * x1[1]); w.w = pk2(sg * x1[2], sg * x1[3]);
                    cf[ks] = __builtin_bit_cast(bf16x8, w);
                }
                dk = dsk[16 * g + fr];
            }
            for (int tg = 0; tg < 8; ++tg) {
                const bf16x4 af = *(const LAS bf16x4*)(UTb + (16 * tg + fr) * 16 + 4 * q);
                const f32x4 z4 = (f32x4){0.f, 0.f, 0.f, 0.f};
#pragma unroll
                for (int i = 0; i < 4; ++i) {
                    const f32x4 dr = __builtin_amdgcn_mfma_f32_16x16x16bf16_1k(af, bre[i], z4, 0, 0, 0), di = __builtin_amdgcn_mfma_f32_16x16x16bf16_1k(af, bim[i], z4, 0, 0, 0);
#pragma unroll
                    for (int v = 0; v < 4; ++v) { BUL[(4 * q + v) * 132 + 16 * i + fr] = dr[v]; BUL[(4 * q + v) * 132 + 64 + 16 * i + fr] = di[v]; }
                }
#pragma unroll
                for (int tl = 0; tl < 16; ++tl) {
                    const float br = BUL[tl * 132 + lane], bi = BUL[tl * 132 + 64 + lane];
                    const float nr = lam[0] * hst[0] - lam[1] * hst[1] + br, ni = lam[0] * hst[1] + lam[1] * hst[0] + bi;
                    hst = (f32x2){nr, ni};
                    if (pass == 1) { const unsigned hw = pk2(nr, ni); HS[tl * 136 + lane] = (bf16)(hw & 0xffffu); HS[tl * 136 + 64 + lane] = (bf16)(hw >> 16); }
                }
                if (pass == 1) {
                    f32x4 acc = z4;
#pragma unroll
                    for (int ks = 0; ks < 4; ++ks) { const bf16x8 hf = *(const LAS bf16x8*)(HS + fr * 136 + ks * 32 + q * 8);
                        acc = __builtin_amdgcn_mfma_f32_16x16x32_bf16(hf, cf[ks], acc, 0, 0, 0); }
#pragma unroll
                    for (int j = 0; j < 4; ++j) { const int tk = tg * 16 + q * 4 + j; const float uv = bflo((unsigned)UTb[tk * 16 + fr]);
                        const float y = gelu_tanh(acc[j] + dk * uv);
                        YG[(size_t)(t0 + tk) * D + 16 * g + fr] = (bf16)(pk2(y, 0.f) & 0xffffu); }
                }
            }
            if (pass == 0) EST[((size_t)ck * 64 + g) * 64 + lane] = hst;
        }
        GSYNC();
    }

    {
        PHASE_ARGS
        pg8::Gemm g{YG, (const bf16*)(ws + W_GLU), T, 2048, D}; pg8::StaticOrder S; S.init(T, 2048, G, bid);
        pg8::EpiRes<2> E{ka->out, ka->out, B1, nullptr, STA, nullptr};
        pg8::gemm_phase<pg8::EpiRes<2>, pg8::StaticOrder, true, true>(lds, g, S, E);
    }
    GSYNC();
    {
        PHASE_ARGS
        pg8::Gemm g{B1, (const bf16*)(ws + W_UP1), T, FF, D}; pg8::StaticOrder S; S.init(T, FF, G, bid);
        pg8::EpiB<2, 32> E{HID, nullptr, nullptr, STA, nullptr, nullptr, FF};
        pg8::gemm_phase<pg8::EpiB<2, 32>, pg8::StaticOrder, true, true>(lds, g, S, E);
    }
    GSYNC();
    {
        PHASE_ARGS
        pg8::Gemm g{HID, (const bf16*)(ws + W_DN1), T, D, FF}; pg8::StaticOrder S; S.init(T, D, G, bid);
        pg8::EpiRes<0> E{ka->out, ka->out, B1, nullptr, STB, nullptr};
        pg8::gemm_phase<pg8::EpiRes<0>, pg8::StaticOrder, true, true>(lds, g, S, E);
    }
    GSYNC();
    {
        PHASE_ARGS
        pg8::Gemm g{PBF + (size_t)T * 256, (const bf16*)(ws + W_P1), T, D, 256}; pg8::StaticOrder S; S.init(T, D, G, bid);
        pg8::EpiB<3, 16> E{PP, nullptr, nullptr, nullptr, nullptr, nullptr, D};
        pg8::gemm_phase<pg8::EpiB<3, 16>, pg8::StaticOrder, true, true>(lds, g, S, E);
    }
    GSYNC();
    {
        PHASE_ARGS
        pg8::Gemm g{B1, (const bf16*)(ws + W_G1), T, D, D}; pg8::StaticOrder S; S.init(T, D, G, bid);
        pg8::EpiRes<1> E{ka->out, ka->out, nullptr, STB, STA, PP};
        pg8::gemm_phase<pg8::EpiRes<1>, pg8::StaticOrder, true, true>(lds, g, S, E);
    }
    GSYNC();
    {
        PHASE_ARGS
        const float* gf = ka->in[40];
        for (int m = gw; m < T; m += NGW) {
            const f32x4* sp = (const f32x4*)(STA + (size_t)m * 32); const f32x4 s0 = sp[0], s1 = sp[1], s2 = sp[2], s3 = sp[3];
            const float ssq = ((s0[0] + s0[1]) + (s0[2] + s0[3])) + ((s1[0] + s1[1]) + (s1[2] + s1[3])) + ((s2[0] + s2[1]) + (s2[2] + s2[3])) + ((s3[0] + s3[1]) + (s3[2] + s3[3]));
            const float rs = rsqrtf(ssq * (1.f / 1024.f) + 1e-6f);
            f32x4* xr = (f32x4*)(ka->out + (size_t)m * D) + lane;
#pragma unroll
            for (int j = 0; j < 4; ++j) { const f32x4 v = xr[64 * j]; const f32x4 gg = *((const f32x4*)gf + lane + 64 * j); xr[64 * j] = v * rs * gg; }
        }
    }
#undef GSYNC
}

extern "C" void kernel_launch(void* const* d_in, const int* in_sizes, int n_in, void* d_out, int out_size, void* d_ws, size_t ws_size, hipStream_t stream) {
    static int grid = 0;
    if (grid == 0) {
        if (n_in != 41 || out_size != T * D || ws_size < WS_END) { fprintf(stderr, "kernel_launch: unexpected shapes (n_in %d, out %d, ws %zu)\n", n_in, out_size, ws_size); grid = -1; return; }
        int dev = 0, cus = 0, per_cu = 0;
        hipGetDevice(&dev); hipDeviceGetAttribute(&cus, hipDeviceAttributeMultiprocessorCount, dev);
        if (hipFuncSetAttribute((const void*)mega_fwd, hipFuncAttributeMaxDynamicSharedMemorySize, LDS_BYTES) != hipSuccess) { fprintf(stderr, "kernel_launch: hipFuncSetAttribute failed\n"); grid = -1; return; }
        if (hipOccupancyMaxActiveBlocksPerMultiprocessor(&per_cu, (const void*)mega_fwd, NWAVES * 64, LDS_BYTES) != hipSuccess || per_cu < 1) { fprintf(stderr, "kernel_launch: occupancy query says %d\n", per_cu); per_cu = 1; }
        (void)hipGetLastError();
        grid = cus;
    }
    if (grid < 0) return;
    if (hipMemsetAsync((char*)d_ws + WS_BAR, 0, 16384, stream) != hipSuccess) { fprintf(stderr, "kernel_launch: memset failed\n"); return; }
    Args a{};
    for (int i = 0; i < 41; ++i) a.in[i] = (const float*)d_in[i];
    a.out = (float*)d_out; a.ws = (unsigned char*)d_ws;
    void* params[] = {&a};
    hipError_t e = hipLaunchCooperativeKernel((const void*)mega_fwd, dim3(grid), dim3(NWAVES * 64), params, LDS_BYTES, stream);
    if (e != hipSuccess) fprintf(stderr, "kernel_launch: cooperative launch failed: %s (grid %d)\n", hipGetErrorString(e), grid);
}
```

```cpp
#include <hip/hip_runtime.h>
#include <hip/hip_cooperative_groups.h>
#include <cstdio>
#include <cstdint>
namespace pg8 {
#define PG8_LAS __attribute__((address_space(3)))
typedef unsigned short bf16_t;
typedef short bf16x8 __attribute__((ext_vector_type(8)));
typedef float f32x4 __attribute__((ext_vector_type(4)));
typedef unsigned u32x4 __attribute__((ext_vector_type(4)));
constexpr int BM = 256, BK = 64, HALF = 128, HTB = HALF * BK * 2  , STAGE_BYTES = 8 * HTB, NXCD = 8, WGM = 8;

__host__ __device__ __forceinline__ int lds_byte(int r, int c) { const int st = (r >> 4) * 2 + (c >> 5), rr = r & 15, cc = c & 31, ob = rr * 64 + cc * 2; return st * 1024 + (ob ^ (((ob >> 9) & 1) << 5)); }
__host__ __device__ __forceinline__ void stage_rc(int b, int& R, int& C) { const int st = b / 1024, sb = b % 1024, swz = sb ^ (((sb >> 9) & 1) << 5); R = (st >> 1) * 16 + swz / 64; C = (st & 1) * 32 + (swz % 64) / 2; }
__host__ __device__ __forceinline__ int perm32(int rho) { const int n = rho >> 4, i = rho & 15; return 8 * (i >> 2) + 4 * n + (i & 3); }

struct Unit { int pm, pn; };
struct Gemm { const bf16_t* A; const bf16_t* Bt; int M, N, K; };

struct StaticOrder {
    int nM, nN, nwg, G, c;
    __host__ __device__ void init(int M, int N, int G_, int c_) { nM = M / BM; nN = N / BM; nwg = nM * nN; G = G_; c = c_; }
    __host__ __device__ bool next(int i, Unit& u) const {
        const long L = (long)i * G + c; if (L >= nwg) return false;
        int wgid = (int)L; { const int q = nwg / NXCD, r = nwg % NXCD, xcd = wgid % NXCD, off = wgid / NXCD; wgid = (xcd < r ? xcd * (q + 1) : r * (q + 1) + (xcd - r) * q) + off; }
        const int nig = WGM * nN, gid = wgid / nig, fm = gid * WGM, gsz = (nM - fm) < WGM ? (nM - fm) : WGM;
        u.pm = fm + ((wgid % nig) % gsz); u.pn = (wgid % nig) / gsz; return true;
    }
    __device__ __forceinline__ void a_ready(const Unit&) const {}
    __device__ __forceinline__ void done(const Unit&) const {}
};

typedef float f32x2n __attribute__((ext_vector_type(2))); typedef __bf16 hbf2n __attribute__((ext_vector_type(2)));
__device__ __forceinline__ unsigned cvt_pk_bf16(float lo, float hi) { const f32x2n v = {lo, hi}; const hbf2n b = __builtin_convertvector(v, hbf2n); return __builtin_bit_cast(unsigned, b); }
typedef float f32x2 __attribute__((ext_vector_type(2)));

constexpr int TT = 16384;
typedef unsigned u32x2 __attribute__((ext_vector_type(2)));
__device__ __forceinline__ float fsigmoid(float x) { return __builtin_amdgcn_rcpf(1.0f + __expf(-x)); }
template <int NSL> __device__ __forceinline__ float row_rstd(const float* st, int r, int fq) {
    const f32x4 v = *(const f32x4*)(st + (size_t)r * 32 + 4 * fq);
    float s = (v[0] + v[1]) + (v[2] + v[3]);
    if (NSL == 32) { const f32x4 w = *(const f32x4*)(st + (size_t)r * 32 + 16 + 4 * fq); s += (w[0] + w[1]) + (w[2] + w[3]); }
    s += __shfl_xor(s, 16); s += __shfl_xor(s, 32);
    return rsqrtf(s * (1.0f / 1024.0f) + 1e-6f);
}
template <int MODE, int NSL> struct EpiB {
    static constexpr bool PERM = true, AFTER_DRAIN = false;
    bf16_t* o0; bf16_t* o1; bf16_t* o2; const float* st; const float* c0; const float* c1; int ldc;
    __device__ __forceinline__ void operator()(const f32x4 (&acc)[2][2][4][2], const Unit& u, int wr, int wc, int fr, int fq) const {
        const int row0 = u.pm * BM + wr * 64 + fr; const int pn = u.pn;
        bf16_t* base; int ld, colt; int kind = 0;
        if (MODE == 0) {
            if (pn < 6) { base = o0 + (size_t)(pn >> 1) * TT * 512; ld = 512; colt = (pn & 1) * 256; }
            else if (pn == 6) { base = o1; ld = 256; colt = 0; }
            else { base = o2; ld = 1536; colt = (pn - 7) * 256; }
        } else if (MODE == 1) {
            kind = pn >> 1; base = o0 + (size_t)kind * TT * 512; if (kind == 2) base = o2; ld = 512; colt = (pn & 1) * 256;
        } else { base = o0; ld = ldc; colt = pn * 256; }
        const int col0 = colt + wc * 32 + 8 * fq;
        const float* cbias = c0; if (kind == 1) cbias = c1; cbias += col0;
        f32x4 bv00 = (f32x4){0.f, 0.f, 0.f, 0.f}, bv01 = bv00, bv10 = bv00, bv11 = bv00;
        if (MODE == 1) { if (kind < 2) { bv00 = *(const f32x4*)(cbias); bv01 = *(const f32x4*)(cbias + 4); bv10 = *(const f32x4*)(cbias + HALF); bv11 = *(const f32x4*)(cbias + HALF + 4); } }
#pragma unroll
        for (int ai = 0; ai < 2; ++ai)
#pragma unroll
            for (int m = 0; m < 4; ++m) {
                const int r = row0 + ai * HALF + m * 16;
                float rs = 1.f;
                if (MODE == 0 || MODE == 2) rs = row_rstd<NSL>(st, r, fq);
                bf16_t* rowp = base + (size_t)r * ld + col0;
#pragma unroll
                for (int bj = 0; bj < 2; ++bj) {
                    f32x4 v0 = acc[ai][bj][m][0], v1 = acc[ai][bj][m][1];
                    if (MODE == 0) { v0 = v0 * rs; v1 = v1 * rs; }
                    if (MODE == 2) {
#pragma unroll
                        for (int e = 0; e < 4; ++e) { float a = fmaxf(v0[e], 0.f) * rs, b = fmaxf(v1[e], 0.f) * rs; v0[e] = a * a; v1[e] = b * b; }
                    }
                    if (MODE == 1) {
                        if (kind < 2) {
                            const float sc = kind == 0 ? (0.6065306597f * 1.4426950409f) : 1.0f;
                            v0 = v0 + (bj == 0 ? bv00 : bv10); v1 = v1 + (bj == 0 ? bv01 : bv11);
#pragma unroll
                            for (int e = 0; e < 4; ++e) { v0[e] = sc * fsigmoid(v0[e]); v1[e] = sc * fsigmoid(v1[e]); }
                        }
                    }
                    u32x4 w; w.x = cvt_pk_bf16(v0[0], v0[1]); w.y = cvt_pk_bf16(v0[2], v0[3]); w.z = cvt_pk_bf16(v1[0], v1[1]); w.w = cvt_pk_bf16(v1[2], v1[3]);
                    if (MODE == 1 && kind < 2) { const int cc_ = col0 + bj * HALF; *(u32x4*)(base + ((size_t)(cc_ >> 6) * TT + r) * 64 + (cc_ & 63)) = w; }
                    else *(u32x4*)(rowp + bj * HALF) = w;
                }
                if (m & 1) asm volatile("" ::: "memory");
            }
    }
};
template <int MODE> struct EpiRes {
    static constexpr bool PERM = false, AFTER_DRAIN = false;
    const float* base; float* out; bf16_t* hb; const float* st_in; float* st_out; const bf16_t* pp;
    __device__ __forceinline__ void operator()(const f32x4 (&acc)[2][2][4][2], const Unit& u, int wr, int wc, int fr, int fq) const {
        constexpr int NB = MODE == 2 ? 1 : 2;
        const int row0 = u.pm * BM + wr * 64 + fr;
        const int cb0 = (MODE == 2 ? u.pn * 128 : u.pn * BM) + wc * 32 + 4 * fq;
        f32x4 bq[2][2][2]; u32x2 pq[2][2][2];
#define ER_LOAD(it_) do { const int r_ = row0 + ((it_) >> 2) * HALF + ((it_) & 3) * 16; _Pragma("unroll") for (int bj = 0; bj < NB; ++bj) _Pragma("unroll") for (int n = 0; n < 2; ++n) { \
            const size_t off_ = (size_t)r_ * 1024 + cb0 + bj * HALF + n * 16; bq[(it_) & 1][bj][n] = *(const f32x4*)(base + off_); if (MODE == 1) pq[(it_) & 1][bj][n] = *(const u32x2*)(pp + off_); } } while (0)
        ER_LOAD(0);
#pragma unroll
        for (int it = 0; it < 8; ++it) {
            const int ai = it >> 2, m = it & 3;
            const int r = row0 + ai * HALF + m * 16;
            if (it + 1 < 8) ER_LOAD(it + 1);
            const float rs = MODE == 1 ? row_rstd<16>(st_in, r, fq) : 1.f;
            float ss = 0.f;
#pragma unroll
            for (int bj = 0; bj < NB; ++bj)
#pragma unroll
                for (int n = 0; n < 2; ++n) {
                    const size_t off = (size_t)r * 1024 + cb0 + bj * HALF + n * 16;
                    const f32x4 b = bq[it & 1][bj][n];
                    f32x4 v = acc[ai][bj][m][n];
                    if (MODE == 1) {
                        const u32x2 pw = pq[it & 1][bj][n];
                        const float p0 = __uint_as_float(pw.x << 16), p1 = __uint_as_float(pw.x & 0xffff0000u), p2 = __uint_as_float(pw.y << 16), p3 = __uint_as_float(pw.y & 0xffff0000u);
                        v[0] = p0 * fsigmoid(v[0] * rs); v[1] = p1 * fsigmoid(v[1] * rs); v[2] = p2 * fsigmoid(v[2] * rs); v[3] = p3 * fsigmoid(v[3] * rs);
                    }
                    if (MODE == 2) {
                        const f32x4 g = acc[ai][1][m][n];
#pragma unroll
                        for (int e = 0; e < 4; ++e) v[e] = v[e] * fsigmoid(g[e]);
                    }
                    const f32x4 o = b + v;
                    *(f32x4*)(out + off) = o;
                    if (hb) { u32x2 w; w.x = cvt_pk_bf16(o[0], o[1]); w.y = cvt_pk_bf16(o[2], o[3]); *(u32x2*)(hb + off) = w; }
                    ss += (o[0] * o[0] + o[1] * o[1]) + (o[2] * o[2] + o[3] * o[3]);
                }
            ss += __shfl_xor(ss, 16); ss += __shfl_xor(ss, 32);
            if (fq == 0) st_out[(size_t)r * 32 + u.pn * 4 + wc] = ss;
            asm volatile("" ::: "memory");
        }
#undef ER_LOAD
    }
};

template <class Epi, class Sched, bool ALIGN_EPI = false, bool SP2 = false>
__device__ __forceinline__ void gemm_phase(PG8_LAS unsigned char* lds, const Gemm g, const Sched& S, const Epi& E) {
    int tid_l = threadIdx.x; asm volatile("" : "+v"(tid_l)); const int tid = tid_l, wid = __builtin_amdgcn_readfirstlane(tid >> 6), lane = tid & 63, wr = wid >> 2, wc = wid & 3, fr = lane & 15, fq = lane >> 4;
    int K = g.K; asm volatile("" : "+s"(K)); const int nt = K / BK;
    unsigned voffA[2], voffB[2];
#pragma unroll
    for (int i = 0; i < 2; ++i) { int R, C; stage_rc(tid * 16 + i * 8192, R, C); const int Rb = Epi::PERM ? ((R & ~31) + perm32(R & 31)) : R;
        voffA[i] = (unsigned)(R * K + C) * 2u; voffB[i] = (unsigned)(Rb * K + C) * 2u; }
    const size_t kstep = (size_t)(BK * 2);
    const size_t hstep = (size_t)HALF * K * 2;
    const size_t tstep = 2 * hstep;
    const unsigned ldsw = (unsigned)wid * 1024u;
    const int aoff = lds_byte(wr * 64 + fr, fq * 8), boff = lds_byte(wc * 32 + fr, fq * 8);
#define PG8_SA(b, h) (((b) * 2 + (h)) * HTB)
#define PG8_SB(b, h) ((4 + (b) * 2 + (h)) * HTB)
#define PG8_STAGE(bufoff, gbase, voff) do { _Pragma("unroll") for (int _i = 0; _i < 2; ++_i) \
        __builtin_amdgcn_global_load_lds((const unsigned*)((const char*)(gbase) + (voff)[_i]), (PG8_LAS unsigned*)(lds + (bufoff) + ldsw + _i * 8192), 16, 0, 0); } while (0)
#define PG8_LDA(dst, b, h) do { _Pragma("unroll") for (int m = 0; m < 4; ++m) _Pragma("unroll") for (int k = 0; k < 2; ++k) dst[m][k] = *(const PG8_LAS bf16x8*)(lds + PG8_SA(b, h) + aoff + m * 2048 + k * 1024); } while (0)
#define PG8_LDB(dst, b, h) do { _Pragma("unroll") for (int n = 0; n < 2; ++n) _Pragma("unroll") for (int k = 0; k < 2; ++k) dst[n][k] = *(const PG8_LAS bf16x8*)(lds + PG8_SB(b, h) + boff + n * 2048 + k * 1024); } while (0)
#define PG8_MMA(ai, bj, At, Bt) do { __builtin_amdgcn_s_setprio(1); _Pragma("unroll") for (int m = 0; m < 4; ++m) _Pragma("unroll") for (int n = 0; n < 2; ++n) _Pragma("unroll") for (int k = 0; k < 2; ++k) \
        acc[ai][bj][m][n] = __builtin_amdgcn_mfma_f32_16x16x32_bf16(Bt[n][k], At[m][k], acc[ai][bj][m][n], 0, 0, 0); __builtin_amdgcn_s_setprio(0); } while (0)
#define PG8_WAIT_V(n) asm volatile("s_waitcnt vmcnt(" #n ")" ::: "memory")
#define PG8_WAIT_L(n) asm volatile("s_waitcnt lgkmcnt(" #n ")" ::: "memory")
#define PG8_BAR __builtin_amdgcn_s_barrier()
#define PG8_SCHED __builtin_amdgcn_sched_barrier(0)
    Unit cur, nxt; int ui = 0;
    if (!S.next(0, cur)) return;
    f32x4 acc[2][2][4][2];
#pragma unroll
    for (int a = 0; a < 2; ++a)
#pragma unroll
        for (int b = 0; b < 2; ++b)
#pragma unroll
            for (int m = 0; m < 4; ++m)
#pragma unroll
                for (int n = 0; n < 2; ++n) acc[a][b][m][n] = (f32x4){0.f, 0.f, 0.f, 0.f};
    bf16x8 At[4][2], B0[2][2], B1[2][2];
    const char* cA = (const char*)g.A + (size_t)cur.pm * tstep; const char* cB = (const char*)g.Bt + (size_t)cur.pn * tstep;
    S.a_ready(cur);
    if constexpr (SP2) {
        PG8_STAGE(PG8_SB(0, 0), cB, voffB); PG8_STAGE(PG8_SB(0, 1), cB + hstep, voffB); PG8_STAGE(PG8_SA(0, 0), cA, voffA); PG8_STAGE(PG8_SA(0, 1), cA + hstep, voffA);
        if (wr == 1) PG8_BAR;
        PG8_WAIT_V(2); PG8_BAR;
        PG8_STAGE(PG8_SB(1, 0), cB + kstep, voffB); PG8_STAGE(PG8_SA(1, 0), cA + kstep, voffA); PG8_STAGE(PG8_SB(1, 1), cB + hstep + kstep, voffB);
        PG8_WAIT_V(6); PG8_BAR;
    } else {
        PG8_STAGE(PG8_SB(0, 0), cB, voffB); PG8_STAGE(PG8_SA(0, 0), cA, voffA); PG8_STAGE(PG8_SB(0, 1), cB + hstep, voffB); PG8_STAGE(PG8_SA(0, 1), cA + hstep, voffA);
        if (wr == 1) PG8_BAR;
        PG8_WAIT_V(4); PG8_BAR;
        PG8_STAGE(PG8_SB(1, 0), cB + kstep, voffB); PG8_STAGE(PG8_SA(1, 0), cA + kstep, voffA); PG8_STAGE(PG8_SB(1, 1), cB + hstep + kstep, voffB);
        PG8_WAIT_V(6); PG8_BAR;
    }
    for (;;) {
        const bool has_next = S.next(ui + 1, nxt);
        const char* nA = has_next ? (const char*)g.A + (size_t)nxt.pm * tstep : cA; const char* nB = has_next ? (const char*)g.Bt + (size_t)nxt.pn * tstep : cB;
        for (int t = 0; t < nt; t += 2) {
            const bool last = (t == nt - 2);
            const char* a1 = cA + (size_t)(t + 1) * kstep;
            const char* a2 = last ? nA : cA + (size_t)(t + 2) * kstep; const char* b2 = last ? nB : cB + (size_t)(t + 2) * kstep;
            const char* a3 = a2 + kstep; const char* b3 = b2 + kstep;
            if (last && has_next) S.a_ready(nxt);
            if constexpr (SP2) {
            PG8_LDB(B0, 0, 0); PG8_LDB(B1, 0, 1); PG8_SCHED; PG8_LDA(At, 0, 0); PG8_STAGE(PG8_SA(1, 1), a1 + hstep, voffA);
            PG8_WAIT_V(8); PG8_WAIT_L(0); PG8_BAR; PG8_MMA(0, 0, At, B0); PG8_MMA(0, 1, At, B1); PG8_BAR; PG8_SCHED;
            PG8_LDA(At, 0, 1); PG8_STAGE(PG8_SB(0, 0), b2, voffB); PG8_STAGE(PG8_SB(0, 1), b2 + hstep, voffB); PG8_STAGE(PG8_SA(0, 0), a2, voffA);
            PG8_WAIT_V(8); PG8_WAIT_L(0); PG8_BAR; PG8_MMA(1, 0, At, B0); PG8_MMA(1, 1, At, B1); PG8_BAR; PG8_SCHED;
            PG8_LDB(B0, 1, 0); PG8_LDB(B1, 1, 1); PG8_SCHED; PG8_LDA(At, 1, 0); PG8_STAGE(PG8_SA(0, 1), a2 + hstep, voffA);
            PG8_WAIT_V(8); PG8_WAIT_L(0); PG8_BAR; PG8_MMA(0, 0, At, B0); PG8_MMA(0, 1, At, B1); PG8_BAR; PG8_SCHED;
            PG8_LDA(At, 1, 1); PG8_STAGE(PG8_SB(1, 0), b3, voffB); PG8_STAGE(PG8_SB(1, 1), b3 + hstep, voffB); PG8_STAGE(PG8_SA(1, 0), a3, voffA);
            PG8_WAIT_V(8); PG8_WAIT_L(0); PG8_BAR; PG8_MMA(1, 0, At, B0); PG8_MMA(1, 1, At, B1); PG8_BAR; PG8_SCHED;
            } else {
            PG8_LDB(B0, 0, 0); PG8_SCHED; PG8_LDA(At, 0, 0); PG8_STAGE(PG8_SA(1, 1), a1 + hstep, voffA);
            PG8_WAIT_L(8); PG8_BAR; PG8_WAIT_L(0); PG8_MMA(0, 0, At, B0); PG8_BAR; PG8_SCHED;
            PG8_LDB(B1, 0, 1); PG8_STAGE(PG8_SB(0, 0), b2, voffB);
            PG8_BAR; PG8_WAIT_L(0); PG8_MMA(0, 1, At, B1); PG8_BAR;
            PG8_LDA(At, 0, 1); PG8_STAGE(PG8_SA(0, 0), a2, voffA);
            PG8_BAR; PG8_WAIT_L(0); PG8_MMA(1, 0, At, B0); PG8_BAR; PG8_SCHED;
            PG8_STAGE(PG8_SB(0, 1), b2 + hstep, voffB);
            PG8_WAIT_V(6); PG8_BAR; PG8_MMA(1, 1, At, B1); PG8_BAR;
            PG8_LDB(B0, 1, 0); PG8_SCHED; PG8_LDA(At, 1, 0); PG8_STAGE(PG8_SA(0, 1), a2 + hstep, voffA);
            PG8_WAIT_L(8); PG8_BAR; PG8_WAIT_L(0); PG8_MMA(0, 0, At, B0); PG8_BAR; PG8_SCHED;
            PG8_LDB(B1, 1, 1); PG8_STAGE(PG8_SB(1, 0), b3, voffB);
            PG8_BAR; PG8_WAIT_L(0); PG8_MMA(0, 1, At, B1); PG8_BAR;
            PG8_LDA(At, 1, 1); PG8_STAGE(PG8_SA(1, 0), a3, voffA);
            PG8_BAR; PG8_WAIT_L(0); PG8_MMA(1, 0, At, B0); PG8_BAR; PG8_SCHED;
            PG8_STAGE(PG8_SB(1, 1), b3 + hstep, voffB);
            PG8_WAIT_V(6); PG8_BAR; PG8_MMA(1, 1, At, B1); PG8_BAR;
            }
        }
        if constexpr (ALIGN_EPI) { if (wr == 0) PG8_BAR; }
        if constexpr (!Epi::AFTER_DRAIN) { E(acc, cur, wr, wc, fr, fq); S.done(cur); }
        if (!has_next) break;
#pragma unroll
        for (int a = 0; a < 2; ++a)
#pragma unroll
            for (int b = 0; b < 2; ++b)
#pragma unroll
                for (int m = 0; m < 4; ++m)
#pragma unroll
                    for (int n = 0; n < 2; ++n) acc[a][b][m][n] = (f32x4){0.f, 0.f, 0.f, 0.f};
        cur = nxt; cA = nA; cB = nB; ++ui;
        if constexpr (ALIGN_EPI) { if (wr == 1) PG8_BAR; }
    }
    PG8_WAIT_V(0);
    if constexpr (!ALIGN_EPI) { if (wr == 0) PG8_BAR; }
    PG8_BAR;
    if constexpr (Epi::AFTER_DRAIN) { E.fused(acc, cur, wr, wc, fr, fq, lds, wid, lane); S.done(cur); }
#undef PG8_SA
#undef PG8_SB
#undef PG8_STAGE
#undef PG8_LDA
#undef PG8_LDB
#undef PG8_MMA
#undef PG8_WAIT_V
#undef PG8_WAIT_L
#undef PG8_BAR
#undef PG8_SCHED
}
}

namespace cg = cooperative_groups;
#define LAS __attribute__((address_space(3)))
typedef unsigned short bf16;
typedef float f32x4 __attribute__((ext_vector_type(4)));
typedef float f32x2 __attribute__((ext_vector_type(2)));
typedef unsigned u32x4 __attribute__((ext_vector_type(4)));
typedef unsigned u32x2 __attribute__((ext_vector_type(2)));
typedef short bf16x8 __attribute__((ext_vector_type(8)));
typedef short bf16x4 __attribute__((ext_vector_type(4)));

constexpr int T = 16384, D = 1024, FF = 4096, DIN = 3328, NWAVES = 8;
constexpr int LDS_BYTES = 147456;
constexpr size_t KiB = 1024, MiB = 1024 * 1024;
constexpr size_t WS_BON = 0;
constexpr size_t WS_EST = 1 * MiB;
constexpr size_t WS_S5P = 5 * MiB;
constexpr size_t WS_STA = 8 * MiB, WS_STB = 10 * MiB;
constexpr size_t W_IN = 12 * MiB, W_LORA = W_IN + 6656 * KiB, W_OUT = W_LORA + 768 * KiB, W_UP0 = W_OUT + 2 * MiB, W_DN0 = W_UP0 + 8 * MiB, W_G0 = W_DN0 + 8 * MiB,
                 W_P0 = W_G0 + 2 * MiB, W_GLU = W_P0 + 512 * KiB, W_UP1 = W_GLU + 4 * MiB, W_DN1 = W_UP1 + 8 * MiB, W_G1 = W_DN1 + 8 * MiB, W_P1 = W_G1 + 2 * MiB;
static_assert(W_P1 + 512 * KiB <= 64 * MiB, "weights");
constexpr size_t WS_PBF = 64 * MiB;
constexpr size_t WS_B1 = 80 * MiB, WS_B2 = 112 * MiB;
constexpr size_t WS_R = 144 * MiB, WS_E = 192 * MiB, WS_A = 208 * MiB, WS_KP = 224 * MiB;
constexpr size_t WS_HID = 112 * MiB;
constexpr size_t WS_PP = 144 * MiB, WS_YG = 144 * MiB;
constexpr size_t WS_ESEG = 1 * MiB, WS_MSEG = 240 * MiB;
constexpr size_t WS_END = 244 * MiB;
constexpr size_t DO_ZB = 0, DO_X = 48 * MiB, DO_AP = 56 * MiB, DO_KK = 48 * MiB, DO_G = 0, DO_RS = 16 * MiB, DO_VS = 32 * MiB;
constexpr size_t WS_Y = 144 * MiB;

__device__ __forceinline__ size_t hm8(int t, int lane) { return ((size_t)(lane >> 3) * T + t) * 64 + (lane & 7) * 8; }
__device__ __forceinline__ float bflo(unsigned w) { return __uint_as_float(w << 16); }
__device__ __forceinline__ float bfhi(unsigned w) { return __uint_as_float(w & 0xffff0000u); }
__device__ __forceinline__ unsigned pk2(float lo, float hi) { return pg8::cvt_pk_bf16(lo, hi); }
__device__ __forceinline__ void unpack8(const u32x4 w, float (&f)[8]) { f[0] = bflo(w.x); f[1] = bfhi(w.x); f[2] = bflo(w.y); f[3] = bfhi(w.y); f[4] = bflo(w.z); f[5] = bfhi(w.z); f[6] = bflo(w.w); f[7] = bfhi(w.w); }
__device__ __forceinline__ u32x4 pack8(const float (&f)[8]) { u32x4 w; w.x = pk2(f[0], f[1]); w.y = pk2(f[2], f[3]); w.z = pk2(f[4], f[5]); w.w = pk2(f[6], f[7]); return w; }
__device__ __forceinline__ float wave_sum(float v) {
#pragma unroll
    for (int o = 1; o < 64; o <<= 1) v += __shfl_xor(v, o);
    return v;
}
__device__ __forceinline__ float sum8(float v) { v += __shfl_xor(v, 1); v += __shfl_xor(v, 2); v += __shfl_xor(v, 4); return v; }
template <int CTRL, int RM> __device__ __forceinline__ float dpp0(float x) {
    return __builtin_bit_cast(float, __builtin_amdgcn_update_dpp(0, __builtin_bit_cast(int, x), CTRL, RM, 0xf, false));
}
__device__ __forceinline__ float wave_sum_dpp(float x) {
    x += dpp0<0xB1, 0xf>(x);
    x += dpp0<0x4E, 0xf>(x);
    x += dpp0<0x141, 0xf>(x);
    x += dpp0<0x140, 0xf>(x);
    x += dpp0<0x142, 0xa>(x);
    x += dpp0<0x143, 0xc>(x);
    return __builtin_bit_cast(float, __builtin_amdgcn_readlane(__builtin_bit_cast(int, x), 63));
}
__device__ __forceinline__ float gelu_tanh(float x) {
    const float u = 0.7978845608f * (x + 0.044715f * x * x * x);
    const float e = __expf(2.0f * u);
    const float th = 1.0f - 2.0f * __builtin_amdgcn_rcpf(e + 1.0f);
    return 0.5f * x * (1.0f + th);
}

__device__ __forceinline__ void tr_item(const float* W, int K, int N, bf16* WT, int mode, const float* gain, LAS float* scr, int item, int lane) {
    const int nblk = N / 32, kb = item / nblk, nb = item % nblk, k0 = 64 * kb, n0 = 32 * nb;
#pragma unroll 8
    for (int i = 0; i < 32; ++i) { const int kk = 2 * i + (lane >> 5); float v = W[(size_t)(k0 + kk) * N + n0 + (lane & 31)]; if (gain) v *= gain[k0 + kk]; scr[kk * 33 + (lane & 31)] = v; }
    asm volatile("s_waitcnt lgkmcnt(0)" ::: "memory");
    const int c = lane & 7;
#pragma unroll
    for (int j = 0; j < 4; ++j) { const int n = (lane >> 3) + 8 * j; const LAS float* s = scr + (8 * c) * 33 + n;
        u32x4 o; o.x = pk2(s[0 * 33], s[1 * 33]); o.y = pk2(s[2 * 33], s[3 * 33]); o.z = pk2(s[4 * 33], s[5 * 33]); o.w = pk2(s[6 * 33], s[7 * 33]);
        const int ng = n0 + n; const int row = mode == 0 ? ng : (256 * (ng >> 7) + (ng & 127) + (mode == 2 ? 128 : 0));
        *(u32x4*)(WT + (size_t)row * K + k0 + 8 * c) = o; }
    asm volatile("s_waitcnt lgkmcnt(0)" ::: "memory");
}

#define RLX_AGENT __ATOMIC_RELAXED, __HIP_MEMORY_SCOPE_AGENT
#define XB_TMO      128
#define XB_XCNT(j)  (256  + 64 * (j))
#define XB_XSUB(j)  (1280 + 64 * (j))
#define XB_XGEN(j)  (2304 + 64 * (j))
#define XB_TOP      3328
#define XB_TOPGEN   3392
#define XCD_BAR_WORDS 3456
#define XB_SPIN_CAP (1u << 18)

__device__ __forceinline__ unsigned xb_ld(unsigned* p)              { return __hip_atomic_load(p, __ATOMIC_RELAXED, __HIP_MEMORY_SCOPE_AGENT); }
__device__ __forceinline__ unsigned xb_add(unsigned* p, unsigned v) { return __hip_atomic_fetch_add(p, v, __ATOMIC_RELAXED, __HIP_MEMORY_SCOPE_AGENT); }
__device__ __forceinline__ unsigned xb_xcc_id() { return (unsigned)__builtin_amdgcn_s_getreg((3 << 11) | 20) & 0xFu; }
#define XB_SPIN(cond, bar) do { unsigned _sp = 0; while (cond) { __builtin_amdgcn_s_sleep(1); \
    if ((++_sp & 255u) == 0u) { if (xb_ld(&(bar)[XB_TMO])) break; if (_sp > XB_SPIN_CAP) { atomicAdd(&(bar)[XB_TMO], 1u); break; } } } } while (0)

struct XcdBarrier {
    unsigned* bar; unsigned x;
    volatile LAS unsigned* st;
};

__device__ __forceinline__ XcdBarrier xcd_barrier_post(unsigned* bar, volatile LAS unsigned* st) {
    XcdBarrier b; b.bar = bar; b.x = xb_xcc_id(); b.st = st;
    if (threadIdx.x == 0) (void)xb_add(&bar[XB_XCNT(b.x)], 1u);
    return b;
}
__device__ __forceinline__ void xcd_barrier_complete(unsigned* bar, unsigned x, unsigned& nloc, unsigned& nx) {
    const unsigned G = gridDim.x * gridDim.y * gridDim.z;
    unsigned sum, cnt, mine, sp = 0u;
    for (;;) {
        sum = 0u; cnt = 0u; mine = 0u;
#pragma unroll
        for (unsigned j = 0; j < 16; ++j) { const unsigned c = xb_ld(&bar[XB_XCNT(j)]); sum += c; cnt += (c > 0u) ? 1u : 0u; mine = (j == x) ? c : mine; }
        if (sum == G) break;
        __builtin_amdgcn_s_sleep(1);
        if ((++sp & 255u) == 0u) { if (xb_ld(&bar[XB_TMO])) break; if (sp > XB_SPIN_CAP) { atomicAdd(&bar[XB_TMO], 1u); break; } }
    }
    nloc = mine > 0u ? mine : 1u; nx = cnt > 0u ? cnt : 1u;
}

__device__ __forceinline__ void xcd_barrier(const XcdBarrier& b) {
    asm volatile("s_waitcnt vmcnt(0)" ::: "memory");
    __syncthreads();
    if (threadIdx.x == 0) {
        unsigned* bar = b.bar;
        __builtin_amdgcn_s_waitcnt(0);
        unsigned nloc = b.st[0], nx = b.st[1];
        if (nloc == 0u) { xcd_barrier_complete(bar, b.x, nloc, nx); b.st[0] = nloc; b.st[1] = nx; }
        const unsigned old = xb_add(&bar[XB_XSUB(b.x)], 1u);
        const unsigned gen = old / nloc;
        if (old + 1u == (gen + 1u) * nloc) {
            __builtin_amdgcn_fence(__ATOMIC_RELEASE, "agent");
            asm volatile("s_waitcnt vmcnt(0)" ::: "memory");
            const unsigned og = xb_add(&bar[XB_TOP], 1u);
            const unsigned tg = og / nx;
            if (og + 1u == (tg + 1u) * nx) xb_add(&bar[XB_TOPGEN], 1u);
            else XB_SPIN(xb_ld(&bar[XB_TOPGEN]) == tg, bar);
            __builtin_amdgcn_fence(__ATOMIC_ACQUIRE, "agent");
            xb_add(&bar[XB_XGEN(b.x)], 1u);
            asm volatile("s_waitcnt vmcnt(0)" ::: "memory");
        } else {
            XB_SPIN(xb_ld(&bar[XB_XGEN(b.x)]) == gen, bar);
            __builtin_amdgcn_fence(__ATOMIC_ACQUIRE, "agent");
            asm volatile("s_waitcnt vmcnt(0)" ::: "memory");
        }
    }
    __syncthreads();
}

constexpr size_t WS_BAR = 6 * MiB;
struct Args { const float* in[41]; float* out; unsigned char* ws; };
typedef const __attribute__((address_space(4))) Args* KArgs;
__device__ __forceinline__ KArgs kargs() { KArgs p = (KArgs)__builtin_amdgcn_kernarg_segment_ptr(); asm volatile("" : "+s"(p)); return p; }


#define STA ((float*)(ws + WS_STA))
#define STB ((float*)(ws + WS_STB))
#define B1 ((bf16*)(ws + WS_B1))
#define B2 ((bf16*)(ws + WS_B2))
#define Rb ((bf16*)(ws + WS_R))
#define Kb (Rb + (size_t)T * 512)
#define Vb (Rb + (size_t)T * 1024)
#define Eb ((bf16*)(ws + WS_E))
#define Ab ((bf16*)(ws + WS_A))
#define KPb ((bf16*)(ws + WS_KP))
#define ZB ((bf16*)(dob + DO_ZB))
#define Xb ((bf16*)(dob + DO_X))
#define APb ((bf16*)(dob + DO_AP))
#define KKb ((bf16*)(dob + DO_KK))
#define Gb ((bf16*)(dob + DO_G))
#define RSb ((bf16*)(dob + DO_RS))
#define VSb ((bf16*)(dob + DO_VS))
#define BON ((float*)(ws + WS_BON))
#define HID ((bf16*)(ws + WS_HID))
#define PP ((bf16*)(ws + WS_PP))
#define YG ((bf16*)(ws + WS_YG))
#define PBF ((bf16*)(ws + WS_PBF))
#define EST ((f32x2*)(ws + WS_EST))
#define LB ((f32x2*)(ws + WS_S5P))
#define LBL (LB + 4096)
#define BB (LB + 8192)
#define PHASE_ARGS KArgs ka = kargs(); unsigned char* const ws = ka->ws; unsigned char* const dob = (unsigned char*)ka->out; (void)dob; int tid_p = threadIdx.x; asm volatile("" : "+v"(tid_p)); const int tid = tid_p, lane = tid & 63, wave = __builtin_amdgcn_readfirstlane(tid >> 6), gw = bid * NWAVES + wave, NGW = G * NWAVES; (void)gw; (void)NGW; (void)lane;

template <int pass> __device__ __forceinline__ void rwkv_seg_pass(LAS unsigned char* lds, unsigned char* const ws, unsigned char* const dob, const int bid, const int G, const int tid) {
    const int lane = tid & 63, wave = __builtin_amdgcn_readfirstlane(tid >> 6);
        constexpr int NCL = 32, NS = 10, SLOT = 12288;
        float* ESEG = (float*)(ws + WS_ESEG); float* MSEG = (float*)(ws + WS_MSEG);
        for (int job = bid; job < 256; job += G) {
            const int h = job & 7, sg = job >> 3, c0 = sg * NCL;
            __syncthreads();
            if (wave >= 4) {
                const int lw = wave - 4;
                const unsigned char* srcb[3]; unsigned ldso[3];
#pragma unroll
                for (int i = 0; i < 3; ++i) { const int p = (lw * 3 + i) * 64 + lane; const int blk = p >> 7, seg = (p >> 3) & 15, part = (p & 7) ^ ((seg >> 1) & 7);
                    const bf16* base = blk == 0 ? Ab : (blk == 1 ? RSb : (blk == 2 ? KKb : (blk == 3 ? KPb : (blk == 4 ? Eb : VSb))));
                    srcb[i] = (const unsigned char*)(base + ((size_t)h * T + seg) * 64) + part * 16; ldso[i] = (unsigned)((lw * 3 + i) * 1024); }
#define RW_ISSUE(cc_) do { const int cq = c0 + ((cc_) < NCL ? (cc_) : NCL - 1); const unsigned so = (unsigned)(((cc_) % NS) * SLOT); _Pragma("unroll") for (int i = 0; i < 3; ++i) \
        __builtin_amdgcn_global_load_lds((const unsigned*)(srcb[i] + (size_t)cq * 2048), (LAS unsigned*)(lds + so + ldso[i]), 16, 0, 0); } while (0)
                for (int c = 0; c < NS - 1; ++c) RW_ISSUE(c);
                asm volatile("s_waitcnt vmcnt(21)" ::: "memory");
                __builtin_amdgcn_s_barrier();
                for (int c = 0; c < NCL; ++c) {
                    RW_ISSUE(c + NS - 1);
                    asm volatile("s_waitcnt vmcnt(21)" ::: "memory");
                    __builtin_amdgcn_s_barrier();
                }
                asm volatile("s_waitcnt vmcnt(0)" ::: "memory");
#undef RW_ISSUE
            } else {
                const int fr = lane & 15, q = lane >> 4;
                f32x4 ST[4], SI[4];
#pragma unroll
                for (int m = 0; m < 4; ++m) { ST[m] = (f32x4){0.f, 0.f, 0.f, 0.f}; const int d_ = 16 * wave + fr - 16 * m - 4 * q;
                    SI[m] = (f32x4){d_ == 0 ? 1.f : 0.f, d_ == 1 ? 1.f : 0.f, d_ == 2 ? 1.f : 0.f, d_ == 3 ? 1.f : 0.f}; }
                if (pass == 1) {
                    const float* Mh = MSEG + (size_t)h * 32 * 4096; const float* Eh = ESEG + (size_t)h * 32 * 4096;
                    for (int s = 0; s < sg; ++s) {
                        const float* Ms = Mh + (size_t)s * 4096; const float* Es = Eh + (size_t)s * 4096;
                        bf16x4 shi[4], slo[4];
#pragma unroll
                        for (int k = 0; k < 4; ++k) { const f32x4 x = ST[k]; u32x2 hw; hw.x = pk2(x[0], x[1]); hw.y = pk2(x[2], x[3]);
                            const f32x4 xh = (f32x4){bflo(hw.x), bfhi(hw.x), bflo(hw.y), bfhi(hw.y)}; const f32x4 xl = x - xh; u32x2 lw2; lw2.x = pk2(xl[0], xl[1]); lw2.y = pk2(xl[2], xl[3]);
                            shi[k] = __builtin_bit_cast(bf16x4, hw); slo[k] = __builtin_bit_cast(bf16x4, lw2); }
                        f32x4 nw[4];
#pragma unroll
                        for (int m = 0; m < 4; ++m) { const float* ep_ = Es + (size_t)(16 * m + 4 * q) * 64 + 16 * wave + fr; nw[m] = (f32x4){ep_[0], ep_[64], ep_[128], ep_[192]}; }
#pragma unroll
                        for (int m = 0; m < 4; ++m) {
#pragma unroll
                            for (int k = 0; k < 4; ++k) {
                                const f32x4 x = *(const f32x4*)(Ms + (size_t)(16 * m + fr) * 64 + 16 * k + 4 * q);
                                u32x2 hw; hw.x = pk2(x[0], x[1]); hw.y = pk2(x[2], x[3]);
                                const f32x4 xh = (f32x4){bflo(hw.x), bfhi(hw.x), bflo(hw.y), bfhi(hw.y)}; const f32x4 xl = x - xh; u32x2 lw2; lw2.x = pk2(xl[0], xl[1]); lw2.y = pk2(xl[2], xl[3]);
                                const bf16x4 ahi = __builtin_bit_cast(bf16x4, hw), alo = __builtin_bit_cast(bf16x4, lw2);
                                nw[m] = __builtin_amdgcn_mfma_f32_16x16x16bf16_1k(ahi, shi[k], nw[m], 0, 0, 0);
                                nw[m] = __builtin_amdgcn_mfma_f32_16x16x16bf16_1k(ahi, slo[k], nw[m], 0, 0, 0);
                                nw[m] = __builtin_amdgcn_mfma_f32_16x16x16bf16_1k(alo, shi[k], nw[m], 0, 0, 0);
                            }
                            asm volatile("" ::: "memory");
                        }
#pragma unroll
                        for (int m = 0; m < 4; ++m) ST[m] = nw[m];
                    }
                }
                bf16x4 cw[4], cr[4], cb[4], ck[4], cp, cmb, cmk, cv; f32x4 cg[4];
#define RW_SW(seg_, pc_) ((((pc_) ^ (((seg_) >> 1) & 7))) * 16)
#define RW_READ(cc_) do { const LAS unsigned char* sl = lds + ((cc_) % NS) * SLOT; \
        _Pragma("unroll") for (int m = 0; m < 4; ++m) { const int sg_ = 4 * m + (fr >> 2), gs_ = 12 + ((16 * m + 4 * q) >> 5); \
            cw[m] = *(const LAS bf16x4*)(sl + 0 * 2048 + fr * 128 + RW_SW(fr, 2 * m + (q >> 1)) + (q & 1) * 8); \
            cr[m] = *(const LAS bf16x4*)(sl + 1 * 2048 + fr * 128 + RW_SW(fr, 2 * m + (q >> 1)) + (q & 1) * 8); \
            cb[m] = *(const LAS bf16x4*)(sl + 2 * 2048 + sg_ * 128 + RW_SW(sg_, (fr & 3) * 2 + (q >> 1)) + (q & 1) * 8); \
            ck[m] = *(const LAS bf16x4*)(sl + 3 * 2048 + sg_ * 128 + RW_SW(sg_, (fr & 3) * 2 + (q >> 1)) + (q & 1) * 8); \
            cg[m] = *(const LAS f32x4*)(sl + 4 * 2048 + gs_ * 128 + RW_SW(gs_, ((16 * m + 4 * q) & 31) >> 2)); } \
        { const int s0_ = fr >> 2, s1_ = 4 + (fr >> 2), s2_ = 8 + (fr >> 2), pc_ = (fr & 3) * 2 + (q >> 1); \
        cp  = *(const LAS bf16x4*)(sl + 4 * 2048 + s0_ * 128 + RW_SW(s0_, pc_) + (q & 1) * 8); \
        cmb = *(const LAS bf16x4*)(sl + 4 * 2048 + s1_ * 128 + RW_SW(s1_, pc_) + (q & 1) * 8); \
        cmk = *(const LAS bf16x4*)(sl + 4 * 2048 + s2_ * 128 + RW_SW(s2_, pc_) + (q & 1) * 8); } \
        _Pragma("unroll") for (int jj = 0; jj < 4; ++jj) cv[jj] = *(const LAS short*)(sl + 5 * 2048 + (4 * q + jj) * 128 + RW_SW(4 * q + jj, 2 * wave + (fr >> 3)) + (fr & 7) * 2); } while (0)
                __builtin_amdgcn_s_barrier();
                RW_READ(0);
                float* yout = (float*)(ws + WS_Y) + ((size_t)h * T + (size_t)c0 * 16) * 64 + 16 * wave + fr;
                for (int c = 0; c < NCL; ++c) {
                    const bf16x4 w0 = cw[0], w1 = cw[1], w2 = cw[2], w3 = cw[3], r0 = cr[0], r1 = cr[1], r2 = cr[2], r3 = cr[3];
                    const bf16x4 b0 = cb[0], b1 = cb[1], b2 = cb[2], b3 = cb[3], k0 = ck[0], k1 = ck[1], k2 = ck[2], k3 = ck[3];
                    const bf16x4 pp_ = cp, mb_ = cmb, mk_ = cmk, vv_ = cv; const f32x4 g0 = cg[0], g1 = cg[1], g2 = cg[2], g3 = cg[3];
                    if (c + 1 < NCL) RW_READ(c + 1);
                    bf16x4 sb[4];
#pragma unroll
                    for (int m = 0; m < 4; ++m) { u32x2 t2; t2.x = pk2(ST[m][0], ST[m][1]); t2.y = pk2(ST[m][2], ST[m][3]); sb[m] = __builtin_bit_cast(bf16x4, t2); }
                    const f32x4 z4 = (f32x4){0.f, 0.f, 0.f, 0.f};
                    f32x4 ua = __builtin_amdgcn_mfma_f32_16x16x16bf16_1k(pp_, vv_, z4, 0, 0, 0);
                    f32x4 ub = __builtin_amdgcn_mfma_f32_16x16x16bf16_1k(w0, sb[0], z4, 0, 0, 0);
                    ua = __builtin_amdgcn_mfma_f32_16x16x16bf16_1k(w1, sb[1], ua, 0, 0, 0);
                    ub = __builtin_amdgcn_mfma_f32_16x16x16bf16_1k(w2, sb[2], ub, 0, 0, 0);
                    ua = __builtin_amdgcn_mfma_f32_16x16x16bf16_1k(w3, sb[3], ua, 0, 0, 0);
                    if (pass == 0) {
                        bf16x4 si[4];
#pragma unroll
                        for (int m = 0; m < 4; ++m) { u32x2 t2; t2.x = pk2(SI[m][0], SI[m][1]); t2.y = pk2(SI[m][2], SI[m][3]); si[m] = __builtin_bit_cast(bf16x4, t2); }
                        f32x4 va = __builtin_amdgcn_mfma_f32_16x16x16bf16_1k(w0, si[0], z4, 0, 0, 0);
                        f32x4 vb = __builtin_amdgcn_mfma_f32_16x16x16bf16_1k(w1, si[1], z4, 0, 0, 0);
                        va = __builtin_amdgcn_mfma_f32_16x16x16bf16_1k(w2, si[2], va, 0, 0, 0);
                        vb = __builtin_amdgcn_mfma_f32_16x16x16bf16_1k(w3, si[3], vb, 0, 0, 0);
                        const f32x4 vt = va + vb; u32x2 v2; v2.x = pk2(vt[0], vt[1]); v2.y = pk2(vt[2], vt[3]); const bf16x4 vbf = __builtin_bit_cast(bf16x4, v2);
                        SI[0] = __builtin_amdgcn_mfma_f32_16x16x16bf16_1k(b0, vbf, SI[0] * g0, 0, 0, 0);
                        SI[1] = __builtin_amdgcn_mfma_f32_16x16x16bf16_1k(b1, vbf, SI[1] * g1, 0, 0, 0);
                        SI[2] = __builtin_amdgcn_mfma_f32_16x16x16bf16_1k(b2, vbf, SI[2] * g2, 0, 0, 0);
                        SI[3] = __builtin_amdgcn_mfma_f32_16x16x16bf16_1k(b3, vbf, SI[3] * g3, 0, 0, 0);
                    }
                    f32x4 ya = z4, yb = z4;
                    if (pass == 1) {
                        ya = __builtin_amdgcn_mfma_f32_16x16x16bf16_1k(mk_, vv_, z4, 0, 0, 0);
                        yb = __builtin_amdgcn_mfma_f32_16x16x16bf16_1k(r0, sb[0], z4, 0, 0, 0);
                        ya = __builtin_amdgcn_mfma_f32_16x16x16bf16_1k(r1, sb[1], ya, 0, 0, 0);
                        yb = __builtin_amdgcn_mfma_f32_16x16x16bf16_1k(r2, sb[2], yb, 0, 0, 0);
                        ya = __builtin_amdgcn_mfma_f32_16x16x16bf16_1k(r3, sb[3], ya, 0, 0, 0);
                    }
                    ST[0] = __builtin_amdgcn_mfma_f32_16x16x16bf16_1k(k0, vv_, ST[0] * g0, 0, 0, 0);
                    ST[1] = __builtin_amdgcn_mfma_f32_16x16x16bf16_1k(k1, vv_, ST[1] * g1, 0, 0, 0);
                    ST[2] = __builtin_amdgcn_mfma_f32_16x16x16bf16_1k(k2, vv_, ST[2] * g2, 0, 0, 0);
                    ST[3] = __builtin_amdgcn_mfma_f32_16x16x16bf16_1k(k3, vv_, ST[3] * g3, 0, 0, 0);
                    const f32x4 ut = ua + ub;
                    u32x2 u2; u2.x = pk2(ut[0], ut[1]); u2.y = pk2(ut[2], ut[3]); const bf16x4 ubf = __builtin_bit_cast(bf16x4, u2);
                    ST[0] = __builtin_amdgcn_mfma_f32_16x16x16bf16_1k(b0, ubf, ST[0], 0, 0, 0);
                    ST[1] = __builtin_amdgcn_mfma_f32_16x16x16bf16_1k(b1, ubf, ST[1], 0, 0, 0);
                    ST[2] = __builtin_amdgcn_mfma_f32_16x16x16bf16_1k(b2, ubf, ST[2], 0, 0, 0);
                    ST[3] = __builtin_amdgcn_mfma_f32_16x16x16bf16_1k(b3, ubf, ST[3], 0, 0, 0);
                    if (pass == 1) {
                        ya = __builtin_amdgcn_mfma_f32_16x16x16bf16_1k(mb_, ubf, ya, 0, 0, 0);
                        const f32x4 yt = ya + yb;
#pragma unroll
                        for (int jj = 0; jj < 4; ++jj) yout[(size_t)(c * 16 + 4 * q + jj) * 64] = yt[jj];
                    }
                    __builtin_amdgcn_s_barrier();
                }
#undef RW_READ
#undef RW_SW
                if (pass == 0) {
                    float* Es = ESEG + ((size_t)h * 32 + sg) * 4096; float* Ms = MSEG + ((size_t)h * 32 + sg) * 4096;
#pragma unroll
                    for (int m = 0; m < 4; ++m)
#pragma unroll
                        for (int v = 0; v < 4; ++v) { const size_t o = (size_t)(16 * m + 4 * q + v) * 64 + 16 * wave + fr; Es[o] = ST[m][v]; Ms[o] = SI[m][v]; }
                }
            }
        }
}

__global__ void __launch_bounds__(NWAVES * 64, 2) mega_fwd(Args a) {
    extern __shared__ __attribute__((aligned(16))) unsigned char lds_raw[];
    LAS unsigned char* lds = (LAS unsigned char*)lds_raw;
    cg::grid_group grid = cg::this_grid();
    const int G = gridDim.x, bid = blockIdx.x;
    volatile LAS unsigned* xst = (volatile LAS unsigned*)(lds + LDS_BYTES - 16);
    if (threadIdx.x < 2) xst[threadIdx.x] = 0u;
    __syncthreads();
    XcdBarrier xbar = xcd_barrier_post((unsigned*)(((KArgs)__builtin_amdgcn_kernarg_segment_ptr())->ws + WS_BAR), xst);
#define GSYNC() xcd_barrier(xbar)
#define GSYNC_CG() do { asm volatile("s_waitcnt vmcnt(0)" ::: "memory"); __syncthreads(); if (threadIdx.x == 0) __builtin_amdgcn_fence(__ATOMIC_RELEASE, "agent"); grid.sync(); __builtin_amdgcn_fence(__ATOMIC_ACQUIRE, "agent"); asm volatile("s_waitcnt vmcnt(0)" ::: "memory"); } while (0)

    {
        PHASE_ARGS
        LAS float* scr = (LAS float*)(lds + wave * 16384);
        constexpr int I_IN = 16 * (DIN / 32), I_SQ = 16 * 32, I_UP = 16 * 128, I_DN = 64 * 32, I_PR = 4 * 32;
        constexpr int NITEMS = I_IN + I_SQ + I_UP + I_DN + I_SQ + I_PR + 2 * I_SQ + I_UP + I_DN + I_SQ + I_PR;
        for (int it = gw; it < NITEMS; it += NGW) {
            int r = it;
            if (r < I_IN) { tr_item(ka->in[3], D, DIN, (bf16*)(ws + W_IN), 0, ka->in[2], scr, r, lane); continue; } r -= I_IN;
            if (r < I_SQ) { tr_item(ka->in[16], D, D, (bf16*)(ws + W_OUT), 0, nullptr, scr, r, lane); continue; } r -= I_SQ;
            if (r < I_UP) { tr_item(ka->in[18], D, FF, (bf16*)(ws + W_UP0), 0, ka->in[17], scr, r, lane); continue; } r -= I_UP;
            if (r < I_DN) { tr_item(ka->in[19], FF, D, (bf16*)(ws + W_DN0), 0, nullptr, scr, r, lane); continue; } r -= I_DN;
            if (r < I_SQ) { tr_item(ka->in[21], D, D, (bf16*)(ws + W_G0), 0, ka->in[20], scr, r, lane); continue; } r -= I_SQ;
            if (r < I_PR) { tr_item(ka->in[22], 256, D, (bf16*)(ws + W_P0), 0, nullptr, scr, r, lane); continue; } r -= I_PR;
            if (r < I_SQ) { tr_item(ka->in[32], D, D, (bf16*)(ws + W_GLU), 1, nullptr, scr, r, lane); continue; } r -= I_SQ;
            if (r < I_SQ) { tr_item(ka->in[33], D, D, (bf16*)(ws + W_GLU), 2, nullptr, scr, r, lane); continue; } r -= I_SQ;
            if (r < I_UP) { tr_item(ka->in[35], D, FF, (bf16*)(ws + W_UP1), 0, ka->in[34], scr, r, lane); continue; } r -= I_UP;
            if (r < I_DN) { tr_item(ka->in[36], FF, D, (bf16*)(ws + W_DN1), 0, nullptr, scr, r, lane); continue; } r -= I_DN;
            if (r < I_SQ) { tr_item(ka->in[38], D, D, (bf16*)(ws + W_G1), 0, ka->in[37], scr, r, lane); continue; } r -= I_SQ;
            tr_item(ka->in[39], 256, D, (bf16*)(ws + W_P1), 0, nullptr, scr, r, lane);
        }
        {
            bf16* WL = (bf16*)(ws + W_LORA); const float* wl = ka->in[6]; const float* al = ka->in[8]; const float* gl = ka->in[9];
            for (int i = bid * 512 + tid; i < 1536 * 256; i += G * 512) {
                const int n = i >> 8, k = i & 255; float v = 0.f;
                if (n < 512) { if (k < 64) v = wl[k * 512 + n]; }
                else if (n < 1024) { if (k >= 64 && k < 128) v = al[(k - 64) * 512 + (n - 512)]; }
                else { if (k >= 128) v = gl[(k - 128) * 512 + (n - 1024)]; }
                WL[i] = (bf16)(pk2(v, 0.f) & 0xffffu);
            }
        }
        for (int m = gw; m < T; m += NGW) {
            const f32x4* xr = (const f32x4*)(ka->in[0] + (size_t)m * D) + lane; f32x4 v[4]; float s = 0.f;
#pragma unroll
            for (int j = 0; j < 4; ++j) { v[j] = xr[64 * j]; s += (v[j][0] * v[j][0] + v[j][1] * v[j][1]) + (v[j][2] * v[j][2] + v[j][3] * v[j][3]); }
            s = wave_sum(s);
            u32x2* o8 = (u32x2*)(B1 + (size_t)m * D) + lane;
#pragma unroll
            for (int j = 0; j < 4; ++j) { u32x2 w; w.x = pk2(v[j][0], v[j][1]); w.y = pk2(v[j][2], v[j][3]); o8[64 * j] = w; }
            if (lane < 16) STA[(size_t)m * 32 + lane] = lane == 0 ? s : 0.f;
        }
        {
            const f32x4* ps = (const f32x4*)ka->in[1]; u32x2* pd = (u32x2*)PBF;
            for (int i = bid * 512 + tid; i < 2 * T * 256 / 4; i += G * 512) { const f32x4 v = ps[i]; u32x2 w; w.x = pk2(v[0], v[1]); w.y = pk2(v[2], v[3]); pd[i] = w; }
        }
        for (int i = bid * 512 + tid; i < 4096; i += G * 512) {
            const int g = i >> 6;
            const float step = expf(ka->in[26][g]); const float lre = fminf(ka->in[24][i], -1e-4f), lim = ka->in[25][i];
            const float x = lre * step, ang = lim * step; float sn, cs; sincosf(ang, &sn, &cs);
            const float er = expf(x); const float lbr = er * cs, lbi = er * sn;
            const float sh = sinf(0.5f * ang); const float nr = expm1f(x) * cs - 2.f * sh * sh, ni = lbi;
            const float d = lre * lre + lim * lim; const float qr = (nr * lre + ni * lim) / d, qi = (ni * lre - nr * lim) / d;
            LB[i] = (f32x2){lbr, lbi};
            float pr = lbr, pi = lbi;
#pragma unroll
            for (int q = 0; q < 7; ++q) { const float tr = pr * pr - pi * pi, ti = 2.f * pr * pi; pr = tr; pi = ti; }
            LBL[i] = (f32x2){pr, pi};
            for (int c = 0; c < 16; ++c) { const float br = ka->in[27][(size_t)i * 16 + c], bi = ka->in[28][(size_t)i * 16 + c]; BB[(size_t)i * 16 + c] = (f32x2){qr * br - qi * bi, qr * bi + qi * br}; }
        }
    }
    GSYNC_CG();

    {
        PHASE_ARGS
        pg8::Gemm g{B1, (const bf16*)(ws + W_IN), T, DIN, D}; pg8::StaticOrder S; S.init(T, DIN, G, bid);
        pg8::EpiB<0, 16> E{Rb, Xb, ZB, STA, nullptr, nullptr, 0};
        pg8::gemm_phase<pg8::EpiB<0, 16>, pg8::StaticOrder, true, true>(lds, g, S, E);
    }
    GSYNC();

    {
        PHASE_ARGS
        const float* mu = ka->in[4]; const float* cw = ka->in[15];
        for (int t = gw; t < T; t += NGW) {
            {
                const u32x2 x0 = *((const u32x2*)(Xb + (size_t)t * 256) + lane);
                u32x2 x1 = (u32x2){0u, 0u}; if (t > 0) x1 = *((const u32x2*)(Xb + (size_t)(t - 1) * 256) + lane);
                const f32x4 m4 = *((const f32x4*)(mu + 1536) + lane);
                float c[4] = {bflo(x0.x), bfhi(x0.x), bflo(x0.y), bfhi(x0.y)}, p[4] = {bflo(x1.x), bfhi(x1.x), bflo(x1.y), bfhi(x1.y)}, o[4];
#pragma unroll
                for (int e = 0; e < 4; ++e) { const float xs = c[e] + m4[e] * (p[e] - c[e]);
                    o[e] = lane < 16 ? tanhf(xs) : (lane < 32 ? xs : pg8::fsigmoid(xs)); }
                u32x2 w; w.x = pk2(o[0], o[1]); w.y = pk2(o[2], o[3]); *((u32x2*)(APb + (size_t)t * 256) + lane) = w;
            }
            {
                const bf16* z0 = ZB + (size_t)t * 1536; float bg[8], c0[8], x0[8], c1[8], x1[8], c2[8], x2[8];
                unpack8(*((const u32x4*)z0 + lane), bg); unpack8(*((const u32x4*)(z0 + 512) + lane), c0); unpack8(*((const u32x4*)(z0 + 1024) + lane), x0);
                const u32x4 zz = (u32x4){0u, 0u, 0u, 0u};
                unpack8(t > 0 ? *((const u32x4*)(z0 - 1536 + 512) + lane) : zz, c1); unpack8(t > 0 ? *((const u32x4*)(z0 - 1536 + 1024) + lane) : zz, x1);
                unpack8(t > 1 ? *((const u32x4*)(z0 - 3072 + 512) + lane) : zz, c2); unpack8(t > 1 ? *((const u32x4*)(z0 - 3072 + 1024) + lane) : zz, x2);
                float o[8];
#pragma unroll
                for (int e = 0; e < 8; ++e) { const int ch = 8 * lane + e; o[e] = bg[e] * (cw[ch] * (c0[e] * x0[e]) + cw[512 + ch] * (c1[e] * x1[e]) + cw[1024 + ch] * (c2[e] * x2[e])); }
                *((u32x4*)(B2 + (size_t)t * D + 512) + lane) = pack8(o);
            }
        }
    }
    GSYNC();

    {
        PHASE_ARGS
        pg8::Gemm g{APb, (const bf16*)(ws + W_LORA), T, 1536, 256}; pg8::StaticOrder S; S.init(T, 1536, G, bid);
        pg8::EpiB<1, 16> E{Eb, Ab, Gb, nullptr, ka->in[5], ka->in[7], 0};
        pg8::gemm_phase<pg8::EpiB<1, 16>, pg8::StaticOrder, true, true>(lds, g, S, E);
    }
    GSYNC();

    {
        PHASE_ARGS
        const float* mu = ka->in[4]; const float* k_k = ka->in[10]; const float* k_a = ka->in[11]; const float* r_k = ka->in[12];
        float mr[8], mk[8], mv[8], kk_[8], ka_[8], rk_[8];
#pragma unroll
        for (int e = 0; e < 8; ++e) { const int ch = 8 * lane + e; mr[e] = mu[ch]; mk[e] = mu[512 + ch]; mv[e] = mu[1024 + ch]; kk_[e] = k_k[ch]; ka_[e] = k_a[ch]; rk_[e] = r_k[ch]; }
        for (int t = gw; t < T; t += NGW) {
            float k0[8], k1[8], r0[8], r1[8], v0[8], v1[8], av[8];
            const u32x4 zz = (u32x4){0u, 0u, 0u, 0u};
            unpack8(*((const u32x4*)(Kb + (size_t)t * 512) + lane), k0); unpack8(t > 0 ? *((const u32x4*)(Kb + (size_t)(t - 1) * 512) + lane) : zz, k1);
            unpack8(*((const u32x4*)(Rb + (size_t)t * 512) + lane), r0); unpack8(t > 0 ? *((const u32x4*)(Rb + (size_t)(t - 1) * 512) + lane) : zz, r1);
            unpack8(*((const u32x4*)(Vb + (size_t)t * 512) + lane), v0); unpack8(t > 0 ? *((const u32x4*)(Vb + (size_t)(t - 1) * 512) + lane) : zz, v1);
            unpack8(*(const u32x4*)(Ab + hm8(t, lane)), av);
            float kp[8], kn[8], rs[8], vs[8]; float ss = 0.f, bs = 0.f;
#pragma unroll
            for (int e = 0; e < 8; ++e) {
                const float ks = k0[e] + mk[e] * (k1[e] - k0[e]); rs[e] = r0[e] + mr[e] * (r1[e] - r0[e]); vs[e] = v0[e] + mv[e] * (v1[e] - v0[e]);
                kn[e] = ks * kk_[e]; ss += kn[e] * kn[e];
                kp[e] = ks * (1.f + (av[e] - 1.f) * ka_[e]); bs += rs[e] * kp[e] * rk_[e];
            }
            ss = sum8(ss); bs = sum8(bs);
            const float inv = 1.f / fmaxf(sqrtf(ss), 1e-12f);
#pragma unroll
            for (int e = 0; e < 8; ++e) kn[e] *= inv;
            *(u32x4*)(KPb + hm8(t, lane)) = pack8(kp);
            *(u32x4*)(KKb + hm8(t, lane)) = pack8(kn);
            *(u32x4*)(RSb + hm8(t, lane)) = pack8(rs);
            *(u32x4*)(VSb + hm8(t, lane)) = pack8(vs);
            if ((lane & 7) == 0) BON[(size_t)t * 8 + (lane >> 3)] = bs;
        }
    }
    GSYNC();

    {
        PHASE_ARGS
        constexpr int TS = 68;
        LAS bf16* TA = (LAS bf16*)(lds + wave * 12288);
        LAS bf16* TBh = TA + 16 * TS; LAS bf16* TKh = TBh + 16 * TS; LAS bf16* TR = TKh + 16 * TS;
        LAS float* MAB = (LAS float*)(lds + wave * 12288 + 8704);
        LAS float* MAK = MAB + 256; LAS float* TM = MAK + 256;
        for (int u = gw; u < 8192; u += NGW) {
            const int c = u >> 3, h = u & 7; const size_t bo = ((size_t)h * T + c * 16) * 64;
            float at[16], bh[16], kh[16], rt[16];
            {
                unsigned short e_[16], k_[16], a_[16], p_[16], r_[16];
#pragma unroll
                for (int t = 0; t < 16; ++t) { const size_t o = bo + (size_t)t * 64 + lane; e_[t] = Eb[o]; k_[t] = KKb[o]; a_[t] = Ab[o]; p_[t] = KPb[o]; r_[t] = RSb[o]; }
                float g = 1.f;
#pragma unroll
                for (int t = 0; t < 16; ++t) {
                    const float w = __builtin_amdgcn_exp2f(-bflo(e_[t])); const float gp = g; g *= w; const float gi = 1.0f / g;
                    const float kkv = bflo(k_[t]);
                    at[t] = -kkv * gp; bh[t] = kkv * bflo(a_[t]) * gi; kh[t] = bflo(p_[t]) * gi; rt[t] = bflo(r_[t]) * g;
                    TA[t * TS + lane] = (bf16)(pk2(at[t], 0.f) & 0xffffu); TBh[t * TS + lane] = (bf16)(pk2(bh[t], 0.f) & 0xffffu);
                    TKh[t * TS + lane] = (bf16)(pk2(kh[t], 0.f) & 0xffffu); TR[t * TS + lane] = (bf16)(pk2(rt[t], 0.f) & 0xffffu);
                }
                bf16* bbp = KKb + bo + (size_t)(lane >> 2) * 64 + (lane & 3) * 16; bf16* kbp = KPb + bo + (size_t)(lane >> 2) * 64 + (lane & 3) * 16;
                float tb[8], tk[8];
#pragma unroll
                for (int hh = 0; hh < 2; ++hh) {
#pragma unroll
                    for (int e = 0; e < 8; ++e) { tb[e] = bh[hh * 8 + e] * g; tk[e] = kh[hh * 8 + e] * g; }
                    *(u32x4*)(bbp + hh * 8) = pack8(tb); *(u32x4*)(kbp + hh * 8) = pack8(tk);
                }
                ((float*)(Eb + bo + (size_t)(12 + (lane >> 5)) * 64))[lane & 31] = g;
#pragma unroll
                for (int t = 0; t < 16; ++t) RSb[bo + (size_t)t * 64 + lane] = (bf16)(pk2(rt[t], 0.f) & 0xffffu);
            }
            const int fr = lane & 15, q = lane >> 4;
            f32x4 mab = (f32x4){0.f, 0.f, 0.f, 0.f}, mak = mab, mbr = mab, mkr = mab;
#pragma unroll
            for (int m = 0; m < 4; ++m) {
                const bf16x4 fb = *(const LAS bf16x4*)(TBh + fr * TS + 16 * m + 4 * q), fk = *(const LAS bf16x4*)(TKh + fr * TS + 16 * m + 4 * q);
                const bf16x4 fa = *(const LAS bf16x4*)(TA + fr * TS + 16 * m + 4 * q), frr = *(const LAS bf16x4*)(TR + fr * TS + 16 * m + 4 * q);
                mab = __builtin_amdgcn_mfma_f32_16x16x16bf16_1k(fb, fa, mab, 0, 0, 0); mak = __builtin_amdgcn_mfma_f32_16x16x16bf16_1k(fk, fa, mak, 0, 0, 0);
                mbr = __builtin_amdgcn_mfma_f32_16x16x16bf16_1k(fb, frr, mbr, 0, 0, 0); mkr = __builtin_amdgcn_mfma_f32_16x16x16bf16_1k(fk, frr, mkr, 0, 0, 0);
            }
#pragma unroll
            for (int jj = 0; jj < 4; ++jj) { const int s = 4 * q + jj;
                MAB[s * 16 + fr] = s < fr ? mab[jj] : 0.f; MAK[s * 16 + fr] = s < fr ? mak[jj] : 0.f;
                mbr[jj] = s <= fr ? mbr[jj] : 0.f; mkr[jj] = s <= fr ? mkr[jj] : 0.f; }
            {
                u32x2 w1, w2; w1.x = pk2(mbr[0], mbr[1]); w1.y = pk2(mbr[2], mbr[3]); w2.x = pk2(mkr[0], mkr[1]); w2.y = pk2(mkr[2], mkr[3]);
                *(u32x2*)(Eb + bo + (size_t)(4 + (fr >> 2)) * 64 + (fr & 3) * 16 + 4 * q) = w1;
                *(u32x2*)(Eb + bo + (size_t)(8 + (fr >> 2)) * 64 + (fr & 3) * 16 + 4 * q) = w2;
            }
            float tm[16];
#pragma unroll
            for (int t = 0; t < 16; ++t) { float acc = (t == fr) ? 1.f : 0.f;
#pragma unroll
                for (int s = 0; s < t; ++s) acc += tm[s] * MAB[s * 16 + t];
                tm[t] = acc; }
            if (q == 0) {
#pragma unroll
                for (int t = 0; t < 16; ++t) TM[fr * 16 + t] = tm[t];
            }
#pragma unroll
            for (int t = 0; t < 16; ++t) { float acc = 0.f;
#pragma unroll
                for (int s = 0; s <= t; ++s) acc += TM[s * 16 + t] * at[s];
                Ab[bo + (size_t)t * 64 + lane] = (bf16)(pk2(acc, 0.f) & 0xffffu); }
            {
                float p4[4] = {0.f, 0.f, 0.f, 0.f};
#pragma unroll
                for (int s2 = 0; s2 < 16; ++s2) { const float mk_ = MAK[fr * 16 + s2];
#pragma unroll
                    for (int e = 0; e < 4; ++e) p4[e] += mk_ * TM[s2 * 16 + 4 * q + e]; }
#pragma unroll
                for (int e = 0; e < 4; ++e) { const int t = 4 * q + e; Eb[bo + (size_t)(t >> 2) * 64 + (t & 3) * 16 + fr] = (bf16)(pk2(p4[e], 0.f) & 0xffffu); }
            }
        }
    }
    GSYNC();

    { PHASE_ARGS rwkv_seg_pass<0>(lds, ws, dob, bid, G, tid); }
    GSYNC();
    { PHASE_ARGS rwkv_seg_pass<1>(lds, ws, dob, bid, G, tid); }
    GSYNC();

    {
        PHASE_ARGS
        const float* lnw = ka->in[13]; const float* lnb = ka->in[14];
        float lw[8], lb[8];
#pragma unroll
        for (int e = 0; e < 8; ++e) { const int ch = 8 * lane + e; lw[e] = lnw[ch]; lb[e] = lnb[ch]; }
        const float* YRp = (const float*)(ws + WS_Y);
        for (int t = gw; t < T; t += NGW) {
            const f32x4 ya = *(const f32x4*)(YRp + hm8(t, lane)), yb = *(const f32x4*)(YRp + hm8(t, lane) + 4);
            float y[8] = {ya[0], ya[1], ya[2], ya[3], yb[0], yb[1], yb[2], yb[3]};
            float vs[8], gv[8];
            unpack8(*(const u32x4*)(VSb + hm8(t, lane)), vs);
            unpack8(*((const u32x4*)(Gb + (size_t)t * 512) + lane), gv);
            float s = 0.f;
#pragma unroll
            for (int e = 0; e < 8; ++e) s += y[e];
            const float mean = sum8(s) * (1.f / 64.f); float qv = 0.f;
#pragma unroll
            for (int e = 0; e < 8; ++e) { y[e] -= mean; qv += y[e] * y[e]; }
            const float rstd = rsqrtf(sum8(qv) * (1.f / 64.f) + 64e-5f);
            const float bon = BON[(size_t)t * 8 + (lane >> 3)];
            float o[8];
#pragma unroll
            for (int e = 0; e < 8; ++e) o[e] = (y[e] * rstd * lw[e] + lb[e] + bon * vs[e]) * gv[e];
            *((u32x4*)(B2 + (size_t)t * D) + lane) = pack8(o);
        }
    }
    GSYNC();

    {
        PHASE_ARGS
        pg8::Gemm g{B2, (const bf16*)(ws + W_OUT), T, D, D}; pg8::StaticOrder S; S.init(T, D, G, bid);
        pg8::EpiRes<0> E{ka->in[0], ka->out, B1, nullptr, STB, nullptr};
        pg8::gemm_phase<pg8::EpiRes<0>, pg8::StaticOrder, true, true>(lds, g, S, E);
    }
    GSYNC();
    {
        PHASE_ARGS
        pg8::Gemm g{B1, (const bf16*)(ws + W_UP0), T, FF, D}; pg8::StaticOrder S; S.init(T, FF, G, bid);
        pg8::EpiB<2, 16> E{HID, nullptr, nullptr, STB, nullptr, nullptr, FF};
        pg8::gemm_phase<pg8::EpiB<2, 16>, pg8::StaticOrder, true, true>(lds, g, S, E);
    }
    GSYNC();
    {
        PHASE_ARGS
        pg8::Gemm g{HID, (const bf16*)(ws + W_DN0), T, D, FF}; pg8::StaticOrder S; S.init(T, D, G, bid);
        pg8::EpiRes<0> E{ka->out, ka->out, B1, nullptr, STA, nullptr};
        pg8::gemm_phase<pg8::EpiRes<0>, pg8::StaticOrder, true, true>(lds, g, S, E);
    }
    GSYNC();
    {
        PHASE_ARGS
        pg8::Gemm g{PBF, (const bf16*)(ws + W_P0), T, D, 256}; pg8::StaticOrder S; S.init(T, D, G, bid);
        pg8::EpiB<3, 16> E{PP, nullptr, nullptr, nullptr, nullptr, nullptr, D};
        pg8::gemm_phase<pg8::EpiB<3, 16>, pg8::StaticOrder, true, true>(lds, g, S, E);
    }
    GSYNC();
    {
        PHASE_ARGS
        pg8::Gemm g{B1, (const bf16*)(ws + W_G0), T, D, D}; pg8::StaticOrder S; S.init(T, D, G, bid);
        pg8::EpiRes<1> E{ka->out, ka->out, B2, STA, STB, PP};
        pg8::gemm_phase<pg8::EpiRes<1>, pg8::StaticOrder, true, true>(lds, g, S, E);
    }
    GSYNC();

#pragma unroll 1
    for (int pass = 0; pass < 2; ++pass) {
        PHASE_ARGS
        LAS bf16* UTb = (LAS bf16*)(lds + wave * 16896);
        LAS bf16* HS = (LAS bf16*)(lds + wave * 16896 + 4096);
        LAS float* BUL = (LAS float*)(lds + wave * 16896 + 8448);
        const float* gm = ka->in[23]; const float* dsk = ka->in[31];
        const int fr = lane & 15, q = lane >> 4;
        f32x2 hcar = (f32x2){0.f, 0.f}; int cdone = 0;
        for (int u = gw; u < 8192; u += NGW) {
            const int ck = u >> 6, g = u & 63, t0 = ck * 128;
#pragma unroll
            for (int qq = 0; qq < 2; ++qq) {
                const int tk = lane + 64 * qq, t = t0 + tk;
                const f32x4* sp = (const f32x4*)(STB + (size_t)t * 32); const f32x4 s0 = sp[0], s1 = sp[1], s2 = sp[2], s3 = sp[3];
                const float ssq = ((s0[0] + s0[1]) + (s0[2] + s0[3])) + ((s1[0] + s1[1]) + (s1[2] + s1[3])) + ((s2[0] + s2[1]) + (s2[2] + s2[3])) + ((s3[0] + s3[1]) + (s3[2] + s3[3]));
                const float rs = rsqrtf(ssq * (1.f / 1024.f) + 1e-6f);
                float f0[8], f1[8]; unpack8(*(const u32x4*)(B2 + (size_t)t * D + 16 * g), f0); unpack8(*(const u32x4*)(B2 + (size_t)t * D + 16 * g + 8), f1);
                const f32x4 g0 = *(const f32x4*)(gm + 16 * g), g1 = *(const f32x4*)(gm + 16 * g + 4), g2 = *(const f32x4*)(gm + 16 * g + 8), g3 = *(const f32x4*)(gm + 16 * g + 12);
                float o0[8] = {f0[0] * rs * g0[0], f0[1] * rs * g0[1], f0[2] * rs * g0[2], f0[3] * rs * g0[3], f0[4] * rs * g1[0], f0[5] * rs * g1[1], f0[6] * rs * g1[2], f0[7] * rs * g1[3]};
                float o1[8] = {f1[0] * rs * g2[0], f1[1] * rs * g2[1], f1[2] * rs * g2[2], f1[3] * rs * g2[3], f1[4] * rs * g3[0], f1[5] * rs * g3[1], f1[6] * rs * g3[2], f1[7] * rs * g3[3]};
                LAS u32x4* ud = (LAS u32x4*)(UTb + tk * 16); ud[0] = pack8(o0); ud[1] = pack8(o1);
            }
            bf16x4 bre[4], bim[4];
#pragma unroll
            for (int i = 0; i < 4; ++i) {
                const float* bp = (const float*)(BB + ((size_t)g * 64 + 16 * i + fr) * 16 + 4 * q);
                const f32x4 x0 = *(const f32x4*)bp, x1 = *(const f32x4*)(bp + 4);
                u32x2 wr_, wi_; wr_.x = pk2(x0[0], x0[2]); wr_.y = pk2(x1[0], x1[2]); wi_.x = pk2(x0[1], x0[3]); wi_.y = pk2(x1[1], x1[3]);
                bre[i] = __builtin_bit_cast(bf16x4, wr_); bim[i] = __builtin_bit_cast(bf16x4, wi_);
            }
            const f32x2 lam = LB[g * 64 + lane];
            f32x2 hst = (f32x2){0.f, 0.f};
            bf16x8 cf[4]; float dk = 0.f;
            if (pass == 1) {
                const f32x2 lL = LBL[g * 64 + lane];
                if ((NGW & 63) != 0) { hcar = (f32x2){0.f, 0.f}; cdone = 0; }
                for (int c2 = cdone; c2 < ck; c2 += 16) {
                    f32x2 eb[16];
#pragma unroll
                    for (int i = 0; i < 16; ++i) eb[i] = (c2 + i < ck) ? EST[((size_t)(c2 + i) * 64 + g) * 64 + lane] : (f32x2){0.f, 0.f};
#pragma unroll
                    for (int i = 0; i < 16; ++i) if (c2 + i < ck) { const float nr = lL[0] * hcar[0] - lL[1] * hcar[1] + eb[i][0], ni = lL[0] * hcar[1] + lL[1] * hcar[0] + eb[i][1]; hcar = (f32x2){nr, ni}; }
                }
                cdone = ck; hst = hcar;
#pragma unroll
                for (int ks = 0; ks < 4; ++ks) {
                    const float* src = (ks < 2 ? ka->in[29] : ka->in[30]) + ((size_t)g * 16 + fr) * 64 + (ks & 1) * 32 + q * 8;
                    const f32x4 x0 = *(const f32x4*)src, x1 = *(const f32x4*)(src + 4); const float sg = ks < 2 ? 1.f : -1.f;
                    u32x4 w; w.x = pk2(sg * x0[0], sg * x0[1]); w.y = pk2(sg * x0[2], sg * x0[3]); w.z = pk2(sg * x1[0], sg * x1[1]); w.w = pk2(sg * x1[2], sg * x1[3]);
                    cf[ks] = __builtin_bit_cast(bf16x8, w);
                }
                dk = dsk[16 * g + fr];
            }
            for (int tg = 0; tg < 8; ++tg) {
                const bf16x4 af = *(const LAS bf16x4*)(UTb + (16 * tg + fr) * 16 + 4 * q);
                const f32x4 z4 = (f32x4){0.f, 0.f, 0.f, 0.f};
#pragma unroll
                for (int i = 0; i < 4; ++i) {
                    const f32x4 dr = __builtin_amdgcn_mfma_f32_16x16x16bf16_1k(af, bre[i], z4, 0, 0, 0), di = __builtin_amdgcn_mfma_f32_16x16x16bf16_1k(af, bim[i], z4, 0, 0, 0);
#pragma unroll
                    for (int v = 0; v < 4; ++v) { BUL[(4 * q + v) * 132 + 16 * i + fr] = dr[v]; BUL[(4 * q + v) * 132 + 64 + 16 * i + fr] = di[v]; }
                }
#pragma unroll
                for (int tl = 0; tl < 16; ++tl) {
                    const float br = BUL[tl * 132 + lane], bi = BUL[tl * 132 + 64 + lane];
                    const float nr = lam[0] * hst[0] - lam[1] * hst[1] + br, ni = lam[0] * hst[1] + lam[1] * hst[0] + bi;
                    hst = (f32x2){nr, ni};
                    if (pass == 1) { const unsigned hw = pk2(nr, ni); HS[tl * 136 + lane] = (bf16)(hw & 0xffffu); HS[tl * 136 + 64 + lane] = (bf16)(hw >> 16); }
                }
                if (pass == 1) {
                    f32x4 acc = z4;
#pragma unroll
                    for (int ks = 0; ks < 4; ++ks) { const bf16x8 hf = *(const LAS bf16x8*)(HS + fr * 136 + ks * 32 + q * 8);
                        acc = __builtin_amdgcn_mfma_f32_16x16x32_bf16(hf, cf[ks], acc, 0, 0, 0); }
#pragma unroll
                    for (int j = 0; j < 4; ++j) { const int tk = tg * 16 + q * 4 + j; const float uv = bflo((unsigned)UTb[tk * 16 + fr]);
                        const float y = gelu_tanh(acc[j] + dk * uv);
                        YG[(size_t)(t0 + tk) * D + 16 * g + fr] = (bf16)(pk2(y, 0.f) & 0xffffu); }
                }
            }
            if (pass == 0) EST[((size_t)ck * 64 + g) * 64 + lane] = hst;
        }
        GSYNC();
    }

    {
        PHASE_ARGS
        pg8::Gemm g{YG, (const bf16*)(ws + W_GLU), T, 2048, D}; pg8::StaticOrder S; S.init(T, 2048, G, bid);
        pg8::EpiRes<2> E{ka->out, ka->out, B1, nullptr, STA, nullptr};
        pg8::gemm_phase<pg8::EpiRes<2>, pg8::StaticOrder, true, true>(lds, g, S, E);
    }
    GSYNC();
    {
        PHASE_ARGS
        pg8::Gemm g{B1, (const bf16*)(ws + W_UP1), T, FF, D}; pg8::StaticOrder S; S.init(T, FF, G, bid);
        pg8::EpiB<2, 32> E{HID, nullptr, nullptr, STA, nullptr, nullptr, FF};
        pg8::gemm_phase<pg8::EpiB<2, 32>, pg8::StaticOrder, true, true>(lds, g, S, E);
    }
    GSYNC();
    {
        PHASE_ARGS
        pg8::Gemm g{HID, (const bf16*)(ws + W_DN1), T, D, FF}; pg8::StaticOrder S; S.init(T, D, G, bid);
        pg8::EpiRes<0> E{ka->out, ka->out, B1, nullptr, STB, nullptr};
        pg8::gemm_phase<pg8::EpiRes<0>, pg8::StaticOrder, true, true>(lds, g, S, E);
    }
    GSYNC();
    {
        PHASE_ARGS
        pg8::Gemm g{PBF + (size_t)T * 256, (const bf16*)(ws + W_P1), T, D, 256}; pg8::StaticOrder S; S.init(T, D, G, bid);
        pg8::EpiB<3, 16> E{PP, nullptr, nullptr, nullptr, nullptr, nullptr, D};
        pg8::gemm_phase<pg8::EpiB<3, 16>, pg8::StaticOrder, true, true>(lds, g, S, E);
    }
    GSYNC();
    {
        PHASE_ARGS
        pg8::Gemm g{B1, (const bf16*)(ws + W_G1), T, D, D}; pg8::StaticOrder S; S.init(T, D, G, bid);
        pg8::EpiRes<1> E{ka->out, ka->out, nullptr, STB, STA, PP};
        pg8::gemm_phase<pg8::EpiRes<1>, pg8::StaticOrder, true, true>(lds, g, S, E);
    }
    GSYNC();
    {
        PHASE_ARGS
        const float* gf = ka->in[40];
        for (int m = gw; m < T; m += NGW) {
            const f32x4* sp = (const f32x4*)(STA + (size_t)m * 32); const f32x4 s0 = sp[0], s1 = sp[1], s2 = sp[2], s3 = sp[3];
            const float ssq = ((s0[0] + s0[1]) + (s0[2] + s0[3])) + ((s1[0] + s1[1]) + (s1[2] + s1[3])) + ((s2[0] + s2[1]) + (s2[2] + s2[3])) + ((s3[0] + s3[1]) + (s3[2] + s3[3]));
            const float rs = rsqrtf(ssq * (1.f / 1024.f) + 1e-6f);
            f32x4* xr = (f32x4*)(ka->out + (size_t)m * D) + lane;
#pragma unroll
            for (int j = 0; j < 4; ++j) { const f32x4 v = xr[64 * j]; const f32x4 gg = *((const f32x4*)gf + lane + 64 * j); xr[64 * j] = v * rs * gg; }
        }
    }
#undef GSYNC
}

extern "C" void kernel_launch(void* const* d_in, const int* in_sizes, int n_in, void* d_out, int out_size, void* d_ws, size_t ws_size, hipStream_t stream) {
    static int grid = 0;
    if (grid == 0) {
        if (n_in != 41 || out_size != T * D || ws_size < WS_END) { fprintf(stderr, "kernel_launch: unexpected shapes (n_in %d, out %d, ws %zu)\n", n_in, out_size, ws_size); grid = -1; return; }
        int dev = 0, cus = 0, per_cu = 0;
        hipGetDevice(&dev); hipDeviceGetAttribute(&cus, hipDeviceAttributeMultiprocessorCount, dev);
        if (hipFuncSetAttribute((const void*)mega_fwd, hipFuncAttributeMaxDynamicSharedMemorySize, LDS_BYTES) != hipSuccess) { fprintf(stderr, "kernel_launch: hipFuncSetAttribute failed\n"); grid = -1; return; }
        if (hipOccupancyMaxActiveBlocksPerMultiprocessor(&per_cu, (const void*)mega_fwd, NWAVES * 64, LDS_BYTES) != hipSuccess || per_cu < 1) { fprintf(stderr, "kernel_launch: occupancy query says %d\n", per_cu); per_cu = 1; }
        (void)hipGetLastError();
        grid = cus;
    }
    if (grid < 0) return;
    if (hipMemsetAsync((char*)d_ws + WS_BAR, 0, 16384, stream) != hipSuccess) { fprintf(stderr, "kernel_launch: memset failed\n"); return; }
    Args a{};
    for (int i = 0; i < 41; ++i) a.in[i] = (const float*)d_in[i];
    a.out = (float*)d_out; a.ws = (unsigned char*)d_ws;
    void* params[] = {&a};
    hipError_t e = hipLaunchCooperativeKernel((const void*)mega_fwd, dim3(grid), dim3(NWAVES * 64), params, LDS_BYTES, stream);
    if (e != hipSuccess) fprintf(stderr, "kernel_launch: cooperative launch failed: %s (grid %d)\n", hipGetErrorString(e), grid);
}
```
